# Optimizing an MI355X kernel written in HIP

```python
import math
import jax, jax.numpy as jnp
from jax import lax
import numpy as np

D_MODEL = 2048
BATCH = 2
SEQ = 16384
DEPTH = 2
DEC_BATCH = 4
DEC_SEQ = 8192
PAST_LEN = 128

GRID_W = 64
HEAD_DIM = 64
ROT_DIM = HEAD_DIM // 4
ROPE_THETA = 500000.0
EPS = 1e-6
Q_BLOCK = 128
HALF = 0.5

FNET_GROUPS = 4
FNET_GROUP_DIM = 128
FNET_WIDTH = FNET_GROUPS * FNET_GROUP_DIM
NAT_HEADS = 8
NAT_WIN_H = 8
NAT_WIN_W = 16
NAT_WIDTH = NAT_HEADS * HEAD_DIM
DIFF_HEADS = 4
DIFF_QK_WIDTH = DIFF_HEADS * 2 * HEAD_DIM
DIFF_V_DIM = 2 * HEAD_DIM
DIFF_WIDTH = DIFF_HEADS * DIFF_V_DIM
DIL_PATTERNS = ((128, 1), (512, 4), (2048, 16))
DIL_GROUPS = len(DIL_PATTERNS)
DIL_HEADS = 8
DIL_QKV_WIDTH = DIL_GROUPS * DIL_HEADS * HEAD_DIM
DIL_WIDTH = DIL_HEADS * HEAD_DIM

N_BRANCH = 4
BRANCH_WIDTH = 512
MIX_COLS = FNET_WIDTH + 3 * NAT_WIDTH + 2 * DIFF_QK_WIDTH + DIFF_WIDTH + 3 * DIL_QKV_WIDTH
IN_COLS = MIX_COLS + N_BRANCH * D_MODEL
N_MOD = 9
D_FF = ((8 * D_MODEL // 3 + 63) // 64) * 64

kernel_name = "hybrid_gated_fourier_nat_diff_dilated_encoder"


def _rmsnorm(x, g):
    xf = x.astype(jnp.float32)
    y = xf * lax.rsqrt(jnp.mean(xf * xf, axis=-1, keepdims=True) + EPS)
    return (y * g).astype(x.dtype)


def _modulate(h, shift, scale):
    return h * (1.0 + scale) + shift


def _swiglu(h, w_in, w_out):
    a, b = jnp.split(h @ w_in, 2, axis=-1)
    return (jax.nn.silu(a) * b) @ w_out


def _rope_tables(T):
    inv = ROPE_THETA ** (-jnp.arange(0, ROT_DIM, 2, dtype=jnp.float32) / ROT_DIM)
    ang = jnp.arange(T, dtype=jnp.float32)[:, None] * inv[None, :]
    return jnp.cos(ang), jnp.sin(ang)


def _apply_rope(x, cos, sin):
    xr = x[..., :ROT_DIM].astype(jnp.float32)
    x1, x2 = xr[..., :ROT_DIM // 2], xr[..., ROT_DIM // 2:]
    c = cos[None, :, None, :]
    s = sin[None, :, None, :]
    rot = jnp.concatenate([x1 * c - x2 * s, x2 * c + x1 * s], axis=-1).astype(x.dtype)
    return jnp.concatenate([rot, x[..., ROT_DIM:]], axis=-1)


def _split_cols(z):
    sizes = [FNET_WIDTH, NAT_WIDTH, NAT_WIDTH, NAT_WIDTH,
             DIFF_QK_WIDTH, DIFF_QK_WIDTH, DIFF_WIDTH,
             DIL_QKV_WIDTH, DIL_QKV_WIDTH, DIL_QKV_WIDTH,
             N_BRANCH * D_MODEL]
    idx = np.cumsum(sizes)[:-1].tolist()
    return jnp.split(z, idx, axis=-1)


def _fourier_mix(u):
    B, T, G, C = u.shape
    f = jnp.fft.fft2(u.astype(jnp.float32), axes=(1, 3), norm="ortho")
    return jnp.real(f).astype(u.dtype).reshape(B, T, G * C)


def _neighborhood_attention(q, k, v, rel_bias):
    B, T, H, dh = q.shape
    rows = T // GRID_W
    kh = min(NAT_WIN_H, rows)
    qg = q.reshape(B, rows, GRID_W, H, dh)
    kg = k.reshape(B, rows, GRID_W, H, dh)
    vg = v.reshape(B, rows, GRID_W, H, dh)
    col = jnp.arange(GRID_W)
    col_start = jnp.clip(col - NAT_WIN_W // 2, 0, GRID_W - NAT_WIN_W)
    col_idx = col_start[:, None] + jnp.arange(NAT_WIN_W)[None, :]
    col_off = col_idx - col[:, None] + (NAT_WIN_W - 1)
    scale = dh ** -0.5

    def row_block(r):
        rs = jnp.clip(r - NAT_WIN_H // 2, 0, rows - kh)
        k_slab = lax.dynamic_slice_in_dim(kg, rs, kh, axis=1)
        v_slab = lax.dynamic_slice_in_dim(vg, rs, kh, axis=1)
        k_sel = k_slab[:, :, col_idx]
        v_sel = v_slab[:, :, col_idx]
        q_row = lax.dynamic_index_in_dim(qg, r, axis=1, keepdims=False)
        s = jnp.einsum('bwhd,bawjhd->bhwaj', q_row, k_sel,
                       preferred_element_type=jnp.float32) * scale
        row_off = rs + jnp.arange(kh) - r + (NAT_WIN_H - 1)
        bias = rel_bias[:, row_off][:, :, col_off]
        s = s + jnp.transpose(bias, (0, 2, 1, 3))[None].astype(jnp.float32)
        p = jax.nn.softmax(s.reshape(B, H, GRID_W, kh * NAT_WIN_W), axis=-1)
        p = p.reshape(B, H, GRID_W, kh, NAT_WIN_W).astype(v.dtype)
        return jnp.einsum('bhwaj,bawjhd->bwhd', p, v_sel)

    out = lax.map(row_block, jnp.arange(rows))
    return jnp.transpose(out, (1, 0, 2, 3, 4)).reshape(B, T, H * dh)


def _diff_attention(q, k, v, lam, lam_init, ln_g):
    B, T, H, _, dh = q.shape
    scale = dh ** -0.5
    nb = T // Q_BLOCK
    qb = jnp.transpose(q.reshape(B, nb, Q_BLOCK, H, 2, dh), (1, 0, 2, 3, 4, 5))

    def block(qblk):
        s = jnp.einsum('bqhcd,bkhcd->bchqk', qblk, k,
                       preferred_element_type=jnp.float32) * scale
        p = jax.nn.softmax(s, axis=-1)
        a = p[:, 0] - lam * p[:, 1]
        return jnp.einsum('bhqk,bkhe->bqhe', a.astype(v.dtype), v)

    o = lax.map(block, qb)
    o = jnp.transpose(o, (1, 0, 2, 3, 4)).reshape(B, T, H, 2 * dh)
    o = _rmsnorm(o, ln_g) * (1.0 - lam_init)
    return o.reshape(B, T, H * 2 * dh)


def _dilated_group(q, k, v, window, dil):
    B, T, H, dh = q.shape
    side = window // (2 * dil)
    offs = dil * jnp.arange(-side, side + 1)
    scale = dh ** -0.5
    nb = T // Q_BLOCK
    qb = jnp.transpose(q.reshape(B, nb, Q_BLOCK, H, dh), (1, 0, 2, 3, 4))
    starts = jnp.arange(nb, dtype=jnp.int32) * Q_BLOCK

    def block(args):
        qblk, start = args
        pos = start + jnp.arange(Q_BLOCK)[:, None] + offs[None, :]
        valid = (pos >= 0) & (pos < T)
        idx = jnp.clip(pos, 0, T - 1)
        k_sel = k[:, idx]
        v_sel = v[:, idx]
        s = jnp.einsum('bqhd,bqjhd->bhqj', qblk, k_sel,
                       preferred_element_type=jnp.float32) * scale
        s = jnp.where(valid[None, None], s, -jnp.inf)
        lse = jax.nn.logsumexp(s, axis=-1)
        p = jnp.exp(s - lse[..., None]).astype(v.dtype)
        return jnp.einsum('bhqj,bqjhd->bqhd', p, v_sel), lse

    o, lse = lax.map(block, (qb, starts))
    o = jnp.transpose(o, (1, 0, 2, 3, 4)).reshape(B, T, H, dh)
    lse = jnp.transpose(lse, (1, 0, 3, 2)).reshape(B, T, H)
    return o, lse


def _dilated_attention(q, k, v):
    B, T, G, H, dh = q.shape
    outs, lses = [], []
    for g, (window, dil) in enumerate(DIL_PATTERNS):
        o, lse = _dilated_group(q[:, :, g], k[:, :, g], v[:, :, g], window, dil)
        outs.append(o)
        lses.append(lse)
    w = jax.nn.softmax(jnp.stack(lses, axis=-1), axis=-1)
    o = jnp.einsum('btghd,bthg->bthd', jnp.stack(outs, axis=2).astype(jnp.float32), w)
    return o.astype(q.dtype).reshape(B, T, H * dh)


def _token_mixer(h, w_in, b_gate, rel_bias, lam_q1, lam_k1, lam_q2, lam_k2, diff_ln_g,
                 w_branch, w_out, layer_idx, cos, sin):
    B, T, _ = h.shape
    (f_in, nq, nk, nv, dq, dk, dv, lq, lk, lv, g_pre) = _split_cols(h @ w_in)
    heads = lambda t, n: t.reshape(B, T, n, HEAD_DIM)
    y_a = _fourier_mix(f_in.reshape(B, T, FNET_GROUPS, FNET_GROUP_DIM))
    y_b = _neighborhood_attention(heads(nq, NAT_HEADS), heads(nk, NAT_HEADS), heads(nv, NAT_HEADS), rel_bias)
    dq = _apply_rope(heads(dq, 2 * DIFF_HEADS), cos, sin).reshape(B, T, DIFF_HEADS, 2, HEAD_DIM)
    dk = _apply_rope(heads(dk, 2 * DIFF_HEADS), cos, sin).reshape(B, T, DIFF_HEADS, 2, HEAD_DIM)
    lam_init = 0.8 - 0.6 * math.exp(-0.3 * layer_idx)
    lam = (jnp.exp(jnp.sum(lam_q1.astype(jnp.float32) * lam_k1.astype(jnp.float32)))
           - jnp.exp(jnp.sum(lam_q2.astype(jnp.float32) * lam_k2.astype(jnp.float32))) + lam_init)
    y_c = _diff_attention(dq, dk, dv.reshape(B, T, DIFF_HEADS, DIFF_V_DIM), lam, lam_init, diff_ln_g)
    n_dil = DIL_GROUPS * DIL_HEADS
    lq = _apply_rope(heads(lq, n_dil), cos, sin).reshape(B, T, DIL_GROUPS, DIL_HEADS, HEAD_DIM)
    lk = _apply_rope(heads(lk, n_dil), cos, sin).reshape(B, T, DIL_GROUPS, DIL_HEADS, HEAD_DIM)
    y_d = _dilated_attention(lq, lk, lv.reshape(B, T, DIL_GROUPS, DIL_HEADS, HEAD_DIM))
    gates = jax.nn.sigmoid((g_pre + b_gate.reshape(-1)).astype(jnp.float32)).astype(h.dtype)
    gates = gates.reshape(B, T, N_BRANCH, D_MODEL)
    branches = [y_a, y_b, y_c, y_d]
    merged = gates[:, :, 0] * (branches[0] @ w_branch[0])
    for n in range(1, N_BRANCH):
        merged = merged + gates[:, :, n] * (branches[n] @ w_branch[n])
    return merged @ w_out


def _trunk(x, c, w_ada, b_ada, g_ffn1, w_ffn1_in, w_ffn1_out, g_mix, w_in, b_gate, nat_rel_bias,
           lam_q1, lam_k1, lam_q2, lam_k2, diff_ln_g, w_branch, w_out, g_ffn2, w_ffn2_in, w_ffn2_out, g_final):
    B, T, _ = x.shape
    cos, sin = _rope_tables(T)
    for l in range(DEPTH):
        mod = (jax.nn.silu(c) @ w_ada[l] + b_ada[l]).reshape(B, N_MOD, 1, D_MODEL)
        sh1, sc1, gt1, sh2, sc2, gt2, sh3, sc3, gt3 = [mod[:, i] for i in range(N_MOD)]
        h = _modulate(_rmsnorm(x, g_ffn1[l]), sh1, sc1)
        x = x + HALF * gt1 * _swiglu(h, w_ffn1_in[l], w_ffn1_out[l])
        h = _modulate(_rmsnorm(x, g_mix[l]), sh2, sc2)
        x = x + gt2 * _token_mixer(h, w_in[l], b_gate[l], nat_rel_bias[l], lam_q1[l], lam_k1[l],
                                   lam_q2[l], lam_k2[l], diff_ln_g[l], w_branch[l], w_out[l], l, cos, sin)
        h = _modulate(_rmsnorm(x, g_ffn2[l]), sh3, sc3)
        x = x + HALF * gt3 * _swiglu(h, w_ffn2_in[l], w_ffn2_out[l])
    return _rmsnorm(x, g_final)


def setup_inputs(seed: int = 0) -> dict:
    key = jax.random.key(seed)
    ks = jax.random.split(key, 28)
    f32 = jnp.float32
    L, D = DEPTH, D_MODEL

    def nrm(k, shape, scale):
        return jax.random.normal(k, shape, f32) * scale

    return {
        "x_prompt": nrm(ks[0], (BATCH, SEQ, D), 1.0),
        "x_sample": nrm(ks[1], (DEC_BATCH, DEC_SEQ, D), 1.0),
        "c_prompt": nrm(ks[2], (BATCH, D), 1.0),
        "c_sample": nrm(ks[3], (DEC_BATCH, D), 1.0),
        "w_ada": nrm(ks[4], (L, D, N_MOD * D), 0.5 * D ** -0.5),
        "b_ada": nrm(ks[5], (L, N_MOD * D), 0.02),
        "g_ffn1": 1.0 + nrm(ks[6], (L, D), 0.02),
        "w_ffn1_in": nrm(ks[7], (L, D, 2 * D_FF), D ** -0.5),
        "w_ffn1_out": nrm(ks[8], (L, D_FF, D), D_FF ** -0.5),
        "g_mix": 1.0 + nrm(ks[9], (L, D), 0.02),
        "w_in": nrm(ks[10], (L, D, IN_COLS), D ** -0.5),
        "b_gate": nrm(ks[11], (L, N_BRANCH, D), 0.02),
        "nat_rel_bias": nrm(ks[12], (L, NAT_HEADS, 2 * NAT_WIN_H - 1, 2 * NAT_WIN_W - 1), 0.1),
        "lam_q1": nrm(ks[13], (L, HEAD_DIM), 0.1),
        "lam_k1": nrm(ks[14], (L, HEAD_DIM), 0.1),
        "lam_q2": nrm(ks[15], (L, HEAD_DIM), 0.1),
        "lam_k2": nrm(ks[16], (L, HEAD_DIM), 0.1),
        "diff_ln_g": 1.0 + nrm(ks[17], (L, DIFF_V_DIM), 0.02),
        "w_branch": nrm(ks[18], (L, N_BRANCH, BRANCH_WIDTH, D), BRANCH_WIDTH ** -0.5),
        "w_out": nrm(ks[19], (L, D, D), D ** -0.5),
        "g_ffn2": 1.0 + nrm(ks[20], (L, D), 0.02),
        "w_ffn2_in": nrm(ks[21], (L, D, 2 * D_FF), D ** -0.5),
        "w_ffn2_out": nrm(ks[22], (L, D_FF, D), D_FF ** -0.5),
        "g_final": 1.0 + nrm(ks[23], (D,), 0.02),
    }


def reference(x_prompt, x_sample, c_prompt, c_sample, w_ada, b_ada, g_ffn1, w_ffn1_in, w_ffn1_out,
              g_mix, w_in, b_gate, nat_rel_bias, lam_q1, lam_k1, lam_q2, lam_k2, diff_ln_g,
              w_branch, w_out, g_ffn2, w_ffn2_in, w_ffn2_out, g_final):
    y_prompt = _trunk(x_prompt, c_prompt, w_ada, b_ada, g_ffn1, w_ffn1_in, w_ffn1_out, g_mix, w_in, b_gate,
                      nat_rel_bias, lam_q1, lam_k1, lam_q2, lam_k2, diff_ln_g, w_branch, w_out,
                      g_ffn2, w_ffn2_in, w_ffn2_out, g_final)
    y_sample = _trunk(x_sample, c_sample, w_ada, b_ada, g_ffn1, w_ffn1_in, w_ffn1_out, g_mix, w_in, b_gate,
                      nat_rel_bias, lam_q1, lam_k1, lam_q2, lam_k2, diff_ln_g, w_branch, w_out,
                      g_ffn2, w_ffn2_in, w_ffn2_out, g_final)
    return (y_prompt, y_sample)
```

```cpp
#include <hip/hip_runtime.h>
#include <cstdio>
#include <cstdint>

#ifndef MK_ONE_LAUNCH
#define MK_ONE_LAUNCH 1
#endif
#ifndef DBG_SKIP
#define DBG_SKIP 0
#endif
#ifndef DBG_REP
#define DBG_REP 0
#endif
#ifndef DBG_PROBE
#define DBG_PROBE -1
#endif
#ifndef WGM_FFI
#define WGM_FFI 4
#endif
#ifndef WGM_INP
#define WGM_INP 4
#endif
#ifndef WGM_FFO
#define WGM_FFO 4
#endif
#ifndef DBG_WPROBE
#define DBG_WPROBE 0
#endif
#define NREP(k) (1 + ((DBG_REP >> (k)) & 1))

#define LAS __attribute__((address_space(3)))
typedef unsigned short bf16_t;
typedef short bf16x8 __attribute__((ext_vector_type(8)));
typedef short s16x4 __attribute__((ext_vector_type(4)));
typedef float f32x4 __attribute__((ext_vector_type(4)));
typedef float f32x2 __attribute__((ext_vector_type(2)));
typedef float f32x16 __attribute__((ext_vector_type(16)));
typedef unsigned u32x4 __attribute__((ext_vector_type(4)));
typedef unsigned u32x2 __attribute__((ext_vector_type(2)));

constexpr int DM = 2048, NTOK = 65536, DFF = 5504, GT = 16384, ZP = 8192, NINV = 16384, NMODC = 18432;
constexpr int ZR = 64;
__host__ __device__ __forceinline__ size_t zoff(int row, int col) { return ((size_t)(col >> 6) * GT + row) * ZR + (col & 63); }
constexpr float EPS = 1e-6f;
constexpr float LOG2E = 1.4426950408889634f;
constexpr float C2 = 0.125f * 1.4426950408889634f;

constexpr size_t MiB = 1u << 20;
constexpr size_t WS_CTL = 0, CTL_ZERO_BYTES = 1 * MiB;
constexpr size_t WS_MOD = 1 * MiB;
constexpr size_t WS_ROPE = 2 * MiB;
constexpr size_t WS_DFT = 3 * MiB;
constexpr size_t WS_LAM = 3 * MiB + 256 * 1024;
constexpr size_t WS_W = 4 * MiB;
constexpr size_t WO_FF1I = 0, WO_FF1O = 45088768, WO_IN = 67633152, WO_BR = 134742016, WO_OUT = 143130624, WO_FF2I = 151519232, WO_FF2O = 196608000, WLAYER = 219152384;
constexpr size_t WS_H = 426 * MiB;
constexpr size_t WS_BIG = 682 * MiB;
constexpr size_t WS_Z = WS_BIG, WS_G = WS_BIG + 272 * MiB, WS_Y = WS_BIG + 528 * MiB, WS_MG = WS_BIG + 592 * MiB, WS_FFTB = WS_BIG + 656 * MiB,
                 WS_DILO = WS_BIG + 688 * MiB, WS_DILL = WS_BIG + 784 * MiB, WS_DOS = WS_BIG + 786 * MiB,
                 WS_SS = WS_BIG + 802 * MiB  ,
                 WS_AT = WS_SS + 2 * MiB  , WS_BW = WS_AT + 1 * MiB  , WS_XF = WS_BW + 2 * MiB  , WS_END = WS_XF + 512 * MiB;
constexpr int BWL = 38400;
static_assert(WS_W + 2 * WLAYER <= WS_H, "weights region");
constexpr int CW_BAR = 4096;

constexpr int LDS_BYTES = 148480;
constexpr int LDSCTL_OFF = 147456;
constexpr int MISC_OFF = LDSCTL_OFF + 320;

__device__ __forceinline__ float bf_lo(unsigned w) { return __uint_as_float(w << 16); }
__device__ __forceinline__ float bf_hi(unsigned w) { return __uint_as_float(w & 0xffff0000u); }
typedef __bf16 bf16x2_t __attribute__((ext_vector_type(2)));
__device__ __forceinline__ unsigned pk2(float lo, float hi) { const f32x2 v = {lo, hi}; const bf16x2_t b = __builtin_convertvector(v, bf16x2_t); return __builtin_bit_cast(unsigned, b); }
__device__ __forceinline__ float swap_max(float x) { auto rr = __builtin_amdgcn_permlane32_swap(__float_as_uint(x), __float_as_uint(x), false, false); return fmaxf(__uint_as_float(rr[0]), __uint_as_float(rr[1])); }
__device__ __forceinline__ float swap_sum(float x) { auto rr = __builtin_amdgcn_permlane32_swap(__float_as_uint(x), __float_as_uint(x), false, false); return __uint_as_float(rr[0]) + __uint_as_float(rr[1]); }
__device__ __forceinline__ int lane_now() { int l; asm volatile("v_mbcnt_lo_u32_b32 %0, -1, 0\n\tv_mbcnt_hi_u32_b32 %0, -1, %0" : "=v"(l)); return l; }
__device__ __forceinline__ int opaque_tid(int wv) { return (wv << 6) | lane_now(); }
__device__ __forceinline__ float wave_sum(float v) {
    v += __uint_as_float((unsigned)__builtin_amdgcn_ds_swizzle((int)__float_as_uint(v), (1 << 10) | 0x1f));
    v += __uint_as_float((unsigned)__builtin_amdgcn_ds_swizzle((int)__float_as_uint(v), (2 << 10) | 0x1f));
    v += __uint_as_float((unsigned)__builtin_amdgcn_ds_swizzle((int)__float_as_uint(v), (4 << 10) | 0x1f));
    v += __uint_as_float((unsigned)__builtin_amdgcn_ds_swizzle((int)__float_as_uint(v), (8 << 10) | 0x1f));
    v += __uint_as_float((unsigned)__builtin_amdgcn_ds_swizzle((int)__float_as_uint(v), (16 << 10) | 0x1f));
    return swap_sum(v);
}
__device__ __forceinline__ int opaque_lane() { return lane_now(); }
__device__ __forceinline__ int brow_of(int row) { return row < 32768 ? (row >> 14) : 2 + ((row - 32768) >> 13); }
__device__ __forceinline__ int crow(int r, int hi) { return (r & 3) + 8 * (r >> 2) + 4 * hi; }

namespace pg8 {
constexpr float ROPE_C0[8] = {1.5915494309e-01f, 3.0863763405e-02f, 5.9851857127e-03f, 1.1606636412e-03f, 2.2507907904e-04f, 4.3647952793e-05f, 8.4643308082e-06f, 1.6414262628e-06f};
constexpr float ROPE_C1[8] = {3.7183271576e-01f, 9.5056171580e-01f, 7.6610377123e-01f, 1.4856494608e-01f, 2.8810122117e-02f, 5.5869379575e-03f, 1.0834343435e-03f, 2.1010256164e-04f};
constexpr int BM = 256, BK = 64, HALF = 128, HTB = HALF * BK * 2, STAGE_BYTES = 8 * HTB, NXCD = 8, WGM = 4;
__host__ __device__ __forceinline__ int lds_byte(int r, int c) { const int st = (r >> 4) * 2 + (c >> 5), rr = r & 15, cc = c & 31, ob = rr * 64 + cc * 2; return st * 1024 + (ob ^ (((ob >> 9) & 1) << 5)); }
__host__ __device__ __forceinline__ void stage_rc(int b, int& R, int& C) { const int st = b / 1024, sb = b % 1024, swz = sb ^ (((sb >> 9) & 1) << 5); R = (st >> 1) * 16 + swz / 64; C = (st & 1) * 32 + (swz % 64) / 2; }
__host__ __device__ __forceinline__ int perm32(int rho) { const int n = rho >> 4, i = rho & 15; return 8 * (i >> 2) + 4 * n + (i & 3); }
__host__ __device__ __forceinline__ size_t atile_off(int r, int k, int nkt) { return ((size_t)((r >> 8) * nkt + (k >> 6)) * 2 + ((r >> 7) & 1)) * 16384 + lds_byte(r & 127, k & 63); }
__host__ __device__ __forceinline__ size_t wtile_off(int v, int k, int nkt) {
    const int rb = v & 127, s = rb & 31, rho = 16 * ((s >> 2) & 1) + 4 * (s >> 3) + (s & 3), R = (rb & ~31) + rho;
    return ((size_t)((v >> 8) * nkt + (k >> 6)) * 2 + ((v >> 7) & 1)) * 16384 + lds_byte(R, k & 63);
}

struct Unit { int pm, pn, pz; const char* a; const char* b; };

__device__ __forceinline__ bool tile_of(int nM, int nN, int G, int c, int i, int& pm, int& pn, int wgm = WGM) {
    const int nwg = nM * nN; const long L = (long)i * G + c; if (L >= nwg) return false;
    int wgid = (int)L; { const int q = nwg / NXCD, r = nwg % NXCD, xcd = wgid % NXCD, off = wgid / NXCD; wgid = (xcd < r ? xcd * (q + 1) : r * (q + 1) + (xcd - r) * q) + off; }
    const int nig = wgm * nN, gid = wgid / nig, fm = gid * wgm, gsz = (nM - fm) < wgm ? (nM - fm) : wgm;
    pm = fm + ((wgid % nig) % gsz); pn = (wgid % nig) / gsz; return true;
}
struct PlainOrder {
    const char* A; const char* Bt; int nM, nN, G, c, wgm; size_t tA, tB; bool atile;
    __device__ __forceinline__ void init(const void* A_, const void* Bt_, int M, int N, int lda, int ldb, int G_, int c_, int wgm_ = WGM) { A = (const char*)A_; Bt = (const char*)Bt_; nM = M / BM; nN = N / BM; G = G_; c = c_; wgm = wgm_; tA = (size_t)BM * lda * 2; tB = (size_t)BM * ldb * 2; atile = true; }
    __device__ __forceinline__ bool next(int i, Unit& u) const { int pm, pn; if (!tile_of(nM, nN, G, c, i, pm, pn, wgm)) return false; u.pm = pm; u.pn = pn; u.pz = 0; u.a = A + (size_t)pm * tA; u.b = Bt + (size_t)pn * tB; return true; }
};
struct MergeOrder {
    const char* A; const char* Bt; int G, c; static constexpr bool atile = false;
    __device__ __forceinline__ bool next(int i, Unit& u) const { int pm, pn; if (!tile_of(64, 8, G, c, i >> 1, pm, pn)) return false; u.pm = pm; u.pn = pn; u.pz = i & 1;
        u.a = A + (size_t)pm * (32 * 32768) + (size_t)(i & 1) * 16384; u.b = Bt + (size_t)pn * (256 * 2048 * 2); return true; }
};

template <class Epi, class Sched, bool HM = false>
__device__ __forceinline__ void gemm_phase(LAS unsigned char* lds, const int K, const int lda, const int ldb, const Sched& S, const Epi& E, const int wv) {
    const int tid = opaque_tid(wv), wid = __builtin_amdgcn_readfirstlane(tid >> 6), lane = tid & 63, wr = wid >> 2, wc = wid & 3, fr = lane & 15, fq = lane >> 4;
    const int nt = K / BK;
    unsigned voffA[2], voffB[2];
#pragma unroll
    for (int i = 0; i < 2; ++i) { int R, C; stage_rc(tid * 16 + i * 8192, R, C); const int Rb = Epi::PERM ? ((R & ~31) + perm32(R & 31)) : R;
        voffA[i] = S.atile ? (unsigned)(tid * 16 + i * 8192) : (unsigned)(R * lda + C) * 2u; voffB[i] = (unsigned)(tid * 16 + i * 8192); (void)Rb; }
    const size_t kstep = S.atile ? (size_t)(2 * HTB) : (size_t)(BK * 2), kstepB = (size_t)(2 * HTB);
    const size_t hstepA = HM ? (size_t)0 : (S.atile ? (size_t)HTB : (size_t)HALF * lda * 2), hstepB = (size_t)HTB;
    const unsigned ldsw = (unsigned)wid * 1024u;
    const int aoff = lds_byte(wr * 64 + fr, fq * 8), boff = lds_byte(wc * 32 + fr, fq * 8);
#define PG8_SA(b, h) (((b) * 2 + (h)) * HTB)
#define PG8_SB(b, h) ((4 + (b) * 2 + (h)) * HTB)
#define PG8_STAGE(bufoff, gbase, voff) do { _Pragma("unroll") for (int _i = 0; _i < 2; ++_i) \
        __builtin_amdgcn_global_load_lds((const unsigned*)((const char*)(gbase) + (voff)[_i]), (LAS unsigned*)(lds + (bufoff) + ldsw + _i * 8192), 16, 0, 0); } while (0)
#define PG8_LDA(dst, b, h) do { _Pragma("unroll") for (int m = 0; m < 4; ++m) _Pragma("unroll") for (int k = 0; k < 2; ++k) dst[m][k] = *(const LAS bf16x8*)(lds + PG8_SA(b, h) + aoff + m * 2048 + k * 1024); } while (0)
#define PG8_LDB(dst, b, h) do { _Pragma("unroll") for (int n = 0; n < 2; ++n) _Pragma("unroll") for (int k = 0; k < 2; ++k) dst[n][k] = *(const LAS bf16x8*)(lds + PG8_SB(b, h) + boff + n * 2048 + k * 1024); } while (0)
#define PG8_MMA(ai, bj, At, Bt) do { __builtin_amdgcn_s_setprio(1); _Pragma("unroll") for (int m = 0; m < 4; ++m) _Pragma("unroll") for (int n = 0; n < 2; ++n) _Pragma("unroll") for (int k = 0; k < 2; ++k) \
        acc[ai][bj][m][n] = __builtin_amdgcn_mfma_f32_16x16x32_bf16(Bt[n][k], At[m][k], acc[ai][bj][m][n], 0, 0, 0); __builtin_amdgcn_s_setprio(0); } while (0)
#define PG8_WAIT_V(n) asm volatile("s_waitcnt vmcnt(" #n ")" ::: "memory")
#define PG8_WAIT_L(n) asm volatile("s_waitcnt lgkmcnt(" #n ")" ::: "memory")
#define PG8_BAR __builtin_amdgcn_s_barrier()
#define PG8_SCHED __builtin_amdgcn_sched_barrier(0)
    Unit cur, nxt; int ui = 0;
    if (!S.next(0, cur)) return;
    f32x4 acc[2][2][4][2];
#pragma unroll
    for (int a = 0; a < 2; ++a)
#pragma unroll
        for (int b = 0; b < 2; ++b)
#pragma unroll
            for (int m = 0; m < 4; ++m)
#pragma unroll
                for (int n = 0; n < 2; ++n) acc[a][b][m][n] = (f32x4){0.f, 0.f, 0.f, 0.f};
    bf16x8 At[4][2], B0[2][2], B1[2][2];
    const char* cA = cur.a; const char* cB = cur.b;
    PG8_STAGE(PG8_SB(0, 0), cB, voffB); PG8_STAGE(PG8_SB(0, 1), cB + hstepB, voffB); PG8_STAGE(PG8_SA(0, 0), cA, voffA); PG8_STAGE(PG8_SA(0, 1), cA + hstepA, voffA);
    if (wr == 1) PG8_BAR;
    PG8_WAIT_V(2); PG8_BAR;
    PG8_STAGE(PG8_SB(1, 0), cB + kstepB, voffB); PG8_STAGE(PG8_SA(1, 0), cA + kstep, voffA); PG8_STAGE(PG8_SB(1, 1), cB + hstepB + kstepB, voffB);
    PG8_WAIT_V(6); PG8_BAR;
    for (;;) {
        const bool has_next = S.next(ui + 1, nxt);
        const char* nA = has_next ? nxt.a : cA; const char* nB = has_next ? nxt.b : cB;
        for (int t = 0; t < nt; t += 2) {
            const bool last = (t == nt - 2);
            const char* a1 = cA + (size_t)(t + 1) * kstep;
            const char* a2 = last ? nA : cA + (size_t)(t + 2) * kstep; const char* b2 = last ? nB : cB + (size_t)(t + 2) * kstepB;
            const char* a3 = a2 + kstep; const char* b3 = b2 + kstepB;
            PG8_LDB(B0, 0, 0); PG8_LDB(B1, 0, 1); PG8_SCHED; PG8_LDA(At, 0, 0); PG8_STAGE(PG8_SA(1, 1), a1 + hstepA, voffA);
            PG8_WAIT_V(8); PG8_WAIT_L(0); PG8_BAR; PG8_MMA(0, 0, At, B0); PG8_MMA(0, 1, At, B1); PG8_BAR; PG8_SCHED;
            if constexpr (!HM) PG8_LDA(At, 0, 1); PG8_STAGE(PG8_SB(0, 0), b2, voffB); PG8_STAGE(PG8_SB(0, 1), b2 + hstepB, voffB); PG8_STAGE(PG8_SA(0, 0), a2, voffA);
            PG8_WAIT_V(8); PG8_WAIT_L(0); PG8_BAR; if constexpr (!HM) { PG8_MMA(1, 0, At, B0); PG8_MMA(1, 1, At, B1); } PG8_BAR; PG8_SCHED;
            PG8_LDB(B0, 1, 0); PG8_LDB(B1, 1, 1); PG8_SCHED; PG8_LDA(At, 1, 0); PG8_STAGE(PG8_SA(0, 1), a2 + hstepA, voffA);
            PG8_WAIT_V(8); PG8_WAIT_L(0); PG8_BAR; PG8_MMA(0, 0, At, B0); PG8_MMA(0, 1, At, B1); PG8_BAR; PG8_SCHED;
            if constexpr (!HM) PG8_LDA(At, 1, 1); PG8_STAGE(PG8_SB(1, 0), b3, voffB); PG8_STAGE(PG8_SB(1, 1), b3 + hstepB, voffB); PG8_STAGE(PG8_SA(1, 0), a3, voffA);
            PG8_WAIT_V(8); PG8_WAIT_L(0); PG8_BAR; if constexpr (!HM) { PG8_MMA(1, 0, At, B0); PG8_MMA(1, 1, At, B1); } PG8_BAR; PG8_SCHED;
            if constexpr (HM) { if (((t + 2) & 7) == 0) E.fold(acc, cur, t >> 3, wr, wc, fr, fq); }
        }
        if (wr == 0) PG8_BAR;
        E(acc, cur, wr, wc, fr, fq);
        if (!has_next) break;
#pragma unroll
        for (int a = 0; a < 2; ++a)
#pragma unroll
            for (int b = 0; b < 2; ++b)
#pragma unroll
                for (int m = 0; m < 4; ++m)
#pragma unroll
                    for (int n = 0; n < 2; ++n) acc[a][b][m][n] = (f32x4){0.f, 0.f, 0.f, 0.f};
        cur = nxt; cA = nA; cB = nB; ++ui;
        if (wr == 1) PG8_BAR;
    }
    PG8_WAIT_V(0);
    PG8_BAR;
#undef PG8_SA
#undef PG8_SB
#undef PG8_STAGE
#undef PG8_LDA
#undef PG8_LDB
#undef PG8_MMA
#undef PG8_WAIT_V
#undef PG8_WAIT_L
#undef PG8_BAR
#undef PG8_SCHED
}

template <class Epi, class Sched>
__device__ __forceinline__ void gemm_hm3(LAS unsigned char* lds, const int K, const int lda, const int ldb, const Sched& S, const Epi& E, const int wv) {
    const int tid = opaque_tid(wv), wid = __builtin_amdgcn_readfirstlane(tid >> 6), lane = tid & 63, wr = wid >> 2, wc = wid & 3, fr = lane & 15, fq = lane >> 4;
    const int nt = K / BK;
    unsigned voffA[2], voffB[2];
#pragma unroll
    for (int i = 0; i < 2; ++i) { int R, C; stage_rc(tid * 16 + i * 8192, R, C); const int Rb = Epi::PERM ? ((R & ~31) + perm32(R & 31)) : R;
        voffA[i] = (unsigned)(tid * 16 + i * 8192); voffB[i] = voffA[i]; (void)R; (void)C; (void)Rb; }
    const size_t kstep = (size_t)(2 * HTB), kstepB = (size_t)(2 * HTB), hstepB = (size_t)HTB;
    const unsigned ldsw = (unsigned)wid * 1024u;
    const int aoff = lds_byte(wr * 64 + fr, fq * 8), boff = lds_byte(wc * 32 + fr, fq * 8);
    constexpr int SLOT = 3 * HTB;
#define H3_STAGE(off, gbase, voff) do { _Pragma("unroll") for (int _i = 0; _i < 2; ++_i) \
        __builtin_amdgcn_global_load_lds((const unsigned*)((const char*)(gbase) + (voff)[_i]), (LAS unsigned*)(lds + (off) + ldsw + _i * 8192), 16, 0, 0); } while (0)
#define H3_STAGE3(sl, ga, gb) do { H3_STAGE((sl), (gb), voffB); H3_STAGE((sl) + HTB, (gb) + hstepB, voffB); H3_STAGE((sl) + 2 * HTB, (ga), voffA); } while (0)
#define H3_LDA(dst, sl) do { _Pragma("unroll") for (int m = 0; m < 4; ++m) _Pragma("unroll") for (int k = 0; k < 2; ++k) dst[m][k] = *(const LAS bf16x8*)(lds + (sl) + 2 * HTB + aoff + m * 2048 + k * 1024); } while (0)
#define H3_LDB(dst, sl, h) do { _Pragma("unroll") for (int n = 0; n < 2; ++n) _Pragma("unroll") for (int k = 0; k < 2; ++k) dst[n][k] = *(const LAS bf16x8*)(lds + (sl) + (h) * HTB + boff + n * 2048 + k * 1024); } while (0)
#define H3_MMA(bj, At, Bt) do { __builtin_amdgcn_s_setprio(1); _Pragma("unroll") for (int m = 0; m < 4; ++m) _Pragma("unroll") for (int n = 0; n < 2; ++n) _Pragma("unroll") for (int k = 0; k < 2; ++k) \
        acc[0][bj][m][n] = __builtin_amdgcn_mfma_f32_16x16x32_bf16(Bt[n][k], At[m][k], acc[0][bj][m][n], 0, 0, 0); __builtin_amdgcn_s_setprio(0); } while (0)
#define H3_BAR __builtin_amdgcn_s_barrier()
    Unit cur, nxt; int ui = 0;
    if (!S.next(0, cur)) return;
    f32x4 acc[2][2][4][2];
#pragma unroll
    for (int a = 0; a < 2; ++a)
#pragma unroll
        for (int b = 0; b < 2; ++b)
#pragma unroll
            for (int m = 0; m < 4; ++m)
#pragma unroll
                for (int n = 0; n < 2; ++n) acc[a][b][m][n] = (f32x4){0.f, 0.f, 0.f, 0.f};
    bf16x8 At[4][2], B0[2][2], B1[2][2]; u32x2 gw[4][2];
    const char* cA = cur.a; const char* cB = cur.b;
    int sl = 0, sl2 = 2 * SLOT;
    H3_STAGE3(0, cA, cB); H3_STAGE3(SLOT, cA + kstep, cB + kstepB);
    asm volatile("s_waitcnt vmcnt(6)" ::: "memory"); H3_BAR;
    if (wr == 1) H3_BAR;
    for (;;) {
        const bool has_next = S.next(ui + 1, nxt);
        const char* nA = has_next ? nxt.a : cA; const char* nB = has_next ? nxt.b : cB;
        for (int t = 0; t < nt; ++t) {
            const bool own = (t + 2 < nt);
            const char* a2 = (own ? cA : nA) + (size_t)(own ? t + 2 : t + 2 - nt) * kstep; const char* b2 = (own ? cB : nB) + (size_t)(own ? t + 2 : t + 2 - nt) * kstepB;
            H3_LDB(B0, sl, 0); H3_LDB(B1, sl, 1); __builtin_amdgcn_sched_barrier(0); H3_LDA(At, sl); H3_STAGE3(sl2, a2, b2);
            const int ph_ = t & 7;
            if (ph_ == 6) { E.fold_load(gw, cur, t >> 3, wr, wc, fr, fq); __builtin_amdgcn_sched_barrier(0); }
            if (ph_ >= 6) asm volatile("s_waitcnt vmcnt(14)" ::: "memory"); else asm volatile("s_waitcnt vmcnt(6)" ::: "memory");
            asm volatile("s_waitcnt lgkmcnt(0)" ::: "memory"); H3_BAR; H3_MMA(0, At, B0); H3_MMA(1, At, B1); H3_BAR; __builtin_amdgcn_sched_barrier(0);
            sl = (sl == 2 * SLOT) ? 0 : sl + SLOT; sl2 = (sl2 == 2 * SLOT) ? 0 : sl2 + SLOT;
            if (ph_ == 7) E.fold_apply(acc, gw, t >> 3);
        }
        if (wr == 0) H3_BAR;
        E(acc, cur, wr, wc, fr, fq);
        if (!has_next) break;
#pragma unroll
        for (int a = 0; a < 2; ++a)
#pragma unroll
            for (int b = 0; b < 2; ++b)
#pragma unroll
                for (int m = 0; m < 4; ++m)
#pragma unroll
                    for (int n = 0; n < 2; ++n) acc[a][b][m][n] = (f32x4){0.f, 0.f, 0.f, 0.f};
        cur = nxt; cA = nA; cB = nB; ++ui;
        if (wr == 1) H3_BAR;
    }
    asm volatile("s_waitcnt vmcnt(0)" ::: "memory");
    H3_BAR;
#undef H3_STAGE
#undef H3_STAGE3
#undef H3_LDA
#undef H3_LDB
#undef H3_MMA
#undef H3_BAR
}

__device__ __forceinline__ float silu_f(float a) { return a * __builtin_amdgcn_rcpf(1.0f + __builtin_amdgcn_exp2f(-a * LOG2E)); }
__device__ __forceinline__ float sigm_f(float a) { return __builtin_amdgcn_rcpf(1.0f + __builtin_amdgcn_exp2f(-a * LOG2E)); }
__device__ __forceinline__ unsigned gq8(float g) { return (unsigned)(g * 255.0f + 0.5f); }
__device__ __forceinline__ unsigned gq8x4(float a, float b, float c, float d) { return gq8(a) | (gq8(b) << 8) | (gq8(c) << 16) | (gq8(d) << 24); }

struct EpiSwiGLU {
    static constexpr bool PERM = true;
    bf16_t* O; const float* ss; const float* bwl;
    __device__ __forceinline__ void operator()(const f32x4 (&acc)[2][2][4][2], const Unit& u, int wr, int wc, int fr, int fq) const {
        const int row0 = u.pm * BM + wr * 64 + fr, col0 = u.pn * 128 + wc * 32 + 8 * fq;
        const float* bw = bwl + (size_t)brow_of(u.pm * BM) * BWL + u.pn * BM + wc * 32 + 8 * fq;
        const f32x4 ba0 = *(const f32x4*)bw, ba1 = *(const f32x4*)(bw + 4), bb0 = *(const f32x4*)(bw + HALF), bb1 = *(const f32x4*)(bw + HALF + 4);
        float rsv[2][4];
#pragma unroll
        for (int ai = 0; ai < 2; ++ai)
#pragma unroll
            for (int m = 0; m < 4; ++m) rsv[ai][m] = ss[row0 + ai * HALF + m * 16];
#pragma unroll
        for (int ai = 0; ai < 2; ++ai)
#pragma unroll
            for (int m = 0; m < 4; ++m) rsv[ai][m] = __builtin_amdgcn_rsqf(rsv[ai][m] * (1.0f / DM) + EPS);
#pragma unroll
        for (int ai = 0; ai < 2; ++ai)
#pragma unroll
            for (int m = 0; m < 4; ++m) { const int row = row0 + ai * HALF + m * 16; const float rs = rsv[ai][m];
                const f32x4 a0 = acc[ai][0][m][0] * rs + ba0, a1 = acc[ai][0][m][1] * rs + ba1, b0 = acc[ai][1][m][0] * rs + bb0, b1 = acc[ai][1][m][1] * rs + bb1;
                u32x4 w;
                w.x = pk2(silu_f(a0[0]) * b0[0], silu_f(a0[1]) * b0[1]); w.y = pk2(silu_f(a0[2]) * b0[2], silu_f(a0[3]) * b0[3]);
                w.z = pk2(silu_f(a1[0]) * b1[0], silu_f(a1[1]) * b1[1]); w.w = pk2(silu_f(a1[2]) * b1[2], silu_f(a1[3]) * b1[3]);
                *(u32x4*)((char*)O + atile_off(row, col0, DFF / 64)) = w;
            }
    }
};
struct EpiResid {
    static constexpr bool PERM = true;
    const float* base_p; const float* base_s;
    float* xf; float* out;
    const float* mod_l; int gofs; float coef; int rowbase;
    bf16_t* xa; const float* atab; float* ssn;
    __device__ __forceinline__ void operator()(const f32x4 (&acc)[2][2][4][2], const Unit& u, int wr, int wc, int fr, int fq) const {
        const int rabs0 = rowbase + u.pm * BM; const int br = brow_of(rabs0);
        const float* base = rabs0 < 32768 ? base_p : base_s;
        const float* g = mod_l + (size_t)br * NMODC + gofs;
        const int row0 = rabs0 + wr * 64 + fr, col0 = u.pn * BM + wc * 32 + 8 * fq;
        float* xt = xf + ((size_t)((rabs0 >> 8) * 8 + u.pn) << 16) + ((wr * 4 + wc) * 64 + fq * 16 + fr) * 4;
        f32x4 gv[2][2], av[2][2];
#pragma unroll
        for (int bj = 0; bj < 2; ++bj)
#pragma unroll
            for (int n = 0; n < 2; ++n) { gv[bj][n] = *(const f32x4*)(g + col0 + bj * HALF + n * 4) * coef; av[bj][n] = xa ? *(const f32x4*)(atab + (size_t)br * DM + col0 + bj * HALF + n * 4) : (f32x4){0.f, 0.f, 0.f, 0.f}; }
#pragma unroll
        for (int aq = 0; aq < 4; ++aq) { const int ai = aq >> 1, mb = (aq & 1) * 2;
            f32x4 bs[2][2][2];
#pragma unroll
            for (int mi = 0; mi < 2; ++mi) { const size_t off = (size_t)(row0 + ai * HALF + (mb + mi) * 16) * DM + col0; const int pc = ((ai * 4 + mb + mi) * 2) * 2;
#pragma unroll
                for (int bj = 0; bj < 2; ++bj)
#pragma unroll
                    for (int n = 0; n < 2; ++n) bs[mi][bj][n] = base_p ? __builtin_nontemporal_load((const f32x4*)(base + off + bj * HALF + n * 4)) : *(const f32x4*)(xt + (pc + bj * 2 + n) * 2048); }
#pragma unroll
            for (int mi = 0; mi < 2; ++mi) { const int m = mb + mi; const size_t off = (size_t)(row0 + ai * HALF + m * 16) * DM + col0; const int pc = ((ai * 4 + m) * 2) * 2; float sq = 0.f;
#pragma unroll
                for (int bj = 0; bj < 2; ++bj) { const f32x4 x0 = bs[mi][bj][0] + gv[bj][0] * acc[ai][bj][m][0], x1 = bs[mi][bj][1] + gv[bj][1] * acc[ai][bj][m][1];
                    if (out) { __builtin_nontemporal_store(x0, (f32x4*)(out + off + bj * HALF)); __builtin_nontemporal_store(x1, (f32x4*)(out + off + bj * HALF + 4)); }
                    else { *(f32x4*)(xt + (pc + bj * 2) * 2048) = x0; *(f32x4*)(xt + (pc + bj * 2 + 1) * 2048) = x1; }
                    if (xa) { const f32x4 y0 = x0 * av[bj][0], y1 = x1 * av[bj][1]; u32x4 w; w.x = pk2(y0[0], y0[1]); w.y = pk2(y0[2], y0[3]); w.z = pk2(y1[0], y1[1]); w.w = pk2(y1[2], y1[3]);
                              *(u32x4*)((char*)xa + atile_off(row0 + ai * HALF + m * 16, col0 + bj * HALF, DM / 64)) = w;
                              sq += ((x0[0] * x0[0] + x0[1] * x0[1]) + (x0[2] * x0[2] + x0[3] * x0[3])) + ((x1[0] * x1[0] + x1[1] * x1[1]) + (x1[2] * x1[2] + x1[3] * x1[3])); } }
                if (xa) {
                    sq += __uint_as_float((unsigned)__builtin_amdgcn_ds_swizzle((int)__float_as_uint(sq), (16 << 10) | 0x1f)); sq = swap_sum(sq);
                    if (fq == 0) atomicAdd(ssn + row0 + ai * HALF + m * 16, sq); } }
        }
    }
};
struct EpiInProj {
    static constexpr bool PERM = true;
    bf16_t* Z; bf16_t* G; const float* bgate; int tmask; const float* ss; const float* bw; int rowbase;
    __device__ __forceinline__ void operator()(const f32x4 (&acc)[2][2][4][2], const Unit& u, int wr, int wc, int fr, int fq) const {
        const int row0 = u.pm * BM + wr * 64 + fr;
        const float* bwp = bw + (size_t)brow_of(rowbase + u.pm * BM) * BWL + u.pn * BM + wc * 32 + 8 * fq;
        const f32x4 bq00 = *(const f32x4*)bwp, bq01 = *(const f32x4*)(bwp + 4), bq10 = *(const f32x4*)(bwp + HALF), bq11 = *(const f32x4*)(bwp + HALF + 4);
        float rsv[2][4];
#pragma unroll
        for (int ai = 0; ai < 2; ++ai)
#pragma unroll
            for (int m = 0; m < 4; ++m) rsv[ai][m] = ss[rowbase + row0 + ai * HALF + m * 16];
#pragma unroll
        for (int ai = 0; ai < 2; ++ai)
#pragma unroll
            for (int m = 0; m < 4; ++m) rsv[ai][m] = __builtin_amdgcn_rsqf(rsv[ai][m] * (1.0f / DM) + EPS);
        if (u.pn < 32) {
            const int col0 = u.pn * BM + wc * 32 + 8 * fq;
            const bool ropet = (u.pn >= 8 && u.pn < 12) || (u.pn >= 14 && u.pn < 26);
            const bool rot = ropet && ((wc & 1) == 0) && (fq < 2);
            float rc0[4] = {0.f, 0.f, 0.f, 0.f}, rc1[4] = {0.f, 0.f, 0.f, 0.f};
            if (rot) {
#pragma unroll
                for (int e = 0; e < 4; ++e) { rc0[e] = fq ? ROPE_C0[4 + e] : ROPE_C0[e]; rc1[e] = fq ? ROPE_C1[4 + e] : ROPE_C1[e]; } }
#pragma unroll
            for (int ai = 0; ai < 2; ++ai)
#pragma unroll
                for (int m = 0; m < 4; ++m) { const int row = row0 + ai * HALF + m * 16; const float rs = rsv[ai][m];
                    float cc[4] = {1.f, 1.f, 1.f, 1.f}, sn[4] = {0.f, 0.f, 0.f, 0.f};
                    if (rot) { const int pos = row & tmask; const float ph = (float)(pos >> 7), pl = (float)(pos & 127);
#pragma unroll
                        for (int e = 0; e < 4; ++e) { const float c0 = rc0[e], c1 = rc1[e];
                            float rev = ph * c1 + pl * c0; rev = rev - __builtin_floorf(rev); cc[e] = __builtin_amdgcn_cosf(rev); sn[e] = __builtin_amdgcn_sinf(rev); } }
#pragma unroll
                    for (int bj = 0; bj < 2; ++bj) { f32x4 v0 = acc[ai][bj][m][0] * rs + (bj ? bq10 : bq00), v1 = acc[ai][bj][m][1] * rs + (bj ? bq11 : bq01);
                        if (u.pn == 2 || u.pn == 3 || u.pn == 8 || u.pn == 9 || (u.pn >= 14 && u.pn < 20)) { v0 *= C2; v1 *= C2; }
                        if (rot) {
#pragma unroll
                            for (int e = 0; e < 4; ++e) { const float x1 = v0[e], x2 = v1[e]; v0[e] = x1 * cc[e] - x2 * sn[e]; v1[e] = x2 * cc[e] + x1 * sn[e]; } }
                        u32x4 w; w.x = pk2(v0[0], v0[1]); w.y = pk2(v0[2], v0[3]); w.z = pk2(v1[0], v1[1]); w.w = pk2(v1[2], v1[3]);
                        *(u32x4*)(Z + zoff(row, col0 + bj * HALF)) = w; } }
        } else {
            const int col0 = (u.pn - 32) * BM + wc * 32 + 8 * fq;
            f32x4 bv[2][2];
#pragma unroll
            for (int bj = 0; bj < 2; ++bj)
#pragma unroll
                for (int n = 0; n < 2; ++n) bv[bj][n] = *(const f32x4*)(bgate + col0 + bj * HALF + 4 * n);
#pragma unroll
            for (int ai = 0; ai < 2; ++ai)
#pragma unroll
                for (int m = 0; m < 4; ++m) { const int row = row0 + ai * HALF + m * 16; const float rs = rsv[ai][m];
#pragma unroll
                    for (int bj = 0; bj < 2; ++bj) { const f32x4 v0 = acc[ai][bj][m][0] * rs + (bv[bj][0] + (bj ? bq10 : bq00)), v1 = acc[ai][bj][m][1] * rs + (bv[bj][1] + (bj ? bq11 : bq01));
                        u32x2 w; w.x = gq8x4(sigm_f(v0[0]), sigm_f(v0[1]), sigm_f(v0[2]), sigm_f(v0[3])); w.y = gq8x4(sigm_f(v1[0]), sigm_f(v1[1]), sigm_f(v1[2]), sigm_f(v1[3]));
                        *(u32x2*)((unsigned char*)G + ((size_t)(u.pm * 32 + (u.pn - 32)) << 16) + ai * 32768 + (m * 2 + bj) * 4096 + (wr * 4 + wc) * 512 + (fq * 16 + fr) * 8) = w; } }
        }
    }
};
struct EpiMerge {
    static constexpr bool PERM = true;
    const bf16_t* G; bf16_t* Mg;
    __device__ __forceinline__ void fold_load(u32x2 (&gw)[4][2], const Unit& u, int n, int wr, int wc, int fr, int fq) const {
        const int row0 = u.pm * BM + u.pz * HALF + wr * 64 + fr, col0 = u.pn * BM + wc * 32 + 8 * fq;
#pragma unroll
        for (int m = 0; m < 4; ++m)
#pragma unroll
            for (int bj = 0; bj < 2; ++bj) gw[m][bj] = *(const u32x2*)((const unsigned char*)G + ((size_t)(u.pm * 32 + n * 8 + u.pn) << 16) + u.pz * 32768 + (m * 2 + bj) * 4096 + (wr * 4 + wc) * 512 + (fq * 16 + fr) * 8);
    }
    __device__ __forceinline__ void fold_apply(f32x4 (&acc)[2][2][4][2], const u32x2 (&gw)[4][2], int n) const {
#pragma unroll
        for (int m = 0; m < 4; ++m)
#pragma unroll
            for (int bj = 0; bj < 2; ++bj) { const u32x2 g = gw[m][bj]; f32x4& v0 = acc[0][bj][m][0]; f32x4& v1 = acc[0][bj][m][1];
                const f32x4 g0 = (f32x4){(float)(g.x & 255u), (float)((g.x >> 8) & 255u), (float)((g.x >> 16) & 255u), (float)(g.x >> 24)} * (1.0f / 255.0f);
                const f32x4 g1 = (f32x4){(float)(g.y & 255u), (float)((g.y >> 8) & 255u), (float)((g.y >> 16) & 255u), (float)(g.y >> 24)} * (1.0f / 255.0f);
                if (n == 0) { acc[1][bj][m][0] = g0 * v0; acc[1][bj][m][1] = g1 * v1; }
                else { acc[1][bj][m][0] += g0 * v0; acc[1][bj][m][1] += g1 * v1; }
                v0 = (f32x4){0.f, 0.f, 0.f, 0.f}; v1 = (f32x4){0.f, 0.f, 0.f, 0.f}; }
    }
    __device__ __forceinline__ void fold(f32x4 (&acc)[2][2][4][2], const Unit& u, int n, int wr, int wc, int fr, int fq) const { u32x2 gw[4][2]; fold_load(gw, u, n, wr, wc, fr, fq); fold_apply(acc, gw, n); }
    __device__ __forceinline__ void operator()(const f32x4 (&acc)[2][2][4][2], const Unit& u, int wr, int wc, int fr, int fq) const {
        const int row0 = u.pm * BM + u.pz * HALF + wr * 64 + fr, col0 = u.pn * BM + wc * 32 + 8 * fq;
#pragma unroll
        for (int m = 0; m < 4; ++m)
#pragma unroll
            for (int bj = 0; bj < 2; ++bj) { const f32x4 v0 = acc[1][bj][m][0], v1 = acc[1][bj][m][1];
                u32x4 w; w.x = pk2(v0[0], v0[1]); w.y = pk2(v0[2], v0[3]); w.z = pk2(v1[0], v1[1]); w.w = pk2(v1[2], v1[3]);
                *(u32x4*)((char*)Mg + atile_off(row0 + m * 16, col0 + bj * HALF, DM / 64)) = w; }
    }
};
}

#define XB_TMO      128
#define XB_XCNT(j)  (256  + 64 * (j))
#define XB_XSUB(j)  (1280 + 64 * (j))
#define XB_XGEN(j)  (2304 + 64 * (j))
#define XB_TOP      3328
#define XB_TOPGEN   3392
#define XCD_BAR_WORDS 3456
#define XB_SPIN_CAP (1u << 24)
__device__ __forceinline__ unsigned xb_ld(unsigned* p)              { return __hip_atomic_load(p, __ATOMIC_RELAXED, __HIP_MEMORY_SCOPE_AGENT); }
__device__ __forceinline__ unsigned xb_add(unsigned* p, unsigned v) { return __hip_atomic_fetch_add(p, v, __ATOMIC_RELAXED, __HIP_MEMORY_SCOPE_AGENT); }
__device__ __forceinline__ unsigned xb_xcc_id() { return (unsigned)__builtin_amdgcn_s_getreg((3 << 11) | 20) & 0xFu; }
#define XB_SPIN(cond, bar) do { unsigned _sp = 0; while (cond) { __builtin_amdgcn_s_sleep(1); \
    if ((++_sp & 255u) == 0u) { if (xb_ld(&(bar)[XB_TMO])) break; if (_sp > XB_SPIN_CAP) { atomicAdd(&(bar)[XB_TMO], 1u); break; } } } } while (0)
struct XcdBarrier { unsigned* bar; unsigned x; volatile LAS unsigned* st; int wv; };
__device__ __forceinline__ XcdBarrier xcd_barrier_post(unsigned* bar, volatile LAS unsigned* st, int wv) {
    XcdBarrier b; b.bar = bar; b.x = xb_xcc_id(); b.st = st; b.wv = wv;
    if (opaque_tid(wv) == 0) (void)xb_add(&bar[XB_XCNT(b.x)], 1u);
    return b;
}
__device__ __forceinline__ void xcd_barrier_complete(unsigned* bar, unsigned x, unsigned& nloc, unsigned& nx) {
    const unsigned G = gridDim.x * gridDim.y * gridDim.z;
    unsigned sum, cnt, mine, sp = 0u;
    for (;;) {
        sum = 0u; cnt = 0u; mine = 0u;
#pragma unroll
        for (unsigned j = 0; j < 16; ++j) { const unsigned c = xb_ld(&bar[XB_XCNT(j)]); sum += c; cnt += (c > 0u) ? 1u : 0u; mine = (j == x) ? c : mine; }
        if (sum == G) break;
        __builtin_amdgcn_s_sleep(1);
        if ((++sp & 255u) == 0u) { if (xb_ld(&bar[XB_TMO])) break; if (sp > XB_SPIN_CAP) { atomicAdd(&bar[XB_TMO], 1u); break; } }
    }
    nloc = mine > 0u ? mine : 1u; nx = cnt > 0u ? cnt : 1u;
}
__device__ __forceinline__ void xcd_barrier(const XcdBarrier& b) {
    asm volatile("s_waitcnt vmcnt(0)" ::: "memory");
    __syncthreads();
    if (opaque_tid(b.wv) == 0) {
        unsigned* bar = b.bar;
        __builtin_amdgcn_s_waitcnt(0);
        unsigned nloc = b.st[0], nx = b.st[1];
        if (nloc == 0u) { xcd_barrier_complete(bar, b.x, nloc, nx); b.st[0] = nloc; b.st[1] = nx; }
        const unsigned old = xb_add(&bar[XB_XSUB(b.x)], 1u);
        const unsigned gen = old / nloc;
        if (old + 1u == (gen + 1u) * nloc) {
            __builtin_amdgcn_fence(__ATOMIC_RELEASE, "agent");
            asm volatile("s_waitcnt vmcnt(0)" ::: "memory");
            const unsigned og = xb_add(&bar[XB_TOP], 1u);
            const unsigned tg = og / nx;
            if (og + 1u == (tg + 1u) * nx) xb_add(&bar[XB_TOPGEN], 1u);
            else XB_SPIN(xb_ld(&bar[XB_TOPGEN]) == tg, bar);
            __builtin_amdgcn_fence(__ATOMIC_ACQUIRE, "agent");
            xb_add(&bar[XB_XGEN(b.x)], 1u);
            asm volatile("s_waitcnt vmcnt(0)" ::: "memory");
        } else {
            XB_SPIN(xb_ld(&bar[XB_XGEN(b.x)]) == gen, bar);
            __builtin_amdgcn_fence(__ATOMIC_ACQUIRE, "agent");
            asm volatile("s_waitcnt vmcnt(0)" ::: "memory");
        }
    }
    __syncthreads();
}

struct Args { const float* in[24]; float* out; unsigned char* ws; int ph_lo, ph_hi, li, pad; };
typedef const __attribute__((address_space(4))) Args KArgs;
__device__ __forceinline__ KArgs* kargs() { KArgs* p = (KArgs*)__builtin_amdgcn_kernarg_segment_ptr(); asm volatile("" : "+s"(p)); return p; }
enum { I_XP = 0, I_XS, I_CP, I_CS, I_WADA, I_BADA, I_GFF1, I_WFF1I, I_WFF1O, I_GMIX, I_WIN, I_BGATE, I_RELB, I_LQ1, I_LK1, I_LQ2, I_LK2, I_DLNG, I_WBR, I_WOUT, I_GFF2, I_WFF2I, I_WFF2O, I_GFIN };

__device__ __forceinline__ int srcmap(int kind, int v) {
    if (kind == 1) return ((v >> 7) & 1) * DFF + (v >> 8) * 128 + (v & 127);
    if (kind == 2) { const int o = v; const bool rp = (o >= 2048 && o < 3072) || (o >= 3584 && o < 6656);
        if (rp && (o & 63) < 16) { const int d = o & 15; const int pd = (d & 3) | ((d & 4) << 1) | ((d & 8) >> 1); return (o & ~15) + pd; }
        return o; }
    return v;
}
__device__ __forceinline__ void conv_tile(const float* src, int ldsrc, bf16_t* dst, int K, int v0, int k0, int kind, LAS float* tile, int tid) {
    __syncthreads();
#pragma unroll
    for (int i = 0; i < 8; ++i) { const int idx = tid + 512 * i, kk = idx >> 6, vv = idx & 63;
        tile[vv * 65 + kk] = src[(size_t)(k0 + kk) * ldsrc + srcmap(kind, v0 + vv)]; }
    __syncthreads();
    const int vv = tid >> 3, kc = tid & 7; const LAS float* s = tile + vv * 65 + kc * 8;
    u32x4 o; o.x = pk2(s[0], s[1]); o.y = pk2(s[2], s[3]); o.z = pk2(s[4], s[5]); o.w = pk2(s[6], s[7]);
    *(u32x4*)((char*)dst + pg8::wtile_off(v0 + vv, k0 + kc * 8, K >> 6)) = o;
}
__device__ __forceinline__ void fold_tile(const float* win_l, bf16_t* dst, int v0, int k0, LAS float* S  , LAS float* tc, LAS float* tsn, int tid) {
    __syncthreads();
    if (tid < 128) { const float x = (float)tid * (1.0f / 128.0f); tc[tid] = __builtin_amdgcn_cosf(x) * 0.08838834764831843f; tsn[tid] = __builtin_amdgcn_sinf(x) * 0.08838834764831843f; }
    const int g = v0 >> 8, isq = (v0 >> 7) & 1, cp0 = v0 & 127;
#pragma unroll
    for (int i = 0; i < 16; ++i) { const int idx = tid + 512 * i, kk = idx >> 7, c = idx & 127;
        S[kk * 129 + c] = win_l[(size_t)(k0 + kk) * 16384 + g * 128 + c]; }
    __syncthreads();
    const int vv = tid >> 3, kc = tid & 7, cp = cp0 + vv; const LAS float* tr = isq ? tsn : tc;
    float o[8] = {0.f, 0.f, 0.f, 0.f, 0.f, 0.f, 0.f, 0.f};
    for (int c = 0; c < 128; ++c) { const float w = tr[(c * cp) & 127];
#pragma unroll
        for (int j = 0; j < 8; ++j) o[j] += S[(kc * 8 + j) * 129 + c] * w; }
    u32x4 ov; ov.x = pk2(o[0], o[1]); ov.y = pk2(o[2], o[3]); ov.z = pk2(o[4], o[5]); ov.w = pk2(o[6], o[7]);
    *(u32x4*)(dst + (size_t)(v0 + vv) * DM + k0 + kc * 8) = ov;
}
__device__ __forceinline__ bf16_t fftm_bf1(float x) { return (bf16_t)(pk2(x, 0.f) & 0xffffu); }
__constant__ double ROPE_INV[8] = {1.0, 0.19392274474868576, 0.03760603093086393, 0.007292664737217109, 0.001414213562373095, 0.0002742481756762073, 5.318295896944988e-05, 1.031338537721246e-05};

__device__ __forceinline__ void ada_task(KArgs& a, int l, int jb, float* mod, LAS float* sc  , LAS float* red  , int tid) {
    __syncthreads();
#pragma unroll 1
    for (int i0 = 0; i0 < 6 * DM; i0 += 8 * 512) {
        float cv[8];
#pragma unroll
        for (int j = 0; j < 8; ++j) { const int i = i0 + j * 512 + tid, br = i >> 11, k = i & 2047; cv[j] = br < 2 ? a.in[I_CP][br * DM + k] : a.in[I_CS][(br - 2) * DM + k]; }
#pragma unroll
        for (int j = 0; j < 8; ++j) sc[i0 + j * 512 + tid] = cv[j] * pg8::sigm_f(cv[j]); }
    __syncthreads();
    const int jq = tid & 7, kp = tid >> 3, j0 = jb * 32;
    const float* w = a.in[I_WADA] + ((size_t)l * DM + kp * 32) * NMODC + j0 + 4 * jq;
    f32x4 acc[6];
#pragma unroll
    for (int br = 0; br < 6; ++br) acc[br] = (f32x4){0.f, 0.f, 0.f, 0.f};
    for (int k = 0; k < 32; ++k) { const f32x4 wv = *(const f32x4*)(w + (size_t)k * NMODC);
#pragma unroll
        for (int br = 0; br < 6; ++br) acc[br] += wv * sc[br * DM + kp * 32 + k]; }
#pragma unroll
    for (int br = 0; br < 6; ++br) *(LAS f32x4*)(red + (kp * 6 + br) * 32 + 4 * jq) = acc[br];
    __syncthreads();
    if (tid < 192) { const int br = tid >> 5, j = tid & 31; float s = a.in[I_BADA][(size_t)l * NMODC + j0 + j];
        for (int k = 0; k < 64; ++k) s += red[(k * 6 + br) * 32 + j];
        mod[((size_t)l * 6 + br) * NMODC + j0 + j] = s; }
}

constexpr int NT_ADA = 2 * 576, NT_FOLD = 0, NT_FFI = 5504, NT_FFO = 2752, NT_IN = 8192, NT_BR = 1024, NT_OUT = 1024;
constexpr int NT_LAYER = 2 * NT_FFI + 2 * NT_FFO + NT_IN + NT_BR + NT_OUT;
constexpr int NT_ROPE = 256, NT_DFT = 40, NT_ZSS = 192, NT_LAM = 1;
constexpr int NT_PRO = NT_ADA + NT_FOLD + 2 * NT_LAYER + NT_ROPE + NT_DFT + NT_ZSS + NT_LAM;

__device__ __forceinline__ void prologue_phase(KArgs& a, LAS unsigned char* lds, int wg, int nwg, int tid) {
    unsigned char* ws = a.ws;
    float* mod = (float*)(ws + WS_MOD);
    LAS float* L = (LAS float*)lds;
    for (int t = wg; t < NT_PRO; t += nwg) {
        int r = t;
        if (r < NT_ADA) { ada_task(a, r / 576, r % 576, mod, L, L + 6 * DM, tid); continue; } r -= NT_ADA;
        if (r < NT_FOLD) { const int l = r >> 9, q = r & 511; fold_tile(a.in[I_WIN] + (size_t)l * DM * 16384, (bf16_t*)(ws + WS_W + l * WLAYER + WO_IN), (q >> 5) * 64, (q & 31) * 64, L, L + 64 * 129, L + 64 * 129 + 128, tid); continue; } r -= NT_FOLD;
        if (r < 2 * NT_LAYER) { const int l = r / NT_LAYER; int q = r % NT_LAYER; unsigned char* wl = ws + WS_W + l * WLAYER;
            if (q < NT_FFI) { conv_tile(a.in[I_WFF1I] + (size_t)l * DM * 11008, 11008, (bf16_t*)(wl + WO_FF1I), DM, (q >> 5) * 64, (q & 31) * 64, 1, L, tid); continue; } q -= NT_FFI;
            if (q < NT_FFI) { conv_tile(a.in[I_WFF2I] + (size_t)l * DM * 11008, 11008, (bf16_t*)(wl + WO_FF2I), DM, (q >> 5) * 64, (q & 31) * 64, 1, L, tid); continue; } q -= NT_FFI;
            if (q < NT_FFO) { conv_tile(a.in[I_WFF1O] + (size_t)l * DFF * DM, DM, (bf16_t*)(wl + WO_FF1O), DFF, (q / 86) * 64, (q % 86) * 64, 0, L, tid); continue; } q -= NT_FFO;
            if (q < NT_FFO) { conv_tile(a.in[I_WFF2O] + (size_t)l * DFF * DM, DM, (bf16_t*)(wl + WO_FF2O), DFF, (q / 86) * 64, (q % 86) * 64, 0, L, tid); continue; } q -= NT_FFO;
            if (q < NT_IN) { conv_tile(a.in[I_WIN] + (size_t)l * DM * 16384, 16384, (bf16_t*)(wl + WO_IN), DM, (q >> 5) * 64, (q & 31) * 64, 2, L, tid); continue; } q -= NT_IN;
            if (q < NT_BR) { const int n = q >> 8, tt = q & 255; conv_tile(a.in[I_WBR] + (size_t)l * 4 * 512 * DM, DM, (bf16_t*)(wl + WO_BR), DM, (tt >> 3) * 64, n * 512 + (tt & 7) * 64, 0, L, tid); continue; } q -= NT_BR;
            conv_tile(a.in[I_WOUT] + (size_t)l * DM * DM, DM, (bf16_t*)(wl + WO_OUT), DM, (q >> 5) * 64, (q & 31) * 64, 0, L, tid); continue; }
        r -= 2 * NT_LAYER;
        if (r < NT_ROPE) { const int idx = r * 512 + tid, pos = idx >> 3, i = idx & 7; double rev = (double)pos * ROPE_INV[i] * 0.15915494309189535; rev -= floor(rev); const float fr = (float)rev;
            float* rp = (float*)(ws + WS_ROPE) + (size_t)idx * 2; rp[0] = __builtin_amdgcn_cosf(fr); rp[1] = __builtin_amdgcn_sinf(fr); continue; } r -= NT_ROPE;
        if (r < NT_DFT) {
            const bool big = r < 32; const int N = big ? 128 : 64, m = (big ? r : r - 32) * 512 + tid, k = m / N, t = m % N;
            const float x = (float)((k * t) & (N - 1)) / (float)N; const float c = __builtin_amdgcn_cosf(x), sn = __builtin_amdgcn_sinf(x);
            bf16_t* dp = (bf16_t*)(ws + WS_DFT + (big ? 0 : 98304)); dp[m] = fftm_bf1(c); dp[N * N + m] = fftm_bf1(sn); dp[2 * N * N + m] = fftm_bf1(-sn); continue; }
        r -= NT_DFT;
        if (r < NT_ZSS) { ((f32x4*)(ws + WS_SS))[r * 512 + tid] = (f32x4){0.f, 0.f, 0.f, 0.f}; continue; }
        if (tid < 2) { const int l = tid; float s1 = 0.f, s2 = 0.f;
            for (int k = 0; k < 64; ++k) { s1 += a.in[I_LQ1][l * 64 + k] * a.in[I_LK1][l * 64 + k]; s2 += a.in[I_LQ2][l * 64 + k] * a.in[I_LK2][l * 64 + k]; }
            const float li = l == 0 ? 0.2f : 0.35550906759096934f;
            ((float*)(ws + WS_LAM))[l] = __expf(s1) - __expf(s2) + li; }
    }
}

constexpr int NT_AT = 144, NT_BWT = 1200, NT_PRO2 = NT_AT + NT_BWT;
__device__ __forceinline__ void prologue2_phase(KArgs& a, LAS unsigned char* lds, int wg, int nwg, int tid) {
    unsigned char* ws = a.ws; const float* mod = (const float*)(ws + WS_MOD);
    LAS float* sh = (LAS float*)lds;
    const int lane = tid & 63, wid = tid >> 6;
    for (int t = wg; t < NT_PRO2; t += nwg) {
        if (t < NT_AT) { const int idx = t * 512 + tid, inst = idx / 12288, rem = idx % 12288, br = rem >> 11, col = rem & 2047, l = inst / 3, sl = inst % 3;
            const float g = a.in[sl == 0 ? I_GFF1 : (sl == 1 ? I_GMIX : I_GFF2)][l * DM + col];
            ((float*)(ws + WS_AT))[idx] = g * (1.0f + mod[((size_t)l * 6 + br) * NMODC + (3 * sl + 1) * DM + col]); continue; }
        const int R0 = (t - NT_AT) * 64, l = R0 / BWL, rr = R0 % BWL, sl = rr < 11008 ? 0 : (rr < 27392 ? 1 : 2), v0 = rr - (sl == 0 ? 0 : (sl == 1 ? 11008 : 27392));
        __syncthreads();
#pragma unroll 1
        for (int i0 = 0; i0 < 6 * DM; i0 += 8 * 512) {
            float mv[8];
#pragma unroll
            for (int j = 0; j < 8; ++j) { const int i = i0 + j * 512 + tid, br = i >> 11, k = i & 2047; mv[j] = mod[((size_t)l * 6 + br) * NMODC + 3 * sl * DM + k]; }
#pragma unroll
            for (int j = 0; j < 8; ++j) { const int i = i0 + j * 512 + tid, br = i >> 11, k = i & 2047; sh[(br * 8 + (k >> 8)) * 260 + (k & 255)] = mv[j]; } }
        __syncthreads();
        const bf16_t* W = (const bf16_t*)(ws + WS_W + (size_t)l * WLAYER + (sl == 0 ? WO_FF1I : (sl == 1 ? WO_IN : WO_FF2I)));
        const int v = v0 + wid * 8 + (lane >> 3), kq = lane & 7;
        float acc[6] = {0.f, 0.f, 0.f, 0.f, 0.f, 0.f};
        for (int i = 0; i < 32; ++i) { const u32x4 wv = *(const u32x4*)((const char*)W + pg8::wtile_off(v, kq * 256 + i * 8, DM / 64));
            const float w8[8] = {bf_lo(wv.x), bf_hi(wv.x), bf_lo(wv.y), bf_hi(wv.y), bf_lo(wv.z), bf_hi(wv.z), bf_lo(wv.w), bf_hi(wv.w)};
#pragma unroll
            for (int br = 0; br < 6; ++br) { const LAS float* sp = sh + (br * 8 + kq) * 260 + i * 8; const f32x4 s0 = *(const LAS f32x4*)sp, s1 = *(const LAS f32x4*)(sp + 4);
                acc[br] += (w8[0] * s0[0] + w8[1] * s0[1]) + (w8[2] * s0[2] + w8[3] * s0[3]) + (w8[4] * s1[0] + w8[5] * s1[1]) + (w8[6] * s1[2] + w8[7] * s1[3]); } }
#pragma unroll
        for (int br = 0; br < 6; ++br) { float x = acc[br];
            x += __uint_as_float((unsigned)__builtin_amdgcn_ds_swizzle((int)__float_as_uint(x), (1 << 10) | 0x1f));
            x += __uint_as_float((unsigned)__builtin_amdgcn_ds_swizzle((int)__float_as_uint(x), (2 << 10) | 0x1f));
            x += __uint_as_float((unsigned)__builtin_amdgcn_ds_swizzle((int)__float_as_uint(x), (4 << 10) | 0x1f));
            if (kq == 0) ((float*)(ws + WS_BW))[((size_t)l * 6 + br) * BWL + rr + wid * 8 + (lane >> 3)] = x; }
    }
}
__device__ __forceinline__ void norm_first_phase(KArgs& a, int wg, int nwg, int wave, int lane) {
    bf16_t* XA = (bf16_t*)(a.ws + WS_H); float* ss0 = (float*)(a.ws + WS_SS); const float* at = (const float*)(a.ws + WS_AT);
    const int stride = nwg * 8; int row = wg * 8 + wave; if (row >= NTOK) return;
    f32x4 v[8], vn[8], av[8]; int brc = -1;
    { const float* x = row < 32768 ? a.in[I_XP] + (size_t)row * DM : a.in[I_XS] + (size_t)(row - 32768) * DM;
#pragma unroll
      for (int i = 0; i < 8; ++i) v[i] = *(const f32x4*)(x + (i * 64 + lane) * 4); }
    for (; row < NTOK; row += stride) {
        const int rn = row + stride; const int br = brow_of(row);
        if (rn < NTOK) { const float* xn = rn < 32768 ? a.in[I_XP] + (size_t)rn * DM : a.in[I_XS] + (size_t)(rn - 32768) * DM;
#pragma unroll
            for (int i = 0; i < 8; ++i) vn[i] = *(const f32x4*)(xn + (i * 64 + lane) * 4); }
        if (br != brc) { brc = br;
#pragma unroll
            for (int i = 0; i < 8; ++i) av[i] = *(const f32x4*)(at + (size_t)br * DM + (i * 64 + lane) * 4); }
        float ss = 0.f;
#pragma unroll
        for (int i = 0; i < 8; ++i) ss += (v[i][0] * v[i][0] + v[i][1] * v[i][1]) + (v[i][2] * v[i][2] + v[i][3] * v[i][3]);
        ss = wave_sum(ss); if (lane == 0) ss0[row] = ss;
#pragma unroll
        for (int i = 0; i < 8; ++i) { const int col = (i * 64 + lane) * 4; const f32x4 o = v[i] * av[i]; u32x2 w; w.x = pk2(o[0], o[1]); w.y = pk2(o[2], o[3]);
            *(u32x2*)(XA + (size_t)row * DM + col) = w; }
#pragma unroll
        for (int i = 0; i < 8; ++i) v[i] = vn[i];
    }
}
__device__ __forceinline__ void final_phase(KArgs& a, int wg, int nwg, int wave, int lane) {
    const float* gw = a.in[I_GFIN];
    const int stride = nwg * 8; int row = wg * 8 + wave; if (row >= NTOK) return;
    f32x4 v[8], vn[8], gv[8];
#pragma unroll
    for (int i = 0; i < 8; ++i) { gv[i] = *(const f32x4*)(gw + (i * 64 + lane) * 4); v[i] = *(const f32x4*)(a.out + (size_t)row * DM + (i * 64 + lane) * 4); }
    for (; row < NTOK; row += stride) {
        const int rn = row + stride; float* x = a.out + (size_t)row * DM;
        if (rn < NTOK) {
#pragma unroll
            for (int i = 0; i < 8; ++i) vn[i] = *(const f32x4*)(a.out + (size_t)rn * DM + (i * 64 + lane) * 4); }
        float ss = 0.f;
#pragma unroll
        for (int i = 0; i < 8; ++i) ss += (v[i][0] * v[i][0] + v[i][1] * v[i][1]) + (v[i][2] * v[i][2] + v[i][3] * v[i][3]);
        ss = wave_sum(ss); const float rstd = __builtin_amdgcn_rsqf(ss * (1.0f / DM) + EPS);
#pragma unroll
        for (int i = 0; i < 8; ++i) { const int col = (i * 64 + lane) * 4; *(f32x4*)(x + col) = v[i] * rstd * gv[i]; }
#pragma unroll
        for (int i = 0; i < 8; ++i) v[i] = vn[i];
    }
}

namespace dattn {
constexpr int KP = 144, VP = 320, KT = 64 * KP, VT = 64 * VP;
constexpr int KS0 = 0, KS1 = KT, VS0 = 2 * KT, VS1 = 2 * KT + VT;
#define DBAR() asm volatile("s_waitcnt lgkmcnt(0)\n\ts_barrier" ::: "memory")
__device__ __forceinline__ bf16x8 trA(LAS unsigned char* p) {
    const s16x4 lo = __builtin_amdgcn_ds_read_tr16_b64_v4i16((LAS s16x4*)p), hi = __builtin_amdgcn_ds_read_tr16_b64_v4i16((LAS s16x4*)(p + 8 * VP));
    return (bf16x8){lo[0], lo[1], lo[2], lo[3], hi[0], hi[1], hi[2], hi[3]};
}
__device__ __forceinline__ void qk(f32x16& p0, f32x16& p1, LAS unsigned char* ks, const bf16x8 (&qf)[4], int r32, int hi) {
    p0 = (f32x16){0.f, 0.f, 0.f, 0.f, 0.f, 0.f, 0.f, 0.f, 0.f, 0.f, 0.f, 0.f, 0.f, 0.f, 0.f, 0.f}; p1 = p0;
#pragma unroll
    for (int s = 0; s < 4; ++s) { const bf16x8 k0f = *(const LAS bf16x8*)(ks + r32 * KP + (16 * s + 8 * hi) * 2), k1f = *(const LAS bf16x8*)(ks + (32 + r32) * KP + (16 * s + 8 * hi) * 2);
        p0 = __builtin_amdgcn_mfma_f32_32x32x16_bf16(k0f, qf[s], p0, 0, 0, 0); p1 = __builtin_amdgcn_mfma_f32_32x32x16_bf16(k1f, qf[s], p1, 0, 0, 0); }
}
__device__ __forceinline__ float softmax(f32x16& p0, f32x16& p1, float& m, float& l, bf16x8 (&pb)[4]) {
    float mx = fmaxf(p0[0], p1[0]);
#pragma unroll
    for (int r = 1; r < 16; ++r) mx = fmaxf(mx, fmaxf(p0[r], p1[r]));
    mx = swap_max(mx);
    const float mn = fmaxf(m, mx * C2), alpha = __builtin_amdgcn_exp2f(m - mn); m = mn;
    float ps = 0.f;
#pragma unroll
    for (int r = 0; r < 16; ++r) { p0[r] = __builtin_amdgcn_exp2f(fmaf(p0[r], C2, -mn)); p1[r] = __builtin_amdgcn_exp2f(fmaf(p1[r], C2, -mn)); ps += p0[r] + p1[r]; }
    ps = swap_sum(ps); l = l * alpha + ps;
#pragma unroll
    for (int ks = 0; ks < 4; ++ks) { u32x4 w;
        if (ks < 2) { w.x = pk2(p0[8 * (ks & 1) + 0], p0[8 * (ks & 1) + 1]); w.y = pk2(p0[8 * (ks & 1) + 2], p0[8 * (ks & 1) + 3]); w.z = pk2(p0[8 * (ks & 1) + 4], p0[8 * (ks & 1) + 5]); w.w = pk2(p0[8 * (ks & 1) + 6], p0[8 * (ks & 1) + 7]); }
        else        { w.x = pk2(p1[8 * (ks & 1) + 0], p1[8 * (ks & 1) + 1]); w.y = pk2(p1[8 * (ks & 1) + 2], p1[8 * (ks & 1) + 3]); w.z = pk2(p1[8 * (ks & 1) + 4], p1[8 * (ks & 1) + 5]); w.w = pk2(p1[8 * (ks & 1) + 6], p1[8 * (ks & 1) + 7]); }
        pb[ks] = __builtin_bit_cast(bf16x8, w); }
    return alpha;
}
__device__ __forceinline__ void pv(f32x16 (&o)[4], LAS unsigned char* vs, int vbase, const bf16x8 (&pb)[4]) {
#pragma unroll
    for (int ks = 0; ks < 4; ++ks)
#pragma unroll
        for (int db = 0; db < 4; ++db) { const bf16x8 va = trA(vs + vbase + ks * 16 * VP + db * 64); o[db] = __builtin_amdgcn_mfma_f32_32x32x16_bf16(va, pb[ks], o[db], 0, 0, 0); }
}
template <int MODE>
__device__ __forceinline__ void unit(const bf16_t* Zs, int T, int h, int qb, const float* lamp, int layer, const float* lng, bf16_t* Ys, u32x4* oscr, LAS unsigned char* lds, const int wv) {
    const int tid = opaque_tid(wv), lane = tid & 63, wid = __builtin_amdgcn_readfirstlane(tid >> 6), r32 = lane & 31, hi = lane >> 5;
    const int qrow = qb * 256 + wid * 32 + r32, NT = T >> 6;
    const int ksr = tid >> 3, ksc = tid & 7, vr0 = tid >> 4, vc0 = tid & 15;
    const int vbase = (4 * hi + ((lane >> 2) & 3)) * VP + (16 * ((lane >> 4) & 1) + 4 * (lane & 3)) * 2;
    const int kw = ksr * KP + ksc * 16, vw = vr0 * VP + vc0 * 16;
#pragma unroll
    for (int c = 0; c < 2; ++c) {
        const bf16_t* Qp = Zs + zoff(qrow, 2048 + h * 128 + c * 64) + hi * 8;
        bf16x8 qf[4];
#pragma unroll
        for (int s = 0; s < 4; ++s) qf[s] = *(const bf16x8*)(Qp + 16 * s);
        LAS unsigned char* const qlds = lds + 59392 + wid * 4096 + lane * 16;
        const bf16_t* Kg = Zs + zoff(ksr, 2560 + h * 128 + c * 64) + ksc * 8;
        const bf16_t* Vg = Zs + zoff(vr0, 3072 + h * 128 + vc0 * 8);
        f32x16 o[4];
#pragma unroll
        for (int d = 0; d < 4; ++d) o[d] = (f32x16){0.f, 0.f, 0.f, 0.f, 0.f, 0.f, 0.f, 0.f, 0.f, 0.f, 0.f, 0.f, 0.f, 0.f, 0.f, 0.f};
        float m = -1e30f, l = 0.f;
        __syncthreads();
#pragma unroll
        for (int s = 0; s < 4; ++s) *(LAS bf16x8*)(qlds + s * 1024) = qf[s];
        { const bf16x8 k0 = *(const bf16x8*)Kg, k1 = *(const bf16x8*)(Kg + (size_t)64 * ZR), v0 = *(const bf16x8*)Vg, v1 = *(const bf16x8*)(Vg + (size_t)32 * ZR);
          *(LAS bf16x8*)(lds + KS0 + kw) = k0; *(LAS bf16x8*)(lds + KS1 + kw) = k1; *(LAS bf16x8*)(lds + VS0 + vw) = v0; *(LAS bf16x8*)(lds + VS0 + vw + 32 * VP) = v1; }
        __syncthreads();
        constexpr float THR = 8.0f;
        f32x16 pA0, pA1, pB0, pB1, negm; u32x4 pbA[4], pbB[4]; float mref = 0.f;
        negm = (f32x16){0.f, 0.f, 0.f, 0.f, 0.f, 0.f, 0.f, 0.f, 0.f, 0.f, 0.f, 0.f, 0.f, 0.f, 0.f, 0.f};
        qk(pA0, pA1, lds + KS0, qf, r32, hi);
        __syncthreads();
#define KFRAG(SL, G) (*(const LAS bf16x8*)((SL) + ((((G) & 1) ? 32 : 0) + r32) * KP + (16 * ((G) >> 1) + 8 * hi) * 2))
#define MX3(a, b, c) __builtin_fmaxf(__builtin_fmaxf((a), (b)), (c))
#define DSTEP(C0, C1, N0, N1, PBR, PBW, J) do { const int j_ = (J); const int jk_ = (j_ + 2 < NT) ? j_ + 2 : NT - 1; \
            LAS unsigned char* ksl_ = lds + (((j_ + 1) & 1) ? KS1 : KS0); LAS unsigned char* vsl_ = lds + (((j_ - 1) & 1) ? VS1 : VS0) + vbase; \
            bf16x8 kf_[8], va_[16], qs_[4]; float ps_ = 0.f; \
            const bf16x8 kreg_ = *(const bf16x8*)(Kg + (size_t)jk_ * 64 * ZR);        \
            const bf16x8 v0_ = *(const bf16x8*)(Vg + (size_t)j_ * 64 * ZR), v1_ = *(const bf16x8*)(Vg + (size_t)j_ * 64 * ZR + (size_t)32 * ZR); \
            kf_[0] = KFRAG(ksl_, 0); kf_[1] = KFRAG(ksl_, 1); qs_[0] = *(const LAS bf16x8*)(qlds); \
            __builtin_amdgcn_sched_barrier(0); \
            _Pragma("unroll") for (int g_ = 0; g_ < 8; ++g_) { \
                if (g_ + 2 < 8) kf_[g_ + 2] = KFRAG(ksl_, g_ + 2); \
                if (!(g_ & 1) && g_ + 2 < 8) qs_[(g_ >> 1) + 1] = *(const LAS bf16x8*)(qlds + ((g_ >> 1) + 1) * 1024); \
                if (g_ >= 6) va_[g_ - 6] = trA(vsl_ + (g_ - 6) * 64); \
                if (g_ == 0) N0 = __builtin_amdgcn_mfma_f32_32x32x16_bf16(kf_[0], qs_[0], negm, 0, 0, 0); else if (g_ == 1) N1 = __builtin_amdgcn_mfma_f32_32x32x16_bf16(kf_[1], qs_[0], negm, 0, 0, 0); \
                else if (g_ & 1) N1 = __builtin_amdgcn_mfma_f32_32x32x16_bf16(kf_[g_], qs_[g_ >> 1], N1, 0, 0, 0); else N0 = __builtin_amdgcn_mfma_f32_32x32x16_bf16(kf_[g_], qs_[g_ >> 1], N0, 0, 0, 0); \
                { const float e0_ = __builtin_amdgcn_exp2f(C0[2 * g_]), e1_ = __builtin_amdgcn_exp2f(C0[2 * g_ + 1]); ps_ += e0_; ps_ += e1_; PBW[g_ >> 2][g_ & 3] = pk2(e0_, e1_); } \
                __builtin_amdgcn_sched_barrier(0); } \
            float tn_ = -1e30f, ep_ = 0.f; \
            __builtin_amdgcn_sched_barrier(0); \
            _Pragma("unroll") for (int i_ = 0; i_ < 16; ++i_) { \
                if (i_ + 2 < 16) va_[i_ + 2] = trA(vsl_ + ((i_ + 2) >> 2) * 16 * VP + ((i_ + 2) & 3) * 64); \
                o[i_ & 3] = __builtin_amdgcn_mfma_f32_32x32x16_bf16(va_[i_], __builtin_bit_cast(bf16x8, PBR[i_ >> 2]), o[i_ & 3], 0, 0, 0); \
                { const float e_ = __builtin_amdgcn_exp2f(C1[i_]); ps_ += e_; if (i_ & 1) PBW[2 + (i_ >> 3)][(i_ >> 1) & 3] = pk2(ep_, e_); else ep_ = e_; } \
                tn_ = MX3(tn_, N0[i_], N1[i_]); asm volatile("" : "+v"(tn_)); \
                __builtin_amdgcn_sched_barrier(0); } \
            asm volatile("" : "+v"(PBW[0]), "+v"(PBW[1]), "+v"(PBW[2]), "+v"(PBW[3])); \
            ps_ = swap_sum(ps_); l += ps_; \
            if (__any(fcarry < 1.0f)) { _Pragma("unroll") for (int d = 0; d < 4; ++d) o[d] *= fcarry; } \
            fcarry = 1.0f; \
            { const float mx_ = swap_max(tn_); \
              if ((j_ + 1 < NT) && __any(mx_ > THR)) { const float d_ = fmaxf(mx_, 0.f); fcarry = __builtin_amdgcn_exp2f(-d_); mref += d_; l *= fcarry; \
                  _Pragma("unroll") for (int r = 0; r < 16; ++r) { N0[r] -= d_; N1[r] -= d_; negm[r] = -mref; } } } \
            *(LAS bf16x8*)(lds + ((j_ & 1) ? KS1 : KS0) + kw) = kreg_; \
            *(LAS bf16x8*)(lds + ((j_ & 1) ? VS1 : VS0) + vw) = v0_; *(LAS bf16x8*)(lds + ((j_ & 1) ? VS1 : VS0) + vw + 32 * VP) = v1_; \
            DBAR(); } while (0)
        float fcarry = 1.0f;
        {
            const bf16x8 kreg_ = *(const bf16x8*)(Kg + (size_t)(2 < NT ? 2 : NT - 1) * 64 * ZR);
            float mx = fmaxf(pA0[0], pA1[0]);
#pragma unroll
            for (int r = 1; r < 16; ++r) mx = fmaxf(mx, fmaxf(pA0[r], pA1[r]));
            mx = swap_max(mx); mref = mx;
#pragma unroll
            for (int r = 0; r < 16; ++r) negm[r] = -mref;
            float ps = 0.f;
#pragma unroll
            for (int r = 0; r < 16; ++r) { pA0[r] = __builtin_amdgcn_exp2f(pA0[r] - mx); pA1[r] = __builtin_amdgcn_exp2f(pA1[r] - mx); ps += pA0[r] + pA1[r]; }
            l = swap_sum(ps);
#pragma unroll
            for (int ks = 0; ks < 4; ++ks) { u32x4 w;
                if (ks < 2) { w.x = pk2(pA0[8 * (ks & 1) + 0], pA0[8 * (ks & 1) + 1]); w.y = pk2(pA0[8 * (ks & 1) + 2], pA0[8 * (ks & 1) + 3]); w.z = pk2(pA0[8 * (ks & 1) + 4], pA0[8 * (ks & 1) + 5]); w.w = pk2(pA0[8 * (ks & 1) + 6], pA0[8 * (ks & 1) + 7]); }
                else        { w.x = pk2(pA1[8 * (ks & 1) + 0], pA1[8 * (ks & 1) + 1]); w.y = pk2(pA1[8 * (ks & 1) + 2], pA1[8 * (ks & 1) + 3]); w.z = pk2(pA1[8 * (ks & 1) + 4], pA1[8 * (ks & 1) + 5]); w.w = pk2(pA1[8 * (ks & 1) + 6], pA1[8 * (ks & 1) + 7]); }
                pbA[ks] = w; }
            { LAS unsigned char* ksl_ = lds + KS1;
#pragma unroll
              for (int g = 0; g < 8; ++g) { const bf16x8 kf = KFRAG(ksl_, g);
                if (g == 0) pB0 = __builtin_amdgcn_mfma_f32_32x32x16_bf16(kf, qf[0], negm, 0, 0, 0); else if (g == 1) pB1 = __builtin_amdgcn_mfma_f32_32x32x16_bf16(kf, qf[0], negm, 0, 0, 0);
                else if (g & 1) pB1 = __builtin_amdgcn_mfma_f32_32x32x16_bf16(kf, qf[g >> 1], pB1, 0, 0, 0); else pB0 = __builtin_amdgcn_mfma_f32_32x32x16_bf16(kf, qf[g >> 1], pB0, 0, 0, 0); } }
            { float t1 = fmaxf(pB0[0], pB1[0]);
#pragma unroll
              for (int r = 1; r < 16; ++r) t1 = fmaxf(t1, fmaxf(pB0[r], pB1[r]));
              t1 = swap_max(t1);
              if ((1 < NT) && __any(t1 > THR)) { const float d_ = fmaxf(t1, 0.f); fcarry = __builtin_amdgcn_exp2f(-d_); mref += d_; l *= fcarry;
#pragma unroll
                  for (int r = 0; r < 16; ++r) { pB0[r] -= d_; pB1[r] -= d_; negm[r] = -mref; } } }
            *(LAS bf16x8*)(lds + KS0 + kw) = kreg_;
            DBAR(); }
        for (int j = 1; j + 1 < NT; j += 2) { DSTEP(pB0, pB1, pA0, pA1, pbA, pbB, j); DSTEP(pA0, pA1, pB0, pB1, pbB, pbA, j + 1); }
        DSTEP(pB0, pB1, pA0, pA1, pbA, pbB, NT - 1);
#undef DSTEP
#undef KFRAG
#undef MX3
        { bf16x8 pbl[4];
#pragma unroll
          for (int q = 0; q < 4; ++q) pbl[q] = __builtin_bit_cast(bf16x8, pbB[q]);
          pv(o, lds + (((NT - 1) & 1) ? VS1 : VS0), vbase, pbl); }
        const float inv = __builtin_amdgcn_rcpf(l);
        const int tidE = opaque_tid(wv), hiE = (tidE >> 5) & 1, qrowE = qb * 256 + (tidE >> 6) * 32 + (tidE & 31);
        if (c == 0) {
#pragma unroll
            for (int d = 0; d < 4; ++d)
#pragma unroll
                for (int i = 0; i < 2; ++i) { u32x4 w; w.x = pk2(o[d][8 * i] * inv, o[d][8 * i + 1] * inv); w.y = pk2(o[d][8 * i + 2] * inv, o[d][8 * i + 3] * inv); w.z = pk2(o[d][8 * i + 4] * inv, o[d][8 * i + 5] * inv); w.w = pk2(o[d][8 * i + 6] * inv, o[d][8 * i + 7] * inv);
                    oscr[(size_t)tidE * 8 + d * 2 + i] = w; }
        } else {
            float ss = 0.f; int ly = layer; asm volatile("" : "+s"(ly));
            const float lamv = lamp[ly], postv = ly == 0 ? 0.8f : 0.64449093240903066f;
#pragma unroll
            for (int d = 0; d < 4; ++d) {
#pragma unroll
                for (int i = 0; i < 2; ++i) { const u32x4 w = __builtin_nontemporal_load(oscr + (size_t)tidE * 8 + d * 2 + i); const float il = inv * lamv;
                    o[d][8 * i + 0] = bf_lo(w.x) - o[d][8 * i + 0] * il; o[d][8 * i + 1] = bf_hi(w.x) - o[d][8 * i + 1] * il; o[d][8 * i + 2] = bf_lo(w.y) - o[d][8 * i + 2] * il; o[d][8 * i + 3] = bf_hi(w.y) - o[d][8 * i + 3] * il;
                    o[d][8 * i + 4] = bf_lo(w.z) - o[d][8 * i + 4] * il; o[d][8 * i + 5] = bf_hi(w.z) - o[d][8 * i + 5] * il; o[d][8 * i + 6] = bf_lo(w.w) - o[d][8 * i + 6] * il; o[d][8 * i + 7] = bf_hi(w.w) - o[d][8 * i + 7] * il; }
#pragma unroll
                for (int r = 0; r < 16; ++r) ss += o[d][r] * o[d][r]; }
            ss = swap_sum(ss);
            const float rn = __builtin_amdgcn_rsqf(ss * (1.0f / 128.0f) + EPS) * postv;
            bf16_t* yp = Ys + (size_t)qrowE * DM + 1024 + h * 128;
            f32x4 gl[16];
#pragma unroll
            for (int i = 0; i < 16; ++i) gl[i] = *(const f32x4*)(lng + (i >> 2) * 32 + 8 * (i & 3) + 4 * hiE);
            __builtin_amdgcn_sched_barrier(0);
#pragma unroll
            for (int d = 0; d < 4; ++d)
#pragma unroll
                for (int a4 = 0; a4 < 4; ++a4) { const int d0 = d * 32 + 8 * a4 + 4 * hiE; const f32x4 g = gl[d * 4 + a4];
                    u32x2 w; w.x = pk2(o[d][4 * a4] * rn * g[0], o[d][4 * a4 + 1] * rn * g[1]); w.y = pk2(o[d][4 * a4 + 2] * rn * g[2], o[d][4 * a4 + 3] * rn * g[3]);
                    *(u32x2*)((char*)Ys + pg8::atile_off(qrowE, 1024 + h * 128 + d * 32 + 8 * a4, DM / 64) + 8 * hiE) = w; (void)yp; (void)d0; }
        }
    }
}
#undef DBAR
}

namespace wattn {
constexpr int VP = 192, VBUF = 32 * VP, KP = 144, KBUF = 32 * KP, WBUF = VBUF + KBUF;
constexpr float THR = 8.0f;
struct KV { bf16x8 kr[4], vr[4]; };
struct Geom { int kind, a0, a1, B, TS, KS, nt, QB, qsh, qcol, kcol, vcol; };
__device__ __forceinline__ unsigned kv_off0(const Geom& G, int lane) { return (unsigned)(zoff(G.B + (lane >> 3) * G.KS, G.kcol) + 8 * (lane & 7)) * 2u; }
__device__ __forceinline__ void load_kv(KV& t, const char* Zc, unsigned off, unsigned rsb, int dv) {
#pragma unroll
    for (int i = 0; i < 4; ++i) { const char* pk = Zc + (off + (unsigned)i * rsb); t.kr[i] = *(const bf16x8*)pk; t.vr[i] = *(const bf16x8*)(pk + dv); }
}
__device__ __forceinline__ void load_q(bf16x8 (&qf)[4], const char* Zc, const Geom& G, int lane) {
    const int r32 = lane & 31, hi = lane >> 5; const int qtok = G.QB + (G.qsh < 0 ? (r32 >> 4) * 64 + (r32 & 15) : (r32 << G.qsh));
    const char* Qp = Zc + (unsigned)(zoff(qtok, G.qcol) + 8 * hi) * 2u;
#pragma unroll
    for (int s = 0; s < 4; ++s) qf[s] = *(const bf16x8*)(Qp + 32 * s);
}
__device__ __forceinline__ void put_k(const KV& t, LAS unsigned char* kb, int lane) {
#pragma unroll
    for (int i = 0; i < 4; ++i) *(LAS bf16x8*)(kb + ((lane >> 3) + 8 * i) * KP + (lane & 7) * 16) = t.kr[i];
}
__device__ __forceinline__ f32x16 qk4(LAS unsigned char* kb, const bf16x8 (&qf)[4], int lane) {
    LAS unsigned char* p = kb + (lane & 31) * KP + (lane >> 5) * 16;
    bf16x8 kf[4];
#pragma unroll
    for (int st = 0; st < 4; ++st) kf[st] = *(const LAS bf16x8*)(p + st * 32);
    __builtin_amdgcn_sched_barrier(0);
    f32x16 s = __builtin_amdgcn_mfma_f32_32x32x16_bf16(kf[0], qf[0], (f32x16){0.f, 0.f, 0.f, 0.f, 0.f, 0.f, 0.f, 0.f, 0.f, 0.f, 0.f, 0.f, 0.f, 0.f, 0.f, 0.f}, 0, 0, 0);
#pragma unroll
    for (int st = 1; st < 4; ++st) s = __builtin_amdgcn_mfma_f32_32x32x16_bf16(kf[st], qf[st], s, 0, 0, 0);
    return s;
}
__device__ __forceinline__ void put_v(const KV& t, LAS unsigned char* vb, int lane) {
#pragma unroll
    for (int i = 0; i < 4; ++i) *(LAS bf16x8*)(vb + ((lane >> 3) + 8 * i) * VP + (lane & 7) * 16) = t.vr[i];
}
__device__ __forceinline__ void pv2(f32x16& o0, f32x16& o1, LAS unsigned char* vb, const u32x4 (&pb)[2], int lane) {
    const int hi = lane >> 5; LAS unsigned char* p0 = vb + (4 * hi + ((lane >> 2) & 3)) * VP + (16 * ((lane >> 4) & 1) + 4 * (lane & 3)) * 2;
    bf16x8 va[4];
#pragma unroll
    for (int i = 0; i < 4; ++i) { LAS unsigned char* p = p0 + (i >> 1) * 16 * VP + (i & 1) * 64;
        const s16x4 lo = __builtin_amdgcn_ds_read_tr16_b64_v4i16((LAS s16x4*)p), hh = __builtin_amdgcn_ds_read_tr16_b64_v4i16((LAS s16x4*)(p + 8 * VP));
        va[i] = (bf16x8){lo[0], lo[1], lo[2], lo[3], hh[0], hh[1], hh[2], hh[3]}; }
    __builtin_amdgcn_sched_barrier(0);
#pragma unroll
    for (int ks = 0; ks < 2; ++ks) { o0 = __builtin_amdgcn_mfma_f32_32x32x16_bf16(va[2 * ks], __builtin_bit_cast(bf16x8, pb[ks]), o0, 0, 0, 0); o1 = __builtin_amdgcn_mfma_f32_32x32x16_bf16(va[2 * ks + 1], __builtin_bit_cast(bf16x8, pb[ks]), o1, 0, 0, 0); }
}
template <class FixS>
__device__ __forceinline__ void run(f32x16& o0, f32x16& o1, float& l, float& mref, bf16x8 (&qf)[4], KV& kvA, KV& kvB, const char* Zc, const Geom& G, const Geom& N, const bool hasN, const FixS& fixs, LAS unsigned char* wbuf, int lane) {
    const f32x16 zero = (f32x16){0.f, 0.f, 0.f, 0.f, 0.f, 0.f, 0.f, 0.f, 0.f, 0.f, 0.f, 0.f, 0.f, 0.f, 0.f, 0.f};
    LAS unsigned char* const vbuf = wbuf; LAS unsigned char* const kbuf = wbuf + VBUF;
    const int nt = G.nt; const unsigned tsb = (unsigned)G.TS * (ZR * 2), rsb = (unsigned)G.KS * (8 * ZR * 2); const int dv = ((G.vcol - G.kcol) >> 6) * (GT * ZR * 2);
    unsigned off2 = kv_off0(G, lane) + 2u * tsb;
    o0 = zero; o1 = zero; l = 0.f;
    f32x16 sA, sB; u32x4 pbA[2], pbB[2]; float fcarry = 1.0f;
    asm volatile("" ::: "memory"); put_k(kvA, kbuf, lane); asm volatile("" ::: "memory");
    sA = qk4(kbuf, qf, lane); fixs(0, sA);
    { float mx = sA[0];
#pragma unroll
      for (int r = 1; r < 16; ++r) mx = fmaxf(mx, sA[r]);
      mx = swap_max(mx); mx = (mx > -1e30f) ? mx : 0.f; mref = mx;
#pragma unroll
      for (int r = 0; r < 16; ++r) sA[r] -= mx; }
#define WSTEP(SC, SN, PBR, PBW, KC, KN, TT, KCI) do { const int t_ = (TT); const bool nx_ = (t_ + 1 < nt); \
        asm volatile("" ::: "memory"); \
        if (nx_) { put_k(KN, kbuf, lane); asm volatile("" ::: "memory"); SN = qk4(kbuf, qf, lane); } \
        if (t_ >= 1) pv2(o0, o1, vbuf, PBR, lane); \
        asm volatile("" ::: "memory"); put_v(KC, vbuf, lane); asm volatile("" ::: "memory"); \
        if (t_ + 2 < nt) { load_kv(KC, Zc, off2, rsb, dv); off2 += tsb; } \
        else if (hasN) load_kv(KC, Zc, kv_off0(N, lane) + (KCI) * ((unsigned)N.TS * (ZR * 2)), (unsigned)N.KS * (8 * ZR * 2), ((N.vcol - N.kcol) >> 6) * (GT * ZR * 2));     \
        if (!nx_ && hasN) load_q(qf, Zc, N, lane); \
        float ps_ = 0.f; \
        _Pragma("unroll") for (int r = 0; r < 16; r += 2) { const float e0_ = __builtin_amdgcn_exp2f(SC[r]), e1_ = __builtin_amdgcn_exp2f(SC[r + 1]); ps_ += e0_; ps_ += e1_; PBW[r >> 3][(r >> 1) & 3] = pk2(e0_, e1_); } \
        ps_ = swap_sum(ps_); l += ps_; \
        if (__any(fcarry < 1.0f)) { o0 *= fcarry; o1 *= fcarry; } \
        fcarry = 1.0f; \
        if (nx_) { _Pragma("unroll") for (int r = 0; r < 16; ++r) SN[r] -= mref; \
            fixs(t_ + 1, SN); float tn_ = SN[0]; \
            _Pragma("unroll") for (int r = 1; r < 16; ++r) tn_ = fmaxf(tn_, SN[r]); \
            tn_ = swap_max(tn_); \
            if (__any(tn_ > THR)) { const float d_ = fmaxf(tn_, 0.f); fcarry = __builtin_amdgcn_exp2f(-d_); mref += d_; l *= fcarry; \
                _Pragma("unroll") for (int r = 0; r < 16; ++r) SN[r] -= d_; } } \
    } while (0)
    int t = 0;
    for (; t + 1 < nt; t += 2) { WSTEP(sA, sB, pbB, pbA, kvA, kvB, t, 0); WSTEP(sB, sA, pbA, pbB, kvB, kvA, t + 1, 1); }
    if (t < nt) { WSTEP(sA, sB, pbB, pbA, kvA, kvB, t, 0); asm volatile("" ::: "memory"); pv2(o0, o1, vbuf, pbA, lane); }
    else { asm volatile("" ::: "memory"); pv2(o0, o1, vbuf, pbB, lane); }
#undef WSTEP
    asm volatile("" ::: "memory");
}

__device__ __forceinline__ Geom nat_geom(int T, int qb, int h) {
    const int tok0 = qb * 32, seqrow0 = tok0 & ~(T - 1), bl = (tok0 & (T - 1)) >> 5, r = 2 * (bl >> 2), c0 = 16 * (bl & 3), rows = T >> 6;
    const int rsu = min(max(r - 4, 0), rows - 8), nt = min(max(r - 3, 0), rows - 8) + 8 - rsu, cst = min(min(max(c0 - 8, 0), 48), 32);
    return Geom{0, qb, 0, seqrow0 + rsu * 64 + cst, 64, 1, nt, seqrow0 + r * 64 + c0, -1, 512 + h * 64, 1024 + h * 64, 1536 + h * 64};
}
__device__ __forceinline__ Geom dil_geom(int T, int g, int qblk, int h) {
    const int ds = 2 * g, d = 1 << ds, nqs = T >> 5;
    const int seqrow0 = (qblk << 5) & ~(T - 1), qs = qblk & (nqs - 1), rho = qs & (d - 1), u0 = (qs >> ds) * 32, U = T >> ds;
    const int jlo = u0 >= 64 ? 0 : (u0 >= 32 ? 1 : 2), jhi = (u0 + 96 <= U) ? 4 : ((u0 + 64 <= U) ? 3 : 2);
    const int base = seqrow0 + rho, ub = u0 - 64 + 32 * jlo;
    return Geom{1, g, qblk, base + (ub << ds), 32 << ds, d, jhi - jlo + 1, base + (u0 << ds), ds, 3584 + g * 512 + h * 64, 5120 + g * 512 + h * 64, 6656 + g * 512 + h * 64};
}
__device__ __forceinline__ void task(const bf16_t* Z, bf16_t* Y, float* DO, float* DL, const LAS float* tabl, int T, int h, bf16x8 (&qf)[4], KV& kvA, KV& kvB, const Geom& G, const Geom& N, bool hasN, LAS unsigned char* vbuf) {
    const int lane = opaque_lane(), r32 = lane & 31, hi = lane >> 5;
    const bool nat = G.kind == 0;
    const int tok0 = G.a0 * 32, nsr0 = tok0 & ~(T - 1), bl = (tok0 & (T - 1)) >> 5, r = 2 * (bl >> 2), c0 = 16 * (bl & 3), rows = T >> 6;
    const int qr = r + (r32 >> 4), qc = c0 + (r32 & 15);
    const int rsu = min(max(r - 4, 0), rows - 8), cst = min(min(max(c0 - 8, 0), 48), 32);
    const int dlo = min(max(qr - 4, 0), rows - 8) - rsu, clo = min(max(qc - 8, 0), 48) - cst - 4 * hi;
    const LAS float* rbl = tabl + h * 465 + (rsu - qr + 7) * 31 + 15 - qc + cst + 4 * hi;
    const int g = G.a0, qblk = G.a1, ds = 2 * g, d = 1 << ds, nqs = T >> 5;
    const int dsr0 = (qblk << 5) & ~(T - 1), qs = qblk & (nqs - 1), rho = qs & (d - 1), u0 = (qs >> ds) * 32;
    const int jlo = u0 >= 64 ? 0 : (u0 >= 32 ? 1 : 2);
    const int qtok = nat ? nsr0 + qr * 64 + qc : dsr0 + rho + ((u0 + r32) << ds);
    const int keyl = r32 - 4 * hi;
    f32x16 o0, o1; float l, mref;
    run(o0, o1, l, mref, qf, kvA, kvB, (const char*)Z, G, N, hasN,
        [&](int t, f32x16& s) {
            if (nat) { const int cl = ((unsigned)(t - dlo) < 8u) ? clo : (1 << 20); const LAS float* bp = rbl + t * 31;
                float bv[16];
#pragma unroll
                for (int rr = 0; rr < 16; ++rr) bv[rr] = bp[(rr & 3) + 8 * (rr >> 2)];
#pragma unroll
                for (int rr = 0; rr < 16; ++rr) s[rr] = ((unsigned)((rr & 3) + 8 * (rr >> 2) - cl) < 16u) ? s[rr] + bv[rr] : -INFINITY; }
            else { const int jt = jlo + t;
                if (jt == 0) {
#pragma unroll
                    for (int rr = 0; rr < 16; ++rr) s[rr] = ((rr & 3) + 8 * (rr >> 2) >= keyl) ? s[rr] : -INFINITY; }
                else if (jt == 4) {
#pragma unroll
                    for (int rr = 0; rr < 16; ++rr) s[rr] = ((rr & 3) + 8 * (rr >> 2) <= keyl) ? s[rr] : -INFINITY; } } },
        vbuf, lane);
    const float inv = __builtin_amdgcn_rcpf(l);
    if (nat) {
        bf16_t* yp = Y + (size_t)qtok * DM + 512 + h * 64;
#pragma unroll
        for (int a4 = 0; a4 < 4; ++a4) { const int d0 = 8 * a4 + 4 * hi;
            u32x2 w; w.x = pk2(o0[4 * a4] * inv, o0[4 * a4 + 1] * inv); w.y = pk2(o0[4 * a4 + 2] * inv, o0[4 * a4 + 3] * inv); *(u32x2*)((char*)Y + pg8::atile_off(qtok, 512 + h * 64 + 8 * a4, DM / 64) + 8 * hi) = w;
            u32x2 w1; w1.x = pk2(o1[4 * a4] * inv, o1[4 * a4 + 1] * inv); w1.y = pk2(o1[4 * a4 + 2] * inv, o1[4 * a4 + 3] * inv); *(u32x2*)((char*)Y + pg8::atile_off(qtok, 512 + h * 64 + 32 + 8 * a4, DM / 64) + 8 * hi) = w1; (void)yp; (void)d0; }
    } else {
        bf16_t* op = (bf16_t*)DO + ((size_t)g * GT + qtok) * 512 + h * 64;
#pragma unroll
        for (int a4 = 0; a4 < 4; ++a4) { const int d0 = 8 * a4 + 4 * hi;
            u32x2 w; w.x = pk2(o0[4 * a4] * inv, o0[4 * a4 + 1] * inv); w.y = pk2(o0[4 * a4 + 2] * inv, o0[4 * a4 + 3] * inv); *(u32x2*)(op + d0) = w;
            u32x2 w1; w1.x = pk2(o1[4 * a4] * inv, o1[4 * a4 + 1] * inv); w1.y = pk2(o1[4 * a4 + 2] * inv, o1[4 * a4 + 3] * inv); *(u32x2*)(op + 32 + d0) = w1; }
        if (hi == 0) DL[((size_t)g * GT + qtok) * 8 + h] = mref + __log2f(l);
    }
}
__device__ __forceinline__ Geom stream_geom(int T, int h, int kk, int wx, int nwg) {
    const int i = wx + (kk >> 1) * nwg, k = kk & 1;
    return nat_geom(T, 2 * i + k, h);
}
__device__ __forceinline__ void stream(const bf16_t* Z, bf16_t* Y, float* DO, float* DL, const LAS float* tabl, int T, int h, int wx, int nwg, LAS unsigned char* vbuf) {
    const int total = 2 * ((256 - wx + nwg - 1) / nwg);
    if (total <= 0) return;
    Geom G = stream_geom(T, h, 0, wx, nwg), N = G; bf16x8 qf[4]; KV kvA, kvB;
    { const int lane = opaque_lane(); const unsigned o0 = kv_off0(G, lane), tsb = (unsigned)G.TS * (ZR * 2), rsb = (unsigned)G.KS * (8 * ZR * 2); const int dv = ((G.vcol - G.kcol) >> 6) * (GT * ZR * 2);
      load_q(qf, (const char*)Z, G, lane); load_kv(kvA, (const char*)Z, o0, rsb, dv); load_kv(kvB, (const char*)Z, o0 + tsb, rsb, dv); }
    for (int kk = 0; kk < total; ++kk) {
        const bool hasN = kk + 1 < total; if (hasN) N = stream_geom(T, h, kk + 1, wx, nwg);
        task(Z, Y, DO, DL, tabl, T, h, qf, kvA, kvB, G, N, hasN, vbuf);
        G = N;
    }
}

constexpr int SKT = 32 * KP, SVT = 32 * VP, SVOFF = 12 * SKT;
struct DTask { int g, h, ds, tok0, u0b, U; };
__device__ __forceinline__ DTask dtask_of(int T, int j) {
    const int g = j >> 9, rem = j & 511, h = rem & 7, jj = rem >> 3, ds = 2 * g, d = 1 << ds, per = T >> 8;
    const int seq = jj / per, q = jj % per, rho = q & (d - 1), ubg = q >> ds;
    return DTask{g, h, ds, seq * T + rho, ubg * 256, T >> ds};
}
__device__ __forceinline__ void dshared_prefetch(u32x4 (&pre)[12], bf16x8 (&qn)[4], const char* Zc, const DTask& D, int tid, int wave, int lane) {
    const int kv = tid >> 8, row = (tid >> 3) & 31, chunk = tid & 7;
    const int col = (kv ? 6656 : 5120) + D.g * 512 + D.h * 64 + chunk * 8;
#pragma unroll
    for (int j = 0; j < 12; ++j) { const int u = D.u0b - 64 + 32 * j;
        if (u >= 0 && u + 32 <= D.U) pre[j] = *(const u32x4*)(Zc + (unsigned)zoff(D.tok0 + ((u + row) << D.ds), col) * 2u); }
    const int r32 = lane & 31, hi = lane >> 5; const int tq = D.tok0 + ((D.u0b + 32 * wave + r32) << D.ds);
    const char* Qp = Zc + (unsigned)(zoff(tq, 3584 + D.g * 512 + D.h * 64) + 8 * hi) * 2u;
#pragma unroll
    for (int s = 0; s < 4; ++s) qn[s] = *(const bf16x8*)(Qp + 32 * s);
}
__device__ __forceinline__ void dshared_task(const bf16_t* Z, float* DO, float* DL, int T, const DTask& D, const DTask& Nx, bool hasN, u32x4 (&pre)[12], bf16x8 (&qn)[4], LAS unsigned char* lds, int tid, int wave) {
    const int lane = tid & 63, r32 = lane & 31, hi = lane >> 5;
    asm volatile("s_waitcnt lgkmcnt(0)\n\ts_barrier" ::: "memory");
    { const int kv = tid >> 8, row = (tid >> 3) & 31, chunk = tid & 7; LAS unsigned char* wp = lds + (kv ? SVOFF + row * VP : row * KP) + chunk * 16;
#pragma unroll
      for (int j = 0; j < 12; ++j) { const int u = D.u0b - 64 + 32 * j; if (u >= 0 && u + 32 <= D.U) *(LAS u32x4*)(wp + j * (kv ? SVT : SKT)) = pre[j]; } }
    bf16x8 qf[4];
#pragma unroll
    for (int s = 0; s < 4; ++s) qf[s] = qn[s];
    asm volatile("s_waitcnt lgkmcnt(0)\n\ts_barrier" ::: "memory");
    if (hasN) dshared_prefetch(pre, qn, (const char*)Z, Nx, tid, wave, lane);
    const int u0 = D.u0b + 32 * wave, jlo = u0 >= 64 ? 0 : (u0 >= 32 ? 1 : 2), jhi = (u0 + 96 <= D.U) ? 4 : ((u0 + 64 <= D.U) ? 3 : 2), nt = jhi - jlo + 1;
    const int keyl = r32 - 4 * hi;
    LAS unsigned char* kb0 = lds + (wave + jlo) * SKT; LAS unsigned char* vb0 = lds + SVOFF + (wave + jlo) * SVT;
    const f32x16 zero = (f32x16){0.f, 0.f, 0.f, 0.f, 0.f, 0.f, 0.f, 0.f, 0.f, 0.f, 0.f, 0.f, 0.f, 0.f, 0.f, 0.f};
    f32x16 o0 = zero, o1 = zero, sA, sB; u32x4 pbA[2], pbB[2]; float l = 0.f, mref, fcarry = 1.0f;
#define DFIX(TT, S) do { const int jt_ = jlo + (TT); \
        if (jt_ == 0) { _Pragma("unroll") for (int rr = 0; rr < 16; ++rr) S[rr] = ((rr & 3) + 8 * (rr >> 2) >= keyl) ? S[rr] : -INFINITY; } \
        else if (jt_ == 4) { _Pragma("unroll") for (int rr = 0; rr < 16; ++rr) S[rr] = ((rr & 3) + 8 * (rr >> 2) <= keyl) ? S[rr] : -INFINITY; } } while (0)
    sA = qk4(kb0, qf, lane); DFIX(0, sA);
    { float mx = sA[0];
#pragma unroll
      for (int r = 1; r < 16; ++r) mx = fmaxf(mx, sA[r]);
      mx = swap_max(mx); mx = (mx > -1e30f) ? mx : 0.f; mref = mx;
#pragma unroll
      for (int r = 0; r < 16; ++r) sA[r] -= mx; }
#define DSTEP2(SC, SN, PBR, PBW, TT) do { const int t_ = (TT); const bool nx_ = (t_ + 1 < nt); \
        if (nx_) SN = qk4(kb0 + (t_ + 1) * SKT, qf, lane); \
        if (t_ >= 1) pv2(o0, o1, vb0 + (t_ - 1) * SVT, PBR, lane); \
        float ps_ = 0.f; \
        _Pragma("unroll") for (int r = 0; r < 16; r += 2) { const float e0_ = __builtin_amdgcn_exp2f(SC[r]), e1_ = __builtin_amdgcn_exp2f(SC[r + 1]); ps_ += e0_; ps_ += e1_; PBW[r >> 3][(r >> 1) & 3] = pk2(e0_, e1_); } \
        ps_ = swap_sum(ps_); l += ps_; \
        if (__any(fcarry < 1.0f)) { o0 *= fcarry; o1 *= fcarry; } \
        fcarry = 1.0f; \
        if (nx_) { _Pragma("unroll") for (int r = 0; r < 16; ++r) SN[r] -= mref; \
            DFIX(t_ + 1, SN); float tn_ = SN[0]; \
            _Pragma("unroll") for (int r = 1; r < 16; ++r) tn_ = fmaxf(tn_, SN[r]); \
            tn_ = swap_max(tn_); \
            if (__any(tn_ > THR)) { const float d_ = fmaxf(tn_, 0.f); fcarry = __builtin_amdgcn_exp2f(-d_); mref += d_; l *= fcarry; \
                _Pragma("unroll") for (int r = 0; r < 16; ++r) SN[r] -= d_; } } \
    } while (0)
    int t = 0;
    for (; t + 1 < nt; t += 2) { DSTEP2(sA, sB, pbB, pbA, t); DSTEP2(sB, sA, pbA, pbB, t + 1); }
    if (t < nt) { DSTEP2(sA, sB, pbB, pbA, t); pv2(o0, o1, vb0 + (nt - 1) * SVT, pbA, lane); }
    else pv2(o0, o1, vb0 + (nt - 1) * SVT, pbB, lane);
#undef DSTEP2
#undef DFIX
    const float inv = __builtin_amdgcn_rcpf(l);
    const int tq = D.tok0 + ((u0 + r32) << D.ds);
    bf16_t* op = (bf16_t*)DO + ((size_t)D.g * GT + tq) * 512 + D.h * 64;
#pragma unroll
    for (int a4 = 0; a4 < 4; ++a4) { const int d0 = 8 * a4 + 4 * hi;
        u32x2 w; w.x = pk2(o0[4 * a4] * inv, o0[4 * a4 + 1] * inv); w.y = pk2(o0[4 * a4 + 2] * inv, o0[4 * a4 + 3] * inv); *(u32x2*)(op + d0) = w;
        u32x2 w1; w1.x = pk2(o1[4 * a4] * inv, o1[4 * a4 + 1] * inv); w1.y = pk2(o1[4 * a4 + 2] * inv, o1[4 * a4 + 3] * inv); *(u32x2*)(op + 32 + d0) = w1; }
    if (hi == 0) DL[((size_t)D.g * GT + tq) * 8 + D.h] = mref + __log2f(l);
}
__device__ __forceinline__ void dshared(const bf16_t* Z, float* DO, float* DL, int T, int wx, int nwg, LAS unsigned char* lds, int tid, int wave) {
    if (wx >= 1536) return;
    const int lane = tid & 63;
    DTask D = dtask_of(T, wx), Nx = D; u32x4 pre[12]; bf16x8 qn[4];
    dshared_prefetch(pre, qn, (const char*)Z, D, tid, wave, lane);
    for (int j = wx; j < 1536; j += nwg) {
        const bool hasN = j + nwg < 1536; if (hasN) Nx = dtask_of(T, j + nwg);
        dshared_task(Z, DO, DL, T, D, Nx, hasN, pre, qn, lds, tid, wave);
        D = Nx;
    }
}
}

namespace fftm {
constexpr int PP = 320, PLANE = 128 * PP;
__device__ __forceinline__ bf16x8 trB(LAS unsigned char* p) {
    const s16x4 lo = __builtin_amdgcn_ds_read_tr16_b64_v4i16((LAS s16x4*)p), hh = __builtin_amdgcn_ds_read_tr16_b64_v4i16((LAS s16x4*)(p + 4 * PP));
    return (bf16x8){lo[0], lo[1], lo[2], lo[3], hh[0], hh[1], hh[2], hh[3]};
}
__device__ __forceinline__ bf16_t bf1(float x) { return (bf16_t)(pk2(x, 0.f) & 0xffffu); }
constexpr int UP = 272, PLOFF = 36864;
template <int N1>
__device__ __forceinline__ void pass1(const bf16_t* Zs, bf16_t* Bs, int t2, int g4, int dftstep, const bf16_t* W, const bf16_t* W128, LAS unsigned char* lds, int tid) {
    __syncthreads();
    { bf16x8 uv[N1 / 32];
#pragma unroll
      for (int i = 0; i < N1 / 32; ++i) { const int idx = tid + 512 * i, t1 = idx >> 4, c = idx & 15; uv[i] = *(const bf16x8*)(Zs + zoff(t1 * 128 + t2, g4 * 128 + c * 8)); }
#pragma unroll
      for (int i = 0; i < N1 / 32; ++i) { const int idx = tid + 512 * i, t1 = idx >> 4, c = idx & 15; *(LAS bf16x8*)(lds + t1 * UP + c * 16) = uv[i]; } }
    __syncthreads();
    constexpr int KB = N1 / 32, TPW = N1 / 64;
    const int lane = tid & 63, wid = __builtin_amdgcn_readfirstlane(tid >> 6), r32 = lane & 31, hi = lane >> 5;
    LAS unsigned char* const pl = lds + PLOFF;
    {
        const int tb = wid & 3, ca0 = (wid >> 2) * 2;
        if (tb < KB) {
            f32x16 aP[2], aQ[2];
#pragma unroll
            for (int t = 0; t < 2; ++t) { aP[t] = (f32x16){0.f, 0.f, 0.f, 0.f, 0.f, 0.f, 0.f, 0.f, 0.f, 0.f, 0.f, 0.f, 0.f, 0.f, 0.f, 0.f}; aQ[t] = aP[t]; }
            const LAS unsigned char* up = lds + (tb * 32 + r32) * UP + 16 * hi;
#pragma unroll
            for (int kh = 0; kh < 2; ++kh) {
                bf16x8 wP[4][2], wQ[4][2];
#pragma unroll
                for (int k4 = 0; k4 < 4; ++k4)
#pragma unroll
                    for (int t = 0; t < 2; ++t) { const bf16_t* wr_ = W128 + ((ca0 + t) * 32 + r32) * 128 + 16 * (kh * 4 + k4) + 8 * hi;
                        wP[k4][t] = *(const bf16x8*)wr_; wQ[k4][t] = *(const bf16x8*)(wr_ + 16384); }
                __builtin_amdgcn_sched_barrier(0);
#pragma unroll
                for (int k4 = 0; k4 < 4; ++k4) { const bf16x8 au = *(const LAS bf16x8*)(up + (kh * 4 + k4) * 32);
#pragma unroll
                    for (int t = 0; t < 2; ++t) { aP[t] = __builtin_amdgcn_mfma_f32_32x32x16_bf16(au, wP[k4][t], aP[t], 0, 0, 0); aQ[t] = __builtin_amdgcn_mfma_f32_32x32x16_bf16(au, wQ[k4][t], aQ[t], 0, 0, 0); } }
                __builtin_amdgcn_sched_barrier(0); }
#pragma unroll
            for (int t = 0; t < 2; ++t)
#pragma unroll
                for (int r = 0; r < 16; ++r) { LAS bf16_t* o = (LAS bf16_t*)(pl + (tb * 32 + crow(r, hi)) * PP) + (ca0 + t) * 32 + r32; o[0] = bf1(aP[t][r]); *(LAS bf16_t*)((LAS unsigned char*)o + PLANE) = bf1(aQ[t][r]); }
        }
    }
    __syncthreads();
    const int kblk = wid % KB, cb0 = (wid / KB) * TPW;
    const bf16_t* wc = W + (kblk * 32 + r32) * N1 + 8 * hi; const bf16_t* wsn = wc + N1 * N1; const bf16_t* wn = wsn + N1 * N1;
    const int vb = (8 * hi + ((lane >> 2) & 3)) * PP + (16 * ((lane >> 4) & 1) + 4 * (lane & 3)) * 2;
    f32x16 re[TPW], im[TPW];
#pragma unroll
    for (int t = 0; t < TPW; ++t) { re[t] = (f32x16){0.f, 0.f, 0.f, 0.f, 0.f, 0.f, 0.f, 0.f, 0.f, 0.f, 0.f, 0.f, 0.f, 0.f, 0.f, 0.f}; im[t] = re[t]; }
#pragma unroll
    for (int kh = 0; kh < N1 / 64; ++kh) {
        bf16x8 ac[4], as[4], an[4];
#pragma unroll
        for (int k4 = 0; k4 < 4; ++k4) { const int ks = kh * 4 + k4; ac[k4] = *(const bf16x8*)(wc + 16 * ks); as[k4] = *(const bf16x8*)(wsn + 16 * ks); an[k4] = *(const bf16x8*)(wn + 16 * ks); }
        __builtin_amdgcn_sched_barrier(0);
#pragma unroll
        for (int k4 = 0; k4 < 4; ++k4) { const int ks = kh * 4 + k4;
#pragma unroll
            for (int t = 0; t < TPW; ++t) { LAS unsigned char* bp = pl + vb + ks * 16 * PP + (cb0 + t) * 64;
                const bf16x8 bP = trB(bp), bQ = trB(bp + PLANE);
                re[t] = __builtin_amdgcn_mfma_f32_32x32x16_bf16(ac[k4], bP, re[t], 0, 0, 0); re[t] = __builtin_amdgcn_mfma_f32_32x32x16_bf16(an[k4], bQ, re[t], 0, 0, 0);
                im[t] = __builtin_amdgcn_mfma_f32_32x32x16_bf16(as[k4], bP, im[t], 0, 0, 0); im[t] = __builtin_amdgcn_mfma_f32_32x32x16_bf16(ac[k4], bQ, im[t], 0, 0, 0); } }
        __builtin_amdgcn_sched_barrier(0);
    }
#pragma unroll
    for (int t = 0; t < TPW; ++t) { const int ch = (cb0 + t) * 32 + r32;
#pragma unroll
        for (int r = 0; r < 16; ++r) { const int k1 = kblk * 32 + crow(r, hi); const float x = (float)((k1 * t2 * dftstep) & 16383) * (1.0f / 16384.0f);
            const float c = __builtin_amdgcn_cosf(x), sn = __builtin_amdgcn_sinf(x);
            bf16_t* o = Bs + ((((size_t)k1 * 128 + t2) * 4 + g4) * 256 + ch);
            o[0] = bf1(re[t][r] * c - im[t][r] * sn); o[128] = bf1(re[t][r] * sn + im[t][r] * c); } }
}
template <int N1>
__device__ __forceinline__ void pass2(const bf16_t* Bs, bf16_t* Ys, int k1, int g4, float rsT, const bf16_t* W128, LAS unsigned char* lds, int tid) {
    __syncthreads();
    { bf16x8 rv[4], iv[4];
#pragma unroll
      for (int i = 0; i < 4; ++i) { const int idx = tid + 512 * i, t2 = idx >> 4, c = idx & 15; const bf16_t* p = Bs + ((((size_t)k1 * 128 + t2) * 4 + g4) * 256 + c * 8); rv[i] = *(const bf16x8*)p; iv[i] = *(const bf16x8*)(p + 128); }
#pragma unroll
      for (int i = 0; i < 4; ++i) { const int idx = tid + 512 * i, t2 = idx >> 4, c = idx & 15; *(LAS bf16x8*)(lds + t2 * PP + c * 16) = rv[i]; *(LAS bf16x8*)(lds + PLANE + t2 * PP + c * 16) = iv[i]; } }
    __syncthreads();
    const int lane = tid & 63, wid = __builtin_amdgcn_readfirstlane(tid >> 6), r32 = lane & 31, hi = lane >> 5;
    const int kblk = wid & 3, cb0 = (wid >> 2) * 2;
    const bf16_t* wc = W128 + (kblk * 32 + r32) * 128 + 8 * hi; const bf16_t* wn = wc + 2 * 128 * 128;
    const int vb = (8 * hi + ((lane >> 2) & 3)) * PP + (16 * ((lane >> 4) & 1) + 4 * (lane & 3)) * 2;
    f32x16 acc[2];
    acc[0] = (f32x16){0.f, 0.f, 0.f, 0.f, 0.f, 0.f, 0.f, 0.f, 0.f, 0.f, 0.f, 0.f, 0.f, 0.f, 0.f, 0.f}; acc[1] = acc[0];
    bf16x8 ac[8], an[8];
#pragma unroll
    for (int ks = 0; ks < 8; ++ks) { ac[ks] = *(const bf16x8*)(wc + 16 * ks); an[ks] = *(const bf16x8*)(wn + 16 * ks); }
    __builtin_amdgcn_sched_barrier(0);
#pragma unroll
    for (int ks = 0; ks < 8; ++ks) {
#pragma unroll
        for (int t = 0; t < 2; ++t) { LAS unsigned char* bp = lds + vb + ks * 16 * PP + (cb0 + t) * 64;
            const bf16x8 bR = trB(bp), bI = trB(bp + PLANE);
            acc[t] = __builtin_amdgcn_mfma_f32_32x32x16_bf16(ac[ks], bR, acc[t], 0, 0, 0); acc[t] = __builtin_amdgcn_mfma_f32_32x32x16_bf16(an[ks], bI, acc[t], 0, 0, 0); }
    }
#pragma unroll
    for (int t = 0; t < 2; ++t) { const int ch = (cb0 + t) * 32 + r32;
#pragma unroll
        for (int r = 0; r < 16; ++r) { const int k2 = kblk * 32 + crow(r, hi); *(bf16_t*)((char*)Ys + pg8::atile_off(k1 + N1 * k2, (g4 * 128 + ch) & ~7, DM / 64) + (ch & 7) * 2) = bf1(acc[t][r] * rsT); } }
}
}

constexpr int NPH = 52;
__global__ void __launch_bounds__(512, 2) fwd(Args a_unused) {
    extern __shared__ __attribute__((aligned(16))) unsigned char lds_raw[];
    LAS unsigned char* lds = (LAS unsigned char*)lds_raw;
    const int wg = blockIdx.x, nwg = gridDim.x;
    int wv = __builtin_amdgcn_readfirstlane((int)threadIdx.x >> 6); asm volatile("" : "+s"(wv));
    { const int tid0 = opaque_tid(wv); for (int u = tid0; u < (LDS_BYTES - LDSCTL_OFF) / 4; u += 512) ((LAS unsigned*)(lds + LDSCTL_OFF))[u] = 0u; }
    __syncthreads();
    int lo, hi; XcdBarrier bar;
    { KArgs* ka = kargs(); lo = ka->ph_lo; hi = ka->ph_hi; unsigned* barw = (unsigned*)(ka->ws + WS_CTL) + CW_BAR + ka->li * XCD_BAR_WORDS;
      bar.bar = barw; bar.x = 0; bar.st = (volatile LAS unsigned*)(lds + MISC_OFF + 32); bar.wv = wv;
      if (hi - lo > 1) bar = xcd_barrier_post(barw, (volatile LAS unsigned*)(lds + MISC_OFF + 32), wv); }
    int pi = 0;
#define PH_BEGIN if (pi >= lo && pi < hi) { KArgs& a = *kargs(); unsigned char* const ws = a.ws; (void)ws;
#define PH_END   if (pi + 1 < hi) xcd_barrier(bar); } ++pi;

    PH_BEGIN prologue_phase(a, lds, wg, nwg, opaque_tid(wv)); PH_END
    PH_BEGIN prologue2_phase(a, lds, wg, nwg, opaque_tid(wv)); PH_END
    PH_BEGIN { const int t_ = opaque_tid(wv); for (int rep = 0; rep < NREP(6); ++rep) norm_first_phase(a, wg, nwg, __builtin_amdgcn_readfirstlane(t_ >> 6), t_ & 63); } PH_END

    for (int l = 0; l < 2; ++l) {
        for (int s = 0; s < 3; ++s) {
            const bool first = (l == 0 && s == 0);
            if ((DBG_SKIP & 1) && s == 1) { pi += 20; continue; }
            if (s != 1) {
                PH_BEGIN { unsigned char* wl = ws + WS_W + (size_t)l * WLAYER; pg8::PlainOrder S; S.init(ws + WS_H, wl + (s == 0 ? WO_FF1I : WO_FF2I), NTOK, 2 * DFF, DM, DM, nwg, wg, WGM_FFI); S.atile = !first;        pg8::EpiSwiGLU E{(bf16_t*)(ws + WS_BIG), (const float*)(ws + WS_SS) + (size_t)(l * 3 + s) * NTOK, (const float*)(ws + WS_BW) + (size_t)l * 6 * BWL + (s == 0 ? 0 : 27392)};
                           for (int rep = 0; rep < NREP(0); ++rep) pg8::gemm_phase(lds, DM, DM, DM, S, E, wv); } PH_END
                PH_BEGIN { unsigned char* wl = ws + WS_W + (size_t)l * WLAYER; pg8::PlainOrder S; S.init(ws + WS_BIG, wl + (s == 0 ? WO_FF1O : WO_FF2O), NTOK, DM, DFF, DFF, nwg, wg, WGM_FFO);
                           const bool lastsub = (l == 1 && s == 2);
                           pg8::EpiResid E{first ? a.in[I_XP] : (const float*)nullptr, first ? a.in[I_XS] - (size_t)32768 * DM : (const float*)nullptr, (float*)(ws + WS_XF), lastsub ? a.out : (float*)nullptr,
                                           (const float*)(ws + WS_MOD) + (size_t)l * 6 * NMODC, (3 * s + 2) * DM, 0.5f, 0,
                                           lastsub ? (bf16_t*)nullptr : (bf16_t*)(ws + WS_H), (const float*)(ws + WS_AT) + (size_t)(l * 3 + s + 1) * 6 * DM, (float*)(ws + WS_SS) + (size_t)(l * 3 + s + 1) * NTOK};
                           pg8::gemm_phase(lds, DFF, DFF, DFF, S, E, wv); } PH_END
            } else {
                for (int g = 0; g < 4; ++g) {
                    const int T = g < 2 ? 16384 : 8192;
                    PH_BEGIN if (!(DBG_SKIP & 128)) { unsigned char* wl = ws + WS_W + (size_t)l * WLAYER; pg8::PlainOrder S; S.init((bf16_t*)(ws + WS_H) + (size_t)g * GT * DM, wl + WO_IN, GT, NINV, DM, DM, nwg, wg, WGM_INP);
                               pg8::EpiInProj E{(bf16_t*)(ws + WS_Z), (bf16_t*)(ws + WS_G), a.in[I_BGATE] + (size_t)l * 4 * DM, T - 1, (const float*)(ws + WS_SS) + (size_t)(l * 3 + 1) * NTOK, (const float*)(ws + WS_BW) + (size_t)l * 6 * BWL + 11008, g * GT};
                               for (int rep = 0; rep < NREP(1); ++rep) pg8::gemm_phase(lds, DM, DM, DM, S, E, wv); } PH_END
                    PH_BEGIN {
                        bf16_t* Zb = (bf16_t*)(ws + WS_Z); bf16_t* Yb = (bf16_t*)(ws + WS_Y);
                        { const float* lamp = (const float*)(ws + WS_LAM); const float* lng = a.in[I_DLNG] + l * 128;
                          if (!(DBG_SKIP & 2)) for (int rep = 0; rep < NREP(2); ++rep) for (int u = wg; u < 256; u += nwg) { const int x = u & 7, h = x >> 1; int seq, qb;
                            if (T == 16384) { seq = 0; qb = (u >> 3) * 2 + (x & 1); } else { seq = x & 1; qb = u >> 3; }
                            dattn::unit<0>(Zb + (size_t)seq * T * ZR, T, h, qb, lamp, l, lng, Yb + (size_t)seq * T * DM, (u32x4*)(ws + WS_DOS) + (size_t)u * 4096, lds, wv);
#if DBG_PROBE >= 0
                            dattn::unit<DBG_PROBE>(Zb + (size_t)seq * T * ZR, T, h, qb, lamp, l, lng, (bf16_t*)(ws + WS_MG) + (size_t)seq * T * DM, (u32x4*)(ws + WS_DOS) + (size_t)u * 4096, lds, wv);
#endif
                            } }
                        __syncthreads();
                        { const int tid = opaque_tid(wv), lane = tid & 63, wave = __builtin_amdgcn_readfirstlane(tid >> 6);
                          LAS unsigned char* vbuf = lds + wave * wattn::WBUF; const float* relb = a.in[I_RELB] + (size_t)l * 8 * 465;
                          LAS float* tabl = (LAS float*)(lds + 8 * wattn::WBUF);
                          { float tv[8];
#pragma unroll
                            for (int i = 0; i < 8; ++i) { const int e = tid + 512 * i; tv[i] = e < 8 * 465 ? relb[e] : 0.f; }
#pragma unroll
                            for (int i = 0; i < 8; ++i) { const int e = tid + 512 * i; if (e < 8 * 465) tabl[e] = tv[i] * LOG2E; } }
                          __syncthreads();
                          float* DO = (float*)(ws + WS_DILO); float* DL = (float*)(ws + WS_DILL);
                          for (int rep = 0; rep < NREP(3); ++rep) {
                          const int wx = (nwg == 256) ? ((wg & 7) * 32 + (wg >> 3)) : wg;
                          wattn::stream(Zb, Yb, DO, DL, tabl, T, wave, wx, nwg, vbuf);
                          __syncthreads();
                          wattn::dshared(Zb, DO, DL, T, wx, nwg, lds, opaque_tid(wv), wave); }
                          }
                        __syncthreads();
                        { const int tid = opaque_tid(wv); const bf16_t* dft = (const bf16_t*)(ws + WS_DFT); bf16_t* FB = (bf16_t*)(ws + WS_FFTB);
                          for (int rep = 0; rep < NREP(4); ++rep)
                          if (DBG_SKIP & 16) {} else if (T == 16384) { for (int u = wg; u < 512; u += nwg) fftm::pass1<128>(Zb, FB, u >> 2, u & 3, 1, dft, dft, lds, tid); }
                          else { for (int u = wg; u < 1024; u += nwg) { const int seq = u >> 9; fftm::pass1<64>(Zb + (size_t)seq * 8192 * ZR, FB + (size_t)seq * 64 * 128 * 1024, (u >> 2) & 127, u & 3, 2, dft + 49152, dft, lds, tid); } } }
                    } PH_END
                    PH_BEGIN {
                        const int tid = opaque_tid(wv); bf16_t* Yb = (bf16_t*)(ws + WS_Y); const bf16_t* FB = (const bf16_t*)(ws + WS_FFTB); const bf16_t* dft = (const bf16_t*)(ws + WS_DFT); const float* DO = (const float*)(ws + WS_DILO); const float* DL = (const float*)(ws + WS_DILL);
                        for (int rep = 0; rep < NREP(4); ++rep)
                        if (DBG_SKIP & 16) {} else if (T == 16384) { for (int u = wg; u < 512; u += nwg) fftm::pass2<128>(FB, Yb, u >> 2, u & 3, 0.0078125f * 0.08838834764831843f, dft, lds, tid); }
                        else { for (int u = wg; u < 512; u += nwg) { const int seq = u >> 8; fftm::pass2<64>(FB + (size_t)seq * 64 * 128 * 1024, Yb + (size_t)seq * 8192 * DM, (u >> 2) & 63, u & 3, 0.011048543456039806f * 0.08838834764831843f, dft, lds, tid); } }
                        if (DBG_SKIP & 30) { for (int item = wg * 512 + tid; item < GT * 512; item += nwg * 512) { const int row = item >> 9, c4 = item & 511, part = c4 >> 7;
                            const bool z = (part == 0 && (DBG_SKIP & 16)) || (part == 1 && (DBG_SKIP & 4)) || (part == 2 && (DBG_SKIP & 2)) || (part == 3 && (DBG_SKIP & 8));
                            if (z) *(u32x2*)(Yb + (size_t)row * DM + c4 * 4) = ((DBG_SKIP & 64) && part == 1) ? ((DBG_SKIP & 128) ? *(const u32x2*)((const bf16_t*)(ws + WS_H) + ((size_t)g * GT + row) * DM + (c4 - 128) * 4) : *(const u32x2*)((const bf16_t*)(ws + WS_Z) + (size_t)row * ZP + 512 + (c4 - 128) * 4)) : (u32x2){0u, 0u}; } }
                        if (!(DBG_SKIP & 8)) {
                            const bf16_t* DOb = (const bf16_t*)DO; const int istr = nwg * 512;
#pragma unroll 1
                            for (int item0 = wg * 512 + tid; item0 < GT * 128; item0 += 4 * istr) {
                                float Lv[4][3]; u32x2 pv[4][3];
#pragma unroll
                                for (int q = 0; q < 4; ++q) { const int item = item0 + q * istr; const bool ok = item < GT * 128; const int row = ok ? item >> 7 : 0, c4 = item & 127, h = c4 >> 4;
#pragma unroll
                                    for (int gq = 0; gq < 3; ++gq) { Lv[q][gq] = DL[((size_t)gq * GT + row) * 8 + h]; pv[q][gq] = *(const u32x2*)(DOb + ((size_t)gq * GT + row) * 512 + c4 * 4); } }
#pragma unroll
                                for (int q = 0; q < 4; ++q) { const int item = item0 + q * istr; if (item >= GT * 128) break; const int row = item >> 7, c4 = item & 127;
                                    const float L0 = Lv[q][0], L1 = Lv[q][1], L2 = Lv[q][2];
                                    const float mx = fmaxf(L0, fmaxf(L1, L2)); const float w0 = __builtin_amdgcn_exp2f(L0 - mx), w1 = __builtin_amdgcn_exp2f(L1 - mx), w2 = __builtin_amdgcn_exp2f(L2 - mx);
                                    const float inv = __builtin_amdgcn_rcpf(w0 + w1 + w2);
                                    const u32x2 p0 = pv[q][0], p1 = pv[q][1], p2 = pv[q][2];
                                    const f32x4 o = ((f32x4){bf_lo(p0.x), bf_hi(p0.x), bf_lo(p0.y), bf_hi(p0.y)} * w0 + (f32x4){bf_lo(p1.x), bf_hi(p1.x), bf_lo(p1.y), bf_hi(p1.y)} * w1 + (f32x4){bf_lo(p2.x), bf_hi(p2.x), bf_lo(p2.y), bf_hi(p2.y)} * w2) * inv;
                                    u32x2 w; w.x = pk2(o[0], o[1]); w.y = pk2(o[2], o[3]); *(u32x2*)((char*)Yb + pg8::atile_off(row, 1536 + (c4 >> 1) * 8, DM / 64) + (c4 & 1) * 8) = w; } } }
                    } PH_END
                    PH_BEGIN { unsigned char* wl = ws + WS_W + (size_t)l * WLAYER; pg8::MergeOrder S{(const char*)(ws + WS_Y), (const char*)(wl + WO_BR), nwg, wg}; pg8::EpiMerge E{(const bf16_t*)(ws + WS_G), (bf16_t*)(ws + WS_MG)};
                               for (int rep = 0; rep < NREP(5); ++rep) pg8::gemm_hm3(lds, DM, DM, DM, S, E, wv); } PH_END
                    PH_BEGIN { unsigned char* wl = ws + WS_W + (size_t)l * WLAYER; pg8::PlainOrder S; S.init(ws + WS_MG, wl + WO_OUT, GT, DM, DM, DM, nwg, wg);
                               pg8::EpiResid E{(const float*)nullptr, (const float*)nullptr, (float*)(ws + WS_XF), (float*)nullptr, (const float*)(ws + WS_MOD) + (size_t)l * 6 * NMODC, 5 * DM, 1.0f, g * GT,
                                               (bf16_t*)(ws + WS_H), (const float*)(ws + WS_AT) + (size_t)(l * 3 + 2) * 6 * DM, (float*)(ws + WS_SS) + (size_t)(l * 3 + 2) * NTOK};
                               pg8::gemm_phase(lds, DM, DM, DM, S, E, wv); } PH_END
                }
            }
        }
    }
    PH_BEGIN { const int t_ = opaque_tid(wv); final_phase(a, wg, nwg, __builtin_amdgcn_readfirstlane(t_ >> 6), t_ & 63); } PH_END
#undef PH_BEGIN
#undef PH_END
}

extern "C" void kernel_launch(void* const* d_in, const int* in_sizes, int n_in, void* d_out, int out_size, void* d_ws, size_t ws_size, hipStream_t stream) {
    static int grid = 0;
    if (grid == 0) {
        if (n_in != 24 || in_sizes[0] != 32768 * DM || out_size != NTOK * DM || ws_size < WS_END) { fprintf(stderr, "kernel_launch: unexpected shapes (n_in %d, out %d, ws %zu, need %zu)\n", n_in, out_size, ws_size, (size_t)WS_END); grid = -1; return; }
        int dev = 0, cus = 0, per_cu = 0;
        if (hipGetDevice(&dev) != hipSuccess || hipDeviceGetAttribute(&cus, hipDeviceAttributeMultiprocessorCount, dev) != hipSuccess) { grid = -1; return; }
        if (hipFuncSetAttribute((const void*)fwd, hipFuncAttributeMaxDynamicSharedMemorySize, LDS_BYTES) != hipSuccess) { fprintf(stderr, "kernel_launch: hipFuncSetAttribute failed\n"); grid = -1; return; }
        if (hipOccupancyMaxActiveBlocksPerMultiprocessor(&per_cu, (const void*)fwd, 512, LDS_BYTES) != hipSuccess || per_cu < 1) { fprintf(stderr, "kernel_launch: occupancy query says %d\n", per_cu); }
        (void)hipGetLastError();
        grid = cus > 256 ? 256 : cus;
    }
    if (grid < 0) return;
    if (hipMemsetAsync((char*)d_ws + WS_CTL, 0, CTL_ZERO_BYTES, stream) != hipSuccess) return;
    Args a{};
    for (int i = 0; i < 24; ++i) a.in[i] = (const float*)d_in[i];
    a.out = (float*)d_out; a.ws = (unsigned char*)d_ws; a.pad = 0;
#if MK_ONE_LAUNCH
    a.ph_lo = 0; a.ph_hi = NPH; a.li = 0;
    hipLaunchKernelGGL(fwd, dim3(grid), dim3(512), LDS_BYTES, stream, a);
#else
    for (int li = 0; li < NPH; ++li) { a.ph_lo = li; a.ph_hi = li + 1; a.li = 0; hipLaunchKernelGGL(fwd, dim3(grid), dim3(512), LDS_BYTES, stream, a); }
#endif
}
```

```cpp
#include <hip/hip_runtime.h>
#include <cstdio>
#include <cstdint>

#ifndef MK_ONE_LAUNCH
#define MK_ONE_LAUNCH 1
#endif
#ifndef DBG_SKIP
#define DBG_SKIP 0
#endif
#ifndef DBG_REP
#define DBG_REP 0
#endif
#ifndef DBG_PROBE
#define DBG_PROBE -1
#endif
#ifndef WGM_FFI
#define WGM_FFI 4
#endif
#ifndef WGM_INP
#define WGM_INP 4
#endif
#ifndef WGM_FFO
#define WGM_FFO 4
#endif
#ifndef DBG_WPROBE
#define DBG_WPROBE 0
#endif
#define NREP(k) (1 + ((DBG_REP >> (k)) & 1))

#define LAS __attribute__((address_space(3)))
typedef unsigned short bf16_t;
typedef short bf16x8 __attribute__((ext_vector_type(8)));
typedef short s16x4 __attribute__((ext_vector_type(4)));
typedef float f32x4 __attribute__((ext_vector_type(4)));
typedef float f32x2 __attribute__((ext_vector_type(2)));
typedef float f32x16 __attribute__((ext_vector_type(16)));
typedef unsigned u32x4 __attribute__((ext_vector_type(4)));
typedef unsigned u32x2 __attribute__((ext_vector_type(2)));

constexpr int DM = 2048, NTOK = 65536, DFF = 5504, GT = 16384, ZP = 8192, NINV = 16384, NMODC = 18432;
constexpr int ZR = 64;
__host__ __device__ __forceinline__ size_t zoff(int row, int col) { return ((size_t)(col >> 6) * GT + row) * ZR + (col & 63); }
constexpr float EPS = 1e-6f;
constexpr float LOG2E = 1.4426950408889634f;
constexpr float C2 = 0.125f * 1.4426950408889634f;

constexpr size_t MiB = 1u << 20;
constexpr size_t WS_CTL = 0, CTL_ZERO_BYTES = 1 * MiB;
constexpr size_t WS_MOD = 1 * MiB;
constexpr size_t WS_ROPE = 2 * MiB;
constexpr size_t WS_DFT = 3 * MiB;
constexpr size_t WS_LAM = 3 * MiB + 256 * 1024;
constexpr size_t WS_W = 4 * MiB;
constexpr size_t WO_FF1I = 0, WO_FF1O = 45088768, WO_IN = 67633152, WO_BR = 134742016, WO_OUT = 143130624, WO_FF2I = 151519232, WO_FF2O = 196608000, WLAYER = 219152384;
constexpr size_t WS_H = 426 * MiB;
constexpr size_t WS_BIG = 682 * MiB;
constexpr size_t WS_Z = WS_BIG, WS_G = WS_BIG + 272 * MiB, WS_Y = WS_BIG + 528 * MiB, WS_MG = WS_BIG + 592 * MiB, WS_FFTB = WS_BIG + 656 * MiB,
                 WS_DILO = WS_BIG + 688 * MiB, WS_DILL = WS_BIG + 784 * MiB, WS_DOS = WS_BIG + 786 * MiB,
                 WS_SS = WS_BIG + 802 * MiB  ,
                 WS_AT = WS_SS + 2 * MiB  , WS_BW = WS_AT + 1 * MiB  , WS_XF = WS_BW + 2 * MiB  , WS_END = WS_XF + 512 * MiB;
constexpr int BWL = 38400;
static_assert(WS_W + 2 * WLAYER <= WS_H, "weights region");
constexpr int CW_BAR = 4096;

constexpr int LDS_BYTES = 148480;
constexpr int LDSCTL_OFF = 147456;
constexpr int MISC_OFF = LDSCTL_OFF + 320;

__device__ __forceinline__ float bf_lo(unsigned w) { return __uint_as_float(w << 16); }
__device__ __forceinline__ float bf_hi(unsigned w) { return __uint_as_float(w & 0xffff0000u); }
typedef __bf16 bf16x2_t __attribute__((ext_vector_type(2)));
__device__ __forceinline__ unsigned pk2(float lo, float hi) { const f32x2 v = {lo, hi}; const bf16x2_t b = __builtin_convertvector(v, bf16x2_t); return __builtin_bit_cast(unsigned, b); }
__device__ __forceinline__ float swap_max(float x) { auto rr = __builtin_amdgcn_permlane32_swap(__float_as_uint(x), __float_as_uint(x), false, false); return fmaxf(__uint_as_float(rr[0]), __uint_as_float(rr[1])); }
__device__ __forceinline__ float swap_sum(float x) { auto rr = __builtin_amdgcn_permlane32_swap(__float_as_uint(x), __float_as_uint(x), false, false); return __uint_as_float(rr[0]) + __uint_as_float(rr[1]); }
__device__ __forceinline__ int lane_now() { int l; asm volatile("v_mbcnt_lo_u32_b32 %0, -1, 0\n\tv_mbcnt_hi_u32_b32 %0, -1, %0" : "=v"(l)); return l; }
__device__ __forceinline__ int opaque_tid(int wv) { return (wv << 6) | lane_now(); }
__device__ __forceinline__ float wave_sum(float v) {
    v += __uint_as_float((unsigned)__builtin_amdgcn_ds_swizzle((int)__float_as_uint(v), (1 << 10) | 0x1f));
    v += __uint_as_float((unsigned)__builtin_amdgcn_ds_swizzle((int)__float_as_uint(v), (2 << 10) | 0x1f));
    v += __uint_as_float((unsigned)__builtin_amdgcn_ds_swizzle((int)__float_as_uint(v), (4 << 10) | 0x1f));
    v += __uint_as_float((unsigned)__builtin_amdgcn_ds_swizzle((int)__float_as_uint(v), (8 << 10) | 0x1f));
    v += __uint_as_float((unsigned)__builtin_amdgcn_ds_swizzle((int)__float_as_uint(v), (16 << 10) | 0x1f));
    return swap_sum(v);
}
__device__ __forceinline__ int opaque_lane() { return lane_now(); }
__device__ __forceinline__ int brow_of(int row) { return row < 32768 ? (row >> 14) : 2 + ((row - 32768) >> 13); }
__device__ __forceinline__ int crow(int r, int hi) { return (r & 3) + 8 * (r >> 2) + 4 * hi; }

namespace pg8 {
constexpr float ROPE_C0[8] = {1.5915494309e-01f, 3.0863763405e-02f, 5.9851857127e-03f, 1.1606636412e-03f, 2.2507907904e-04f, 4.3647952793e-05f, 8.4643308082e-06f, 1.6414262628e-06f};
constexpr float ROPE_C1[8] = {3.7183271576e-01f, 9.5056171580e-01f, 7.6610377123e-01f, 1.4856494608e-01f, 2.8810122117e-02f, 5.5869379575e-03f, 1.0834343435e-03f, 2.1010256164e-04f};
constexpr int BM = 256, BK = 64, HALF = 128, HTB = HALF * BK * 2, STAGE_BYTES = 8 * HTB, NXCD = 8, WGM = 4;
__host__ __device__ __forceinline__ int lds_byte(int r, int c) { const int st = (r >> 4) * 2 + (c >> 5), rr = r & 15, cc = c & 31, ob = rr * 64 + cc * 2; return st * 1024 + (ob ^ (((ob >> 9) & 1) << 5)); }
__host__ __device__ __forceinline__ void stage_rc(int b, int& R, int& C) { const int st = b / 1024, sb = b % 1024, swz = sb ^ (((sb >> 9) & 1) << 5); R = (st >> 1) * 16 + swz / 64; C = (st & 1) * 32 + (swz % 64) / 2; }
__host__ __device__ __forceinline__ int perm32(int rho) { const int n = rho >> 4, i = rho & 15; return 8 * (i >> 2) + 4 * n + (i & 3); }
__host__ __device__ __forceinline__ size_t atile_off(int r, int k, int nkt) { return ((size_t)((r >> 8) * nkt + (k >> 6)) * 2 + ((r >> 7) & 1)) * 16384 + lds_byte(r & 127, k & 63); }
__host__ __device__ __forceinline__ size_t wtile_off(int v, int k, int nkt) {
    const int rb = v & 127, s = rb & 31, rho = 16 * ((s >> 2) & 1) + 4 * (s >> 3) + (s & 3), R = (rb & ~31) + rho;
    return ((size_t)((v >> 8) * nkt + (k >> 6)) * 2 + ((v >> 7) & 1)) * 16384 + lds_byte(R, k & 63);
}

struct Unit { int pm, pn, pz; const char* a; const char* b; };

__device__ __forceinline__ bool tile_of(int nM, int nN, int G, int c, int i, int& pm, int& pn, int wgm = WGM) {
    const int nwg = nM * nN; const long L = (long)i * G + c; if (L >= nwg) return false;
    int wgid = (int)L; { const int q = nwg / NXCD, r = nwg % NXCD, xcd = wgid % NXCD, off = wgid / NXCD; wgid = (xcd < r ? xcd * (q + 1) : r * (q + 1) + (xcd - r) * q) + off; }
    const int nig = wgm * nN, gid = wgid / nig, fm = gid * wgm, gsz = (nM - fm) < wgm ? (nM - fm) : wgm;
    pm = fm + ((wgid % nig) % gsz); pn = (wgid % nig) / gsz; return true;
}
struct PlainOrder {
    const char* A; const char* Bt; int nM, nN, G, c, wgm; size_t tA, tB; bool atile;
    __device__ __forceinline__ void init(const void* A_, const void* Bt_, int M, int N, int lda, int ldb, int G_, int c_, int wgm_ = WGM) { A = (const char*)A_; Bt = (const char*)Bt_; nM = M / BM; nN = N / BM; G = G_; c = c_; wgm = wgm_; tA = (size_t)BM * lda * 2; tB = (size_t)BM * ldb * 2; atile = true; }
    __device__ __forceinline__ bool next(int i, Unit& u) const { int pm, pn; if (!tile_of(nM, nN, G, c, i, pm, pn, wgm)) return false; u.pm = pm; u.pn = pn; u.pz = 0; u.a = A + (size_t)pm * tA; u.b = Bt + (size_t)pn * tB; return true; }
};
struct MergeOrder {
    const char* A; const char* Bt; int G, c; static constexpr bool atile = false;
    __device__ __forceinline__ bool next(int i, Unit& u) const { int pm, pn; if (!tile_of(64, 8, G, c, i >> 1, pm, pn)) return false; u.pm = pm; u.pn = pn; u.pz = i & 1;
        u.a = A + (size_t)pm * (32 * 32768) + (size_t)(i & 1) * 16384; u.b = Bt + (size_t)pn * (256 * 2048 * 2); return true; }
};

template <class Epi, class Sched, bool HM = false>
__device__ __forceinline__ void gemm_phase(LAS unsigned char* lds, const int K, const int lda, const int ldb, const Sched& S, const Epi& E, const int wv) {
    const int tid = opaque_tid(wv), wid = __builtin_amdgcn_readfirstlane(tid >> 6), lane = tid & 63, wr = wid >> 2, wc = wid & 3, fr = lane & 15, fq = lane >> 4;
    const int nt = K / BK;
    unsigned voffA[2], voffB[2];
#pragma unroll
    for (int i = 0; i < 2; ++i) { int R, C; stage_rc(tid * 16 + i * 8192, R, C); const int Rb = Epi::PERM ? ((R & ~31) + perm32(R & 31)) : R;
        voffA[i] = S.atile ? (unsigned)(tid * 16 + i * 8192) : (unsigned)(R * lda + C) * 2u; voffB[i] = (unsigned)(tid * 16 + i * 8192); (void)Rb; }
    const size_t kstep = S.atile ? (size_t)(2 * HTB) : (size_t)(BK * 2), kstepB = (size_t)(2 * HTB);
    const size_t hstepA = HM ? (size_t)0 : (S.atile ? (size_t)HTB : (size_t)HALF * lda * 2), hstepB = (size_t)HTB;
    const unsigned ldsw = (unsigned)wid * 1024u;
    const int aoff = lds_byte(wr * 64 + fr, fq * 8), boff = lds_byte(wc * 32 + fr, fq * 8);
#define PG8_SA(b, h) (((b) * 2 + (h)) * HTB)
#define PG8_SB(b, h) ((4 + (b) * 2 + (h)) * HTB)
#define PG8_STAGE(bufoff, gbase, voff) do { _Pragma("unroll") for (int _i = 0; _i < 2; ++_i) \
        __builtin_amdgcn_global_load_lds((const unsigned*)((const char*)(gbase) + (voff)[_i]), (LAS unsigned*)(lds + (bufoff) + ldsw + _i * 8192), 16, 0, 0); } while (0)
#define PG8_LDA(dst, b, h) do { _Pragma("unroll") for (int m = 0; m < 4; ++m) _Pragma("unroll") for (int k = 0; k < 2; ++k) dst[m][k] = *(const LAS bf16x8*)(lds + PG8_SA(b, h) + aoff + m * 2048 + k * 1024); } while (0)
#define PG8_LDB(dst, b, h) do { _Pragma("unroll") for (int n = 0; n < 2; ++n) _Pragma("unroll") for (int k = 0; k < 2; ++k) dst[n][k] = *(const LAS bf16x8*)(lds + PG8_SB(b, h) + boff + n * 2048 + k * 1024); } while (0)
#define PG8_MMA(ai, bj, At, Bt) do { __builtin_amdgcn_s_setprio(1); _Pragma("unroll") for (int m = 0; m < 4; ++m) _Pragma("unroll") for (int n = 0; n < 2; ++n) _Pragma("unroll") for (int k = 0; k < 2; ++k) \
        acc[ai][bj][m][n] = __builtin_amdgcn_mfma_f32_16x16x32_bf16(Bt[n][k], At[m][k], acc[ai][bj][m][n], 0, 0, 0); __builtin_amdgcn_s_setprio(0); } while (0)
#define PG8_WAIT_V(n) asm volatile("s_waitcnt vmcnt(" #n ")" ::: "memory")
#define PG8_WAIT_L(n) asm volatile("s_waitcnt lgkmcnt(" #n ")" ::: "memory")
#define PG8_BAR __builtin_amdgcn_s_barrier()
#define PG8_SCHED __builtin_amdgcn_sched_barrier(0)
    Unit cur, nxt; int ui = 0;
    if (!S.next(0, cur)) return;
    f32x4 acc[2][2][4][2];
#pragma unroll
    for (int a = 0; a < 2; ++a)
#pragma unroll
        for (int b = 0; b < 2; ++b)
#pragma unroll
            for (int m = 0; m < 4; ++m)
#pragma unroll
                for (int n = 0; n < 2; ++n) acc[a][b][m][n] = (f32x4){0.f, 0.f, 0.f, 0.f};
    bf16x8 At[4][2], B0[2][2], B1[2][2];
    const char* cA = cur.a; const char* cB = cur.b;
    PG8_STAGE(PG8_SB(0, 0), cB, voffB); PG8_STAGE(PG8_SB(0, 1), cB + hstepB, voffB); PG8_STAGE(PG8_SA(0, 0), cA, voffA); PG8_STAGE(PG8_SA(0, 1), cA + hstepA, voffA);
    if (wr == 1) PG8_BAR;
    PG8_WAIT_V(2); PG8_BAR;
    PG8_STAGE(PG8_SB(1, 0), cB + kstepB, voffB); PG8_STAGE(PG8_SA(1, 0), cA + kstep, voffA); PG8_STAGE(PG8_SB(1, 1), cB + hstepB + kstepB, voffB);
    PG8_WAIT_V(6); PG8_BAR;
    for (;;) {
        const bool has_next = S.next(ui + 1, nxt);
        const char* nA = has_next ? nxt.a : cA; const char* nB = has_next ? nxt.b : cB;
        for (int t = 0; t < nt; t += 2) {
            const bool last = (t == nt - 2);
            const char* a1 = cA + (size_t)(t + 1) * kstep;
            const char* a2 = last ? nA : cA + (size_t)(t + 2) * kstep; const char* b2 = last ? nB : cB + (size_t)(t + 2) * kstepB;
            const char* a3 = a2 + kstep; const char* b3 = b2 + kstepB;
            PG8_LDB(B0, 0, 0); PG8_LDB(B1, 0, 1); PG8_SCHED; PG8_LDA(At, 0, 0); PG8_STAGE(PG8_SA(1, 1), a1 + hstepA, voffA);
            PG8_WAIT_V(8); PG8_WAIT_L(0); PG8_BAR; PG8_MMA(0, 0, At, B0); PG8_MMA(0, 1, At, B1); PG8_BAR; PG8_SCHED;
            if constexpr (!HM) PG8_LDA(At, 0, 1); PG8_STAGE(PG8_SB(0, 0), b2, voffB); PG8_STAGE(PG8_SB(0, 1), b2 + hstepB, voffB); PG8_STAGE(PG8_SA(0, 0), a2, voffA);
            PG8_WAIT_V(8); PG8_WAIT_L(0); PG8_BAR; if constexpr (!HM) { PG8_MMA(1, 0, At, B0); PG8_MMA(1, 1, At, B1); } PG8_BAR; PG8_SCHED;
            PG8_LDB(B0, 1, 0); PG8_LDB(B1, 1, 1); PG8_SCHED; PG8_LDA(At, 1, 0); PG8_STAGE(PG8_SA(0, 1), a2 + hstepA, voffA);
            PG8_WAIT_V(8); PG8_WAIT_L(0); PG8_BAR; PG8_MMA(0, 0, At, B0); PG8_MMA(0, 1, At, B1); PG8_BAR; PG8_SCHED;
            if constexpr (!HM) PG8_LDA(At, 1, 1); PG8_STAGE(PG8_SB(1, 0), b3, voffB); PG8_STAGE(PG8_SB(1, 1), b3 + hstepB, voffB); PG8_STAGE(PG8_SA(1, 0), a3, voffA);
            PG8_WAIT_V(8); PG8_WAIT_L(0); PG8_BAR; if constexpr (!HM) { PG8_MMA(1, 0, At, B0); PG8_MMA(1, 1, At, B1); } PG8_BAR; PG8_SCHED;
            if constexpr (HM) { if (((t + 2) & 7) == 0) E.fold(acc, cur, t >> 3, wr, wc, fr, fq); }
        }
        if (wr == 0) PG8_BAR;
        E(acc, cur, wr, wc, fr, fq);
        if (!has_next) break;
#pragma unroll
        for (int a = 0; a < 2; ++a)
#pragma unroll
            for (int b = 0; b < 2; ++b)
#pragma unroll
                for (int m = 0; m < 4; ++m)
#pragma unroll
                    for (int n = 0; n < 2; ++n) acc[a][b][m][n] = (f32x4){0.f, 0.f, 0.f, 0.f};
        cur = nxt; cA = nA; cB = nB; ++ui;
        if (wr == 1) PG8_BAR;
    }
    PG8_WAIT_V(0);
    PG8_BAR;
#undef PG8_SA
#undef PG8_SB
#undef PG8_STAGE
#undef PG8_LDA
#undef PG8_LDB
#undef PG8_MMA
#undef PG8_WAIT_V
#undef PG8_WAIT_L
#undef PG8_BAR
#undef PG8_SCHED
}

template <class Epi, class Sched>
__device__ __forceinline__ void gemm_hm3(LAS unsigned char* lds, const int K, const int lda, const int ldb, const Sched& S, const Epi& E, const int wv) {
    const int tid = opaque_tid(wv), wid = __builtin_amdgcn_readfirstlane(tid >> 6), lane = tid & 63, wr = wid >> 2, wc = wid & 3, fr = lane & 15, fq = lane >> 4;
    const int nt = K / BK;
    unsigned voffA[2], voffB[2];
#pragma unroll
    for (int i = 0; i < 2; ++i) { int R, C; stage_rc(tid * 16 + i * 8192, R, C); const int Rb = Epi::PERM ? ((R & ~31) + perm32(R & 31)) : R;
        voffA[i] = (unsigned)(tid * 16 + i * 8192); voffB[i] = voffA[i]; (void)R; (void)C; (void)Rb; }
    const size_t kstep = (size_t)(2 * HTB), kstepB = (size_t)(2 * HTB), hstepB = (size_t)HTB;
    const unsigned ldsw = (unsigned)wid * 1024u;
    const int aoff = lds_byte(wr * 64 + fr, fq * 8), boff = lds_byte(wc * 32 + fr, fq * 8);
    constexpr int SLOT = 3 * HTB;
#define H3_STAGE(off, gbase, voff) do { _Pragma("unroll") for (int _i = 0; _i < 2; ++_i) \
        __builtin_amdgcn_global_load_lds((const unsigned*)((const char*)(gbase) + (voff)[_i]), (LAS unsigned*)(lds + (off) + ldsw + _i * 8192), 16, 0, 0); } while (0)
#define H3_STAGE3(sl, ga, gb) do { H3_STAGE((sl), (gb), voffB); H3_STAGE((sl) + HTB, (gb) + hstepB, voffB); H3_STAGE((sl) + 2 * HTB, (ga), voffA); } while (0)
#define H3_LDA(dst, sl) do { _Pragma("unroll") for (int m = 0; m < 4; ++m) _Pragma("unroll") for (int k = 0; k < 2; ++k) dst[m][k] = *(const LAS bf16x8*)(lds + (sl) + 2 * HTB + aoff + m * 2048 + k * 1024); } while (0)
#define H3_LDB(dst, sl, h) do { _Pragma("unroll") for (int n = 0; n < 2; ++n) _Pragma("unroll") for (int k = 0; k < 2; ++k) dst[n][k] = *(const LAS bf16x8*)(lds + (sl) + (h) * HTB + boff + n * 2048 + k * 1024); } while (0)
#define H3_MMA(bj, At, Bt) do { __builtin_amdgcn_s_setprio(1); _Pragma("unroll") for (int m = 0; m < 4; ++m) _Pragma("unroll") for (int n = 0; n < 2; ++n) _Pragma("unroll") for (int k = 0; k < 2; ++k) \
        acc[0][bj][m][n] = __builtin_amdgcn_mfma_f32_16x16x32_bf16(Bt[n][k], At[m][k], acc[0][bj][m][n], 0, 0, 0); __builtin_amdgcn_s_setprio(0); } while (0)
#define H3_BAR __builtin_amdgcn_s_barrier()
    Unit cur, nxt; int ui = 0;
    if (!S.next(0, cur)) return;
    f32x4 acc[2][2][4][2];
#pragma unroll
    for (int a = 0; a < 2; ++a)
#pragma unroll
        for (int b = 0; b < 2; ++b)
#pragma unroll
            for (int m = 0; m < 4; ++m)
#pragma unroll
                for (int n = 0; n < 2; ++n) acc[a][b][m][n] = (f32x4){0.f, 0.f, 0.f, 0.f};
    bf16x8 At[4][2], B0[2][2], B1[2][2]; u32x2 gw[4][2];
    const char* cA = cur.a; const char* cB = cur.b;
    int sl = 0, sl2 = 2 * SLOT;
    H3_STAGE3(0, cA, cB); H3_STAGE3(SLOT, cA + kstep, cB + kstepB);
    asm volatile("s_waitcnt vmcnt(6)" ::: "memory"); H3_BAR;
    if (wr == 1) H3_BAR;
    for (;;) {
        const bool has_next = S.next(ui + 1, nxt);
        const char* nA = has_next ? nxt.a : cA; const char* nB = has_next ? nxt.b : cB;
        for (int t = 0; t < nt; ++t) {
            const bool own = (t + 2 < nt);
            const char* a2 = (own ? cA : nA) + (size_t)(own ? t + 2 : t + 2 - nt) * kstep; const char* b2 = (own ? cB : nB) + (size_t)(own ? t + 2 : t + 2 - nt) * kstepB;
            H3_LDB(B0, sl, 0); H3_LDB(B1, sl, 1); __builtin_amdgcn_sched_barrier(0); H3_LDA(At, sl); H3_STAGE3(sl2, a2, b2);
            const int ph_ = t & 7;
            if (ph_ == 6) { E.fold_load(gw, cur, t >> 3, wr, wc, fr, fq); __builtin_amdgcn_sched_barrier(0); }
            if (ph_ >= 6) asm volatile("s_waitcnt vmcnt(14)" ::: "memory"); else asm volatile("s_waitcnt vmcnt(6)" ::: "memory");
            asm volatile("s_waitcnt lgkmcnt(0)" ::: "memory"); H3_BAR; H3_MMA(0, At, B0); H3_MMA(1, At, B1); H3_BAR; __builtin_amdgcn_sched_barrier(0);
            sl = (sl == 2 * SLOT) ? 0 : sl + SLOT; sl2 = (sl2 == 2 * SLOT) ? 0 : sl2 + SLOT;
            if (ph_ == 7) E.fold_apply(acc, gw, t >> 3);
        }
        if (wr == 0) H3_BAR;
        E(acc, cur, wr, wc, fr, fq);
        if (!has_next) break;
#pragma unroll
        for (int a = 0; a < 2; ++a)
#pragma unroll
            for (int b = 0; b < 2; ++b)
#pragma unroll
                for (int m = 0; m < 4; ++m)
#pragma unroll
                    for (int n = 0; n < 2; ++n) acc[a][b][m][n] = (f32x4){0.f, 0.f, 0.f, 0.f};
        cur = nxt; cA = nA; cB = nB; ++ui;
        if (wr == 1) H3_BAR;
    }
    asm volatile("s_waitcnt vmcnt(0)" ::: "memory");
    H3_BAR;
#undef H3_STAGE
#undef H3_STAGE3
#undef H3_LDA
#undef H3_LDB
#undef H3_MMA
#undef H3_BAR
}

__device__ __forceinline__ float silu_f(float a) { return a * __builtin_amdgcn_rcpf(1.0f + __builtin_amdgcn_exp2f(-a * LOG2E)); }
__device__ __forceinline__ float sigm_f(float a) { return __builtin_amdgcn_rcpf(1.0f + __builtin_amdgcn_exp2f(-a * LOG2E)); }
__device__ __forceinline__ unsigned gq8(float g) { return (unsigned)(g * 255.0f + 0.5f); }
__device__ __forceinline__ unsigned gq8x4(float a, float b, float c, float d) { return gq8(a) | (gq8(b) << 8) | (gq8(c) << 16) | (gq8(d) << 24); }

struct EpiSwiGLU {
    static constexpr bool PERM = true;
    bf16_t* O; const float* ss; const float* bwl;
    __device__ __forceinline__ void operator()(const f32x4 (&acc)[2][2][4][2], const Unit& u, int wr, int wc, int fr, int fq) const {
        const int row0 = u.pm * BM + wr * 64 + fr, col0 = u.pn * 128 + wc * 32 + 8 * fq;
        const float* bw = bwl + (size_t)brow_of(u.pm * BM) * BWL + u.pn * BM + wc * 32 + 8 * fq;
        const f32x4 ba0 = *(const f32x4*)bw, ba1 = *(const f32x4*)(bw + 4), bb0 = *(const f32x4*)(bw + HALF), bb1 = *(const f32x4*)(bw + HALF + 4);
        float rsv[2][4];
#pragma unroll
        for (int ai = 0; ai < 2; ++ai)
#pragma unroll
            for (int m = 0; m < 4; ++m) rsv[ai][m] = ss[row0 + ai * HALF + m * 16];
#pragma unroll
        for (int ai = 0; ai < 2; ++ai)
#pragma unroll
            for (int m = 0; m < 4; ++m) rsv[ai][m] = __builtin_amdgcn_rsqf(rsv[ai][m] * (1.0f / DM) + EPS);
#pragma unroll
        for (int ai = 0; ai < 2; ++ai)
#pragma unroll
            for (int m = 0; m < 4; ++m) { const int row = row0 + ai * HALF + m * 16; const float rs = rsv[ai][m];
                const f32x4 a0 = acc[ai][0][m][0] * rs + ba0, a1 = acc[ai][0][m][1] * rs + ba1, b0 = acc[ai][1][m][0] * rs + bb0, b1 = acc[ai][1][m][1] * rs + bb1;
                u32x4 w;
                w.x = pk2(silu_f(a0[0]) * b0[0], silu_f(a0[1]) * b0[1]); w.y = pk2(silu_f(a0[2]) * b0[2], silu_f(a0[3]) * b0[3]);
                w.z = pk2(silu_f(a1[0]) * b1[0], silu_f(a1[1]) * b1[1]); w.w = pk2(silu_f(a1[2]) * b1[2], silu_f(a1[3]) * b1[3]);
                *(u32x4*)((char*)O + atile_off(row, col0, DFF / 64)) = w;
            }
    }
};
struct EpiResid {
    static constexpr bool PERM = true;
    const float* base_p; const float* base_s;
    float* xf; float* out;
    const float* mod_l; int gofs; float coef; int rowbase;
    bf16_t* xa; const float* atab; float* ssn;
    __device__ __forceinline__ void operator()(const f32x4 (&acc)[2][2][4][2], const Unit& u, int wr, int wc, int fr, int fq) const {
        const int rabs0 = rowbase + u.pm * BM; const int br = brow_of(rabs0);
        const float* base = rabs0 < 32768 ? base_p : base_s;
        const float* g = mod_l + (size_t)br * NMODC + gofs;
        const int row0 = rabs0 + wr * 64 + fr, col0 = u.pn * BM + wc * 32 + 8 * fq;
        float* xt = xf + ((size_t)((rabs0 >> 8) * 8 + u.pn) << 16) + ((wr * 4 + wc) * 64 + fq * 16 + fr) * 4;
        f32x4 gv[2][2], av[2][2];
#pragma unroll
        for (int bj = 0; bj < 2; ++bj)
#pragma unroll
            for (int n = 0; n < 2; ++n) { gv[bj][n] = *(const f32x4*)(g + col0 + bj * HALF + n * 4) * coef; av[bj][n] = xa ? *(const f32x4*)(atab + (size_t)br * DM + col0 + bj * HALF + n * 4) : (f32x4){0.f, 0.f, 0.f, 0.f}; }
#pragma unroll
        for (int aq = 0; aq < 4; ++aq) { const int ai = aq >> 1, mb = (aq & 1) * 2;
            f32x4 bs[2][2][2];
#pragma unroll
            for (int mi = 0; mi < 2; ++mi) { const size_t off = (size_t)(row0 + ai * HALF + (mb + mi) * 16) * DM + col0; const int pc = ((ai * 4 + mb + mi) * 2) * 2;
#pragma unroll
                for (int bj = 0; bj < 2; ++bj)
#pragma unroll
                    for (int n = 0; n < 2; ++n) bs[mi][bj][n] = base_p ? __builtin_nontemporal_load((const f32x4*)(base + off + bj * HALF + n * 4)) : __builtin_nontemporal_load((const f32x4*)(xt + (pc + bj * 2 + n) * 2048)); }
#pragma unroll
            for (int mi = 0; mi < 2; ++mi) { const int m = mb + mi; const size_t off = (size_t)(row0 + ai * HALF + m * 16) * DM + col0; const int pc = ((ai * 4 + m) * 2) * 2; float sq = 0.f;
#pragma unroll
                for (int bj = 0; bj < 2; ++bj) { const f32x4 x0 = bs[mi][bj][0] + gv[bj][0] * acc[ai][bj][m][0], x1 = bs[mi][bj][1] + gv[bj][1] * acc[ai][bj][m][1];
                    if (out) { __builtin_nontemporal_store(x0, (f32x4*)(out + off + bj * HALF)); __builtin_nontemporal_store(x1, (f32x4*)(out + off + bj * HALF + 4)); }
                    else { __builtin_nontemporal_store(x0, (f32x4*)(xt + (pc + bj * 2) * 2048)); __builtin_nontemporal_store(x1, (f32x4*)(xt + (pc + bj * 2 + 1) * 2048)); }
                    if (xa) { const f32x4 y0 = x0 * av[bj][0], y1 = x1 * av[bj][1]; u32x4 w; w.x = pk2(y0[0], y0[1]); w.y = pk2(y0[2], y0[3]); w.z = pk2(y1[0], y1[1]); w.w = pk2(y1[2], y1[3]);
                              *(u32x4*)((char*)xa + atile_off(row0 + ai * HALF + m * 16, col0 + bj * HALF, DM / 64)) = w;
                              sq += ((x0[0] * x0[0] + x0[1] * x0[1]) + (x0[2] * x0[2] + x0[3] * x0[3])) + ((x1[0] * x1[0] + x1[1] * x1[1]) + (x1[2] * x1[2] + x1[3] * x1[3])); } }
                if (xa) {
                    sq += __uint_as_float((unsigned)__builtin_amdgcn_ds_swizzle((int)__float_as_uint(sq), (16 << 10) | 0x1f)); sq = swap_sum(sq);
                    if (fq == 0) atomicAdd(ssn + row0 + ai * HALF + m * 16, sq); } }
        }
    }
};
struct EpiInProj {
    static constexpr bool PERM = true;
    bf16_t* Z; bf16_t* G; const float* bgate; int tmask; const float* ss; const float* bw; int rowbase;
    __device__ __forceinline__ void operator()(const f32x4 (&acc)[2][2][4][2], const Unit& u, int wr, int wc, int fr, int fq) const {
        const int row0 = u.pm * BM + wr * 64 + fr;
        const float* bwp = bw + (size_t)brow_of(rowbase + u.pm * BM) * BWL + u.pn * BM + wc * 32 + 8 * fq;
        const f32x4 bq00 = *(const f32x4*)bwp, bq01 = *(const f32x4*)(bwp + 4), bq10 = *(const f32x4*)(bwp + HALF), bq11 = *(const f32x4*)(bwp + HALF + 4);
        float rsv[2][4];
#pragma unroll
        for (int ai = 0; ai < 2; ++ai)
#pragma unroll
            for (int m = 0; m < 4; ++m) rsv[ai][m] = ss[rowbase + row0 + ai * HALF + m * 16];
#pragma unroll
        for (int ai = 0; ai < 2; ++ai)
#pragma unroll
            for (int m = 0; m < 4; ++m) rsv[ai][m] = __builtin_amdgcn_rsqf(rsv[ai][m] * (1.0f / DM) + EPS);
        if (u.pn < 32) {
            const int col0 = u.pn * BM + wc * 32 + 8 * fq;
            const bool ropet = (u.pn >= 8 && u.pn < 12) || (u.pn >= 14 && u.pn < 26);
            const bool rot = ropet && ((wc & 1) == 0) && (fq < 2);
            float rc0[4] = {0.f, 0.f, 0.f, 0.f}, rc1[4] = {0.f, 0.f, 0.f, 0.f};
            if (rot) {
#pragma unroll
                for (int e = 0; e < 4; ++e) { rc0[e] = fq ? ROPE_C0[4 + e] : ROPE_C0[e]; rc1[e] = fq ? ROPE_C1[4 + e] : ROPE_C1[e]; } }
#pragma unroll
            for (int ai = 0; ai < 2; ++ai)
#pragma unroll
                for (int m = 0; m < 4; ++m) { const int row = row0 + ai * HALF + m * 16; const float rs = rsv[ai][m];
                    float cc[4] = {1.f, 1.f, 1.f, 1.f}, sn[4] = {0.f, 0.f, 0.f, 0.f};
                    if (rot) { const int pos = row & tmask; const float ph = (float)(pos >> 7), pl = (float)(pos & 127);
#pragma unroll
                        for (int e = 0; e < 4; ++e) { const float c0 = rc0[e], c1 = rc1[e];
                            float rev = ph * c1 + pl * c0; rev = rev - __builtin_floorf(rev); cc[e] = __builtin_amdgcn_cosf(rev); sn[e] = __builtin_amdgcn_sinf(rev); } }
#pragma unroll
                    for (int bj = 0; bj < 2; ++bj) { f32x4 v0 = acc[ai][bj][m][0] * rs + (bj ? bq10 : bq00), v1 = acc[ai][bj][m][1] * rs + (bj ? bq11 : bq01);
                        if (u.pn == 2 || u.pn == 3 || u.pn == 8 || u.pn == 9 || (u.pn >= 14 && u.pn < 20)) { v0 *= C2; v1 *= C2; }
                        if (rot) {
#pragma unroll
                            for (int e = 0; e < 4; ++e) { const float x1 = v0[e], x2 = v1[e]; v0[e] = x1 * cc[e] - x2 * sn[e]; v1[e] = x2 * cc[e] + x1 * sn[e]; } }
                        u32x4 w; w.x = pk2(v0[0], v0[1]); w.y = pk2(v0[2], v0[3]); w.z = pk2(v1[0], v1[1]); w.w = pk2(v1[2], v1[3]);
                        *(u32x4*)(Z + zoff(row, col0 + bj * HALF)) = w; } }
        } else {
            const int col0 = (u.pn - 32) * BM + wc * 32 + 8 * fq;
            f32x4 bv[2][2];
#pragma unroll
            for (int bj = 0; bj < 2; ++bj)
#pragma unroll
                for (int n = 0; n < 2; ++n) bv[bj][n] = *(const f32x4*)(bgate + col0 + bj * HALF + 4 * n);
#pragma unroll
            for (int ai = 0; ai < 2; ++ai)
#pragma unroll
                for (int m = 0; m < 4; ++m) { const int row = row0 + ai * HALF + m * 16; const float rs = rsv[ai][m];
#pragma unroll
                    for (int bj = 0; bj < 2; ++bj) { const f32x4 v0 = acc[ai][bj][m][0] * rs + (bv[bj][0] + (bj ? bq10 : bq00)), v1 = acc[ai][bj][m][1] * rs + (bv[bj][1] + (bj ? bq11 : bq01));
                        u32x2 w; w.x = gq8x4(sigm_f(v0[0]), sigm_f(v0[1]), sigm_f(v0[2]), sigm_f(v0[3])); w.y = gq8x4(sigm_f(v1[0]), sigm_f(v1[1]), sigm_f(v1[2]), sigm_f(v1[3]));
                        __builtin_nontemporal_store(w, (u32x2*)((unsigned char*)G + ((size_t)(u.pm * 32 + (u.pn - 32)) << 16) + ai * 32768 + (m * 2 + bj) * 4096 + (wr * 4 + wc) * 512 + (fq * 16 + fr) * 8)); } }
        }
    }
};
struct EpiMerge {
    static constexpr bool PERM = true;
    const bf16_t* G; bf16_t* Mg;
    __device__ __forceinline__ void fold_load(u32x2 (&gw)[4][2], const Unit& u, int n, int wr, int wc, int fr, int fq) const {
        const int row0 = u.pm * BM + u.pz * HALF + wr * 64 + fr, col0 = u.pn * BM + wc * 32 + 8 * fq;
#pragma unroll
        for (int m = 0; m < 4; ++m)
#pragma unroll
            for (int bj = 0; bj < 2; ++bj) gw[m][bj] = __builtin_nontemporal_load((const u32x2*)((const unsigned char*)G + ((size_t)(u.pm * 32 + n * 8 + u.pn) << 16) + u.pz * 32768 + (m * 2 + bj) * 4096 + (wr * 4 + wc) * 512 + (fq * 16 + fr) * 8));
    }
    __device__ __forceinline__ void fold_apply(f32x4 (&acc)[2][2][4][2], const u32x2 (&gw)[4][2], int n) const {
#pragma unroll
        for (int m = 0; m < 4; ++m)
#pragma unroll
            for (int bj = 0; bj < 2; ++bj) { const u32x2 g = gw[m][bj]; f32x4& v0 = acc[0][bj][m][0]; f32x4& v1 = acc[0][bj][m][1];
                const f32x4 g0 = (f32x4){(float)(g.x & 255u), (float)((g.x >> 8) & 255u), (float)((g.x >> 16) & 255u), (float)(g.x >> 24)} * (1.0f / 255.0f);
                const f32x4 g1 = (f32x4){(float)(g.y & 255u), (float)((g.y >> 8) & 255u), (float)((g.y >> 16) & 255u), (float)(g.y >> 24)} * (1.0f / 255.0f);
                if (n == 0) { acc[1][bj][m][0] = g0 * v0; acc[1][bj][m][1] = g1 * v1; }
                else { acc[1][bj][m][0] += g0 * v0; acc[1][bj][m][1] += g1 * v1; }
                v0 = (f32x4){0.f, 0.f, 0.f, 0.f}; v1 = (f32x4){0.f, 0.f, 0.f, 0.f}; }
    }
    __device__ __forceinline__ void fold(f32x4 (&acc)[2][2][4][2], const Unit& u, int n, int wr, int wc, int fr, int fq) const { u32x2 gw[4][2]; fold_load(gw, u, n, wr, wc, fr, fq); fold_apply(acc, gw, n); }
    __device__ __forceinline__ void operator()(const f32x4 (&acc)[2][2][4][2], const Unit& u, int wr, int wc, int fr, int fq) const {
        const int row0 = u.pm * BM + u.pz * HALF + wr * 64 + fr, col0 = u.pn * BM + wc * 32 + 8 * fq;
#pragma unroll
        for (int m = 0; m < 4; ++m)
#pragma unroll
            for (int bj = 0; bj < 2; ++bj) { const f32x4 v0 = acc[1][bj][m][0], v1 = acc[1][bj][m][1];
                u32x4 w; w.x = pk2(v0[0], v0[1]); w.y = pk2(v0[2], v0[3]); w.z = pk2(v1[0], v1[1]); w.w = pk2(v1[2], v1[3]);
                *(u32x4*)((char*)Mg + atile_off(row0 + m * 16, col0 + bj * HALF, DM / 64)) = w; }
    }
};
}

#define XB_TMO      128
#define XB_XCNT(j)  (256  + 64 * (j))
#define XB_XSUB(j)  (1280 + 64 * (j))
#define XB_XGEN(j)  (2304 + 64 * (j))
#define XB_TOP      3328
#define XB_TOPGEN   3392
#define XCD_BAR_WORDS 3456
#define XB_SPIN_CAP (1u << 24)
__device__ __forceinline__ unsigned xb_ld(unsigned* p)              { return __hip_atomic_load(p, __ATOMIC_RELAXED, __HIP_MEMORY_SCOPE_AGENT); }
__device__ __forceinline__ unsigned xb_add(unsigned* p, unsigned v) { return __hip_atomic_fetch_add(p, v, __ATOMIC_RELAXED, __HIP_MEMORY_SCOPE_AGENT); }
__device__ __forceinline__ unsigned xb_xcc_id() { return (unsigned)__builtin_amdgcn_s_getreg((3 << 11) | 20) & 0xFu; }
#define XB_SPIN(cond, bar) do { unsigned _sp = 0; while (cond) { __builtin_amdgcn_s_sleep(1); \
    if ((++_sp & 255u) == 0u) { if (xb_ld(&(bar)[XB_TMO])) break; if (_sp > XB_SPIN_CAP) { atomicAdd(&(bar)[XB_TMO], 1u); break; } } } } while (0)
struct XcdBarrier { unsigned* bar; unsigned x; volatile LAS unsigned* st; int wv; };
__device__ __forceinline__ XcdBarrier xcd_barrier_post(unsigned* bar, volatile LAS unsigned* st, int wv) {
    XcdBarrier b; b.bar = bar; b.x = xb_xcc_id(); b.st = st; b.wv = wv;
    if (opaque_tid(wv) == 0) (void)xb_add(&bar[XB_XCNT(b.x)], 1u);
    return b;
}
__device__ __forceinline__ void xcd_barrier_complete(unsigned* bar, unsigned x, unsigned& nloc, unsigned& nx) {
    const unsigned G = gridDim.x * gridDim.y * gridDim.z;
    unsigned sum, cnt, mine, sp = 0u;
    for (;;) {
        sum = 0u; cnt = 0u; mine = 0u;
#pragma unroll
        for (unsigned j = 0; j < 16; ++j) { const unsigned c = xb_ld(&bar[XB_XCNT(j)]); sum += c; cnt += (c > 0u) ? 1u : 0u; mine = (j == x) ? c : mine; }
        if (sum == G) break;
        __builtin_amdgcn_s_sleep(1);
        if ((++sp & 255u) == 0u) { if (xb_ld(&bar[XB_TMO])) break; if (sp > XB_SPIN_CAP) { atomicAdd(&bar[XB_TMO], 1u); break; } }
    }
    nloc = mine > 0u ? mine : 1u; nx = cnt > 0u ? cnt : 1u;
}
__device__ __forceinline__ void xcd_barrier(const XcdBarrier& b) {
    asm volatile("s_waitcnt vmcnt(0)" ::: "memory");
    __syncthreads();
    if (opaque_tid(b.wv) == 0) {
        unsigned* bar = b.bar;
        __builtin_amdgcn_s_waitcnt(0);
        unsigned nloc = b.st[0], nx = b.st[1];
        if (nloc == 0u) { xcd_barrier_complete(bar, b.x, nloc, nx); b.st[0] = nloc; b.st[1] = nx; }
        const unsigned old = xb_add(&bar[XB_XSUB(b.x)], 1u);
        const unsigned gen = old / nloc;
        if (old + 1u == (gen + 1u) * nloc) {
            __builtin_amdgcn_fence(__ATOMIC_RELEASE, "agent");
            asm volatile("s_waitcnt vmcnt(0)" ::: "memory");
            const unsigned og = xb_add(&bar[XB_TOP], 1u);
            const unsigned tg = og / nx;
            if (og + 1u == (tg + 1u) * nx) xb_add(&bar[XB_TOPGEN], 1u);
            else XB_SPIN(xb_ld(&bar[XB_TOPGEN]) == tg, bar);
            __builtin_amdgcn_fence(__ATOMIC_ACQUIRE, "agent");
            xb_add(&bar[XB_XGEN(b.x)], 1u);
            asm volatile("s_waitcnt vmcnt(0)" ::: "memory");
        } else {
            XB_SPIN(xb_ld(&bar[XB_XGEN(b.x)]) == gen, bar);
            __builtin_amdgcn_fence(__ATOMIC_ACQUIRE, "agent");
            asm volatile("s_waitcnt vmcnt(0)" ::: "memory");
        }
    }
    __syncthreads();
}

struct Args { const float* in[24]; float* out; unsigned char* ws; int ph_lo, ph_hi, li, pad; };
typedef const __attribute__((address_space(4))) Args KArgs;
__device__ __forceinline__ KArgs* kargs() { KArgs* p = (KArgs*)__builtin_amdgcn_kernarg_segment_ptr(); asm volatile("" : "+s"(p)); return p; }
enum { I_XP = 0, I_XS, I_CP, I_CS, I_WADA, I_BADA, I_GFF1, I_WFF1I, I_WFF1O, I_GMIX, I_WIN, I_BGATE, I_RELB, I_LQ1, I_LK1, I_LQ2, I_LK2, I_DLNG, I_WBR, I_WOUT, I_GFF2, I_WFF2I, I_WFF2O, I_GFIN };

__device__ __forceinline__ int srcmap(int kind, int v) {
    if (kind == 1) return ((v >> 7) & 1) * DFF + (v >> 8) * 128 + (v & 127);
    if (kind == 2) { const int o = v; const bool rp = (o >= 2048 && o < 3072) || (o >= 3584 && o < 6656);
        if (rp && (o & 63) < 16) { const int d = o & 15; const int pd = (d & 3) | ((d & 4) << 1) | ((d & 8) >> 1); return (o & ~15) + pd; }
        return o; }
    return v;
}
__device__ __forceinline__ void conv_tile(const float* src, int ldsrc, bf16_t* dst, int K, int v0, int k0, int kind, LAS float* tile, int tid) {
    __syncthreads();
#pragma unroll
    for (int i = 0; i < 8; ++i) { const int idx = tid + 512 * i, kk = idx >> 6, vv = idx & 63;
        tile[vv * 65 + kk] = src[(size_t)(k0 + kk) * ldsrc + srcmap(kind, v0 + vv)]; }
    __syncthreads();
    const int vv = tid >> 3, kc = tid & 7; const LAS float* s = tile + vv * 65 + kc * 8;
    u32x4 o; o.x = pk2(s[0], s[1]); o.y = pk2(s[2], s[3]); o.z = pk2(s[4], s[5]); o.w = pk2(s[6], s[7]);
    *(u32x4*)((char*)dst + pg8::wtile_off(v0 + vv, k0 + kc * 8, K >> 6)) = o;
}
__device__ __forceinline__ void fold_tile(const float* win_l, bf16_t* dst, int v0, int k0, LAS float* S  , LAS float* tc, LAS float* tsn, int tid) {
    __syncthreads();
    if (tid < 128) { const float x = (float)tid * (1.0f / 128.0f); tc[tid] = __builtin_amdgcn_cosf(x) * 0.08838834764831843f; tsn[tid] = __builtin_amdgcn_sinf(x) * 0.08838834764831843f; }
    const int g = v0 >> 8, isq = (v0 >> 7) & 1, cp0 = v0 & 127;
#pragma unroll
    for (int i = 0; i < 16; ++i) { const int idx = tid + 512 * i, kk = idx >> 7, c = idx & 127;
        S[kk * 129 + c] = win_l[(size_t)(k0 + kk) * 16384 + g * 128 + c]; }
    __syncthreads();
    const int vv = tid >> 3, kc = tid & 7, cp = cp0 + vv; const LAS float* tr = isq ? tsn : tc;
    float o[8] = {0.f, 0.f, 0.f, 0.f, 0.f, 0.f, 0.f, 0.f};
    for (int c = 0; c < 128; ++c) { const float w = tr[(c * cp) & 127];
#pragma unroll
        for (int j = 0; j < 8; ++j) o[j] += S[(kc * 8 + j) * 129 + c] * w; }
    u32x4 ov; ov.x = pk2(o[0], o[1]); ov.y = pk2(o[2], o[3]); ov.z = pk2(o[4], o[5]); ov.w = pk2(o[6], o[7]);
    *(u32x4*)(dst + (size_t)(v0 + vv) * DM + k0 + kc * 8) = ov;
}
__device__ __forceinline__ bf16_t fftm_bf1(float x) { return (bf16_t)(pk2(x, 0.f) & 0xffffu); }
__constant__ double ROPE_INV[8] = {1.0, 0.19392274474868576, 0.03760603093086393, 0.007292664737217109, 0.001414213562373095, 0.0002742481756762073, 5.318295896944988e-05, 1.031338537721246e-05};

__device__ __forceinline__ void ada_task(KArgs& a, int l, int jb, float* mod, LAS float* sc  , LAS float* red  , int tid) {
    __syncthreads();
#pragma unroll 1
    for (int i0 = 0; i0 < 6 * DM; i0 += 8 * 512) {
        float cv[8];
#pragma unroll
        for (int j = 0; j < 8; ++j) { const int i = i0 + j * 512 + tid, br = i >> 11, k = i & 2047; cv[j] = br < 2 ? a.in[I_CP][br * DM + k] : a.in[I_CS][(br - 2) * DM + k]; }
#pragma unroll
        for (int j = 0; j < 8; ++j) sc[i0 + j * 512 + tid] = cv[j] * pg8::sigm_f(cv[j]); }
    __syncthreads();
    const int jq = tid & 7, kp = tid >> 3, j0 = jb * 32;
    const float* w = a.in[I_WADA] + ((size_t)l * DM + kp * 32) * NMODC + j0 + 4 * jq;
    f32x4 acc[6];
#pragma unroll
    for (int br = 0; br < 6; ++br) acc[br] = (f32x4){0.f, 0.f, 0.f, 0.f};
    for (int k = 0; k < 32; ++k) { const f32x4 wv = *(const f32x4*)(w + (size_t)k * NMODC);
#pragma unroll
        for (int br = 0; br < 6; ++br) acc[br] += wv * sc[br * DM + kp * 32 + k]; }
#pragma unroll
    for (int br = 0; br < 6; ++br) *(LAS f32x4*)(red + (kp * 6 + br) * 32 + 4 * jq) = acc[br];
    __syncthreads();
    if (tid < 192) { const int br = tid >> 5, j = tid & 31; float s = a.in[I_BADA][(size_t)l * NMODC + j0 + j];
        for (int k = 0; k < 64; ++k) s += red[(k * 6 + br) * 32 + j];
        mod[((size_t)l * 6 + br) * NMODC + j0 + j] = s; }
}

constexpr int NT_ADA = 2 * 576, NT_FOLD = 0, NT_FFI = 5504, NT_FFO = 2752, NT_IN = 8192, NT_BR = 1024, NT_OUT = 1024;
constexpr int NT_LAYER = 2 * NT_FFI + 2 * NT_FFO + NT_IN + NT_BR + NT_OUT;
constexpr int NT_ROPE = 256, NT_DFT = 40, NT_ZSS = 192, NT_LAM = 1;
constexpr int NT_PRO = NT_ADA + NT_FOLD + 2 * NT_LAYER + NT_ROPE + NT_DFT + NT_ZSS + NT_LAM;

__device__ __forceinline__ void prologue_phase(KArgs& a, LAS unsigned char* lds, int wg, int nwg, int tid) {
    unsigned char* ws = a.ws;
    float* mod = (float*)(ws + WS_MOD);
    LAS float* L = (LAS float*)lds;
    for (int t = wg; t < NT_PRO; t += nwg) {
        int r = t;
        if (r < NT_ADA) { ada_task(a, r / 576, r % 576, mod, L, L + 6 * DM, tid); continue; } r -= NT_ADA;
        if (r < NT_FOLD) { const int l = r >> 9, q = r & 511; fold_tile(a.in[I_WIN] + (size_t)l * DM * 16384, (bf16_t*)(ws + WS_W + l * WLAYER + WO_IN), (q >> 5) * 64, (q & 31) * 64, L, L + 64 * 129, L + 64 * 129 + 128, tid); continue; } r -= NT_FOLD;
        if (r < 2 * NT_LAYER) { const int l = r / NT_LAYER; int q = r % NT_LAYER; unsigned char* wl = ws + WS_W + l * WLAYER;
            if (q < NT_FFI) { conv_tile(a.in[I_WFF1I] + (size_t)l * DM * 11008, 11008, (bf16_t*)(wl + WO_FF1I), DM, (q >> 5) * 64, (q & 31) * 64, 1, L, tid); continue; } q -= NT_FFI;
            if (q < NT_FFI) { conv_tile(a.in[I_WFF2I] + (size_t)l * DM * 11008, 11008, (bf16_t*)(wl + WO_FF2I), DM, (q >> 5) * 64, (q & 31) * 64, 1, L, tid); continue; } q -= NT_FFI;
            if (q < NT_FFO) { conv_tile(a.in[I_WFF1O] + (size_t)l * DFF * DM, DM, (bf16_t*)(wl + WO_FF1O), DFF, (q / 86) * 64, (q % 86) * 64, 0, L, tid); continue; } q -= NT_FFO;
            if (q < NT_FFO) { conv_tile(a.in[I_WFF2O] + (size_t)l * DFF * DM, DM, (bf16_t*)(wl + WO_FF2O), DFF, (q / 86) * 64, (q % 86) * 64, 0, L, tid); continue; } q -= NT_FFO;
            if (q < NT_IN) { conv_tile(a.in[I_WIN] + (size_t)l * DM * 16384, 16384, (bf16_t*)(wl + WO_IN), DM, (q >> 5) * 64, (q & 31) * 64, 2, L, tid); continue; } q -= NT_IN;
            if (q < NT_BR) { const int n = q >> 8, tt = q & 255; conv_tile(a.in[I_WBR] + (size_t)l * 4 * 512 * DM, DM, (bf16_t*)(wl + WO_BR), DM, (tt >> 3) * 64, n * 512 + (tt & 7) * 64, 0, L, tid); continue; } q -= NT_BR;
            conv_tile(a.in[I_WOUT] + (size_t)l * DM * DM, DM, (bf16_t*)(wl + WO_OUT), DM, (q >> 5) * 64, (q & 31) * 64, 0, L, tid); continue; }
        r -= 2 * NT_LAYER;
        if (r < NT_ROPE) { const int idx = r * 512 + tid, pos = idx >> 3, i = idx & 7; double rev = (double)pos * ROPE_INV[i] * 0.15915494309189535; rev -= floor(rev); const float fr = (float)rev;
            float* rp = (float*)(ws + WS_ROPE) + (size_t)idx * 2; rp[0] = __builtin_amdgcn_cosf(fr); rp[1] = __builtin_amdgcn_sinf(fr); continue; } r -= NT_ROPE;
        if (r < NT_DFT) {
            const bool big = r < 32; const int N = big ? 128 : 64, m = (big ? r : r - 32) * 512 + tid, k = m / N, t = m % N;
            const float x = (float)((k * t) & (N - 1)) / (float)N; const float c = __builtin_amdgcn_cosf(x), sn = __builtin_amdgcn_sinf(x);
            bf16_t* dp = (bf16_t*)(ws + WS_DFT + (big ? 0 : 98304)); dp[m] = fftm_bf1(c); dp[N * N + m] = fftm_bf1(sn); dp[2 * N * N + m] = fftm_bf1(-sn); continue; }
        r -= NT_DFT;
        if (r < NT_ZSS) { ((f32x4*)(ws + WS_SS))[r * 512 + tid] = (f32x4){0.f, 0.f, 0.f, 0.f}; continue; }
        if (tid < 2) { const int l = tid; float s1 = 0.f, s2 = 0.f;
            for (int k = 0; k < 64; ++k) { s1 += a.in[I_LQ1][l * 64 + k] * a.in[I_LK1][l * 64 + k]; s2 += a.in[I_LQ2][l * 64 + k] * a.in[I_LK2][l * 64 + k]; }
            const float li = l == 0 ? 0.2f : 0.35550906759096934f;
            ((float*)(ws + WS_LAM))[l] = __expf(s1) - __expf(s2) + li; }
    }
}

constexpr int NT_AT = 144, NT_BWT = 1200, NT_PRO2 = NT_AT + NT_BWT;
__device__ __forceinline__ void prologue2_phase(KArgs& a, LAS unsigned char* lds, int wg, int nwg, int tid) {
    unsigned char* ws = a.ws; const float* mod = (const float*)(ws + WS_MOD);
    LAS float* sh = (LAS float*)lds;
    const int lane = tid & 63, wid = tid >> 6;
    for (int t = wg; t < NT_PRO2; t += nwg) {
        if (t < NT_AT) { const int idx = t * 512 + tid, inst = idx / 12288, rem = idx % 12288, br = rem >> 11, col = rem & 2047, l = inst / 3, sl = inst % 3;
            const float g = a.in[sl == 0 ? I_GFF1 : (sl == 1 ? I_GMIX : I_GFF2)][l * DM + col];
            ((float*)(ws + WS_AT))[idx] = g * (1.0f + mod[((size_t)l * 6 + br) * NMODC + (3 * sl + 1) * DM + col]); continue; }
        const int R0 = (t - NT_AT) * 64, l = R0 / BWL, rr = R0 % BWL, sl = rr < 11008 ? 0 : (rr < 27392 ? 1 : 2), v0 = rr - (sl == 0 ? 0 : (sl == 1 ? 11008 : 27392));
        __syncthreads();
#pragma unroll 1
        for (int i0 = 0; i0 < 6 * DM; i0 += 8 * 512) {
            float mv[8];
#pragma unroll
            for (int j = 0; j < 8; ++j) { const int i = i0 + j * 512 + tid, br = i >> 11, k = i & 2047; mv[j] = mod[((size_t)l * 6 + br) * NMODC + 3 * sl * DM + k]; }
#pragma unroll
            for (int j = 0; j < 8; ++j) { const int i = i0 + j * 512 + tid, br = i >> 11, k = i & 2047; sh[(br * 8 + (k >> 8)) * 260 + (k & 255)] = mv[j]; } }
        __syncthreads();
        const bf16_t* W = (const bf16_t*)(ws + WS_W + (size_t)l * WLAYER + (sl == 0 ? WO_FF1I : (sl == 1 ? WO_IN : WO_FF2I)));
        const int v = v0 + wid * 8 + (lane >> 3), kq = lane & 7;
        float acc[6] = {0.f, 0.f, 0.f, 0.f, 0.f, 0.f};
        for (int i = 0; i < 32; ++i) { const u32x4 wv = *(const u32x4*)((const char*)W + pg8::wtile_off(v, kq * 256 + i * 8, DM / 64));
            const float w8[8] = {bf_lo(wv.x), bf_hi(wv.x), bf_lo(wv.y), bf_hi(wv.y), bf_lo(wv.z), bf_hi(wv.z), bf_lo(wv.w), bf_hi(wv.w)};
#pragma unroll
            for (int br = 0; br < 6; ++br) { const LAS float* sp = sh + (br * 8 + kq) * 260 + i * 8; const f32x4 s0 = *(const LAS f32x4*)sp, s1 = *(const LAS f32x4*)(sp + 4);
                acc[br] += (w8[0] * s0[0] + w8[1] * s0[1]) + (w8[2] * s0[2] + w8[3] * s0[3]) + (w8[4] * s1[0] + w8[5] * s1[1]) + (w8[6] * s1[2] + w8[7] * s1[3]); } }
#pragma unroll
        for (int br = 0; br < 6; ++br) { float x = acc[br];
            x += __uint_as_float((unsigned)__builtin_amdgcn_ds_swizzle((int)__float_as_uint(x), (1 << 10) | 0x1f));
            x += __uint_as_float((unsigned)__builtin_amdgcn_ds_swizzle((int)__float_as_uint(x), (2 << 10) | 0x1f));
            x += __uint_as_float((unsigned)__builtin_amdgcn_ds_swizzle((int)__float_as_uint(x), (4 << 10) | 0x1f));
            if (kq == 0) ((float*)(ws + WS_BW))[((size_t)l * 6 + br) * BWL + rr + wid * 8 + (lane >> 3)] = x; }
    }
}
__device__ __forceinline__ void norm_first_phase(KArgs& a, int wg, int nwg, int wave, int lane) {
    bf16_t* XA = (bf16_t*)(a.ws + WS_H); float* ss0 = (float*)(a.ws + WS_SS); const float* at = (const float*)(a.ws + WS_AT);
    const int stride = nwg * 8; int row = wg * 8 + wave; if (row >= NTOK) return;
    f32x4 v[8], vn[8], av[8]; int brc = -1;
    { const float* x = row < 32768 ? a.in[I_XP] + (size_t)row * DM : a.in[I_XS] + (size_t)(row - 32768) * DM;
#pragma unroll
      for (int i = 0; i < 8; ++i) v[i] = *(const f32x4*)(x + (i * 64 + lane) * 4); }
    for (; row < NTOK; row += stride) {
        const int rn = row + stride; const int br = brow_of(row);
        if (rn < NTOK) { const float* xn = rn < 32768 ? a.in[I_XP] + (size_t)rn * DM : a.in[I_XS] + (size_t)(rn - 32768) * DM;
#pragma unroll
            for (int i = 0; i < 8; ++i) vn[i] = *(const f32x4*)(xn + (i * 64 + lane) * 4); }
        if (br != brc) { brc = br;
#pragma unroll
            for (int i = 0; i < 8; ++i) av[i] = *(const f32x4*)(at + (size_t)br * DM + (i * 64 + lane) * 4); }
        float ss = 0.f;
#pragma unroll
        for (int i = 0; i < 8; ++i) ss += (v[i][0] * v[i][0] + v[i][1] * v[i][1]) + (v[i][2] * v[i][2] + v[i][3] * v[i][3]);
        ss = wave_sum(ss); if (lane == 0) ss0[row] = ss;
#pragma unroll
        for (int i = 0; i < 8; ++i) { const int col = (i * 64 + lane) * 4; const f32x4 o = v[i] * av[i]; u32x2 w; w.x = pk2(o[0], o[1]); w.y = pk2(o[2], o[3]);
            *(u32x2*)(XA + (size_t)row * DM + col) = w; }
#pragma unroll
        for (int i = 0; i < 8; ++i) v[i] = vn[i];
    }
}
__device__ __forceinline__ void final_phase(KArgs& a, int wg, int nwg, int wave, int lane) {
    const float* gw = a.in[I_GFIN];
    const int stride = nwg * 8; int row = wg * 8 + wave; if (row >= NTOK) return;
    f32x4 v[8], vn[8], gv[8];
#pragma unroll
    for (int i = 0; i < 8; ++i) { gv[i] = *(const f32x4*)(gw + (i * 64 + lane) * 4); v[i] = *(const f32x4*)(a.out + (size_t)row * DM + (i * 64 + lane) * 4); }
    for (; row < NTOK; row += stride) {
        const int rn = row + stride; float* x = a.out + (size_t)row * DM;
        if (rn < NTOK) {
#pragma unroll
            for (int i = 0; i < 8; ++i) vn[i] = *(const f32x4*)(a.out + (size_t)rn * DM + (i * 64 + lane) * 4); }
        float ss = 0.f;
#pragma unroll
        for (int i = 0; i < 8; ++i) ss += (v[i][0] * v[i][0] + v[i][1] * v[i][1]) + (v[i][2] * v[i][2] + v[i][3] * v[i][3]);
        ss = wave_sum(ss); const float rstd = __builtin_amdgcn_rsqf(ss * (1.0f / DM) + EPS);
#pragma unroll
        for (int i = 0; i < 8; ++i) { const int col = (i * 64 + lane) * 4; *(f32x4*)(x + col) = v[i] * rstd * gv[i]; }
#pragma unroll
        for (int i = 0; i < 8; ++i) v[i] = vn[i];
    }
}

namespace dattn {
constexpr int KP = 144, VP = 320, KT = 64 * KP, VT = 64 * VP;
constexpr int KS0 = 0, KS1 = KT, VS0 = 2 * KT, VS1 = 2 * KT + VT;
#define DBAR() asm volatile("s_waitcnt lgkmcnt(0)\n\ts_barrier" ::: "memory")
__device__ __forceinline__ bf16x8 trA(LAS unsigned char* p) {
    const s16x4 lo = __builtin_amdgcn_ds_read_tr16_b64_v4i16((LAS s16x4*)p), hi = __builtin_amdgcn_ds_read_tr16_b64_v4i16((LAS s16x4*)(p + 8 * VP));
    return (bf16x8){lo[0], lo[1], lo[2], lo[3], hi[0], hi[1], hi[2], hi[3]};
}
__device__ __forceinline__ void qk(f32x16& p0, f32x16& p1, LAS unsigned char* ks, const bf16x8 (&qf)[4], int r32, int hi) {
    p0 = (f32x16){0.f, 0.f, 0.f, 0.f, 0.f, 0.f, 0.f, 0.f, 0.f, 0.f, 0.f, 0.f, 0.f, 0.f, 0.f, 0.f}; p1 = p0;
#pragma unroll
    for (int s = 0; s < 4; ++s) { const bf16x8 k0f = *(const LAS bf16x8*)(ks + r32 * KP + (16 * s + 8 * hi) * 2), k1f = *(const LAS bf16x8*)(ks + (32 + r32) * KP + (16 * s + 8 * hi) * 2);
        p0 = __builtin_amdgcn_mfma_f32_32x32x16_bf16(k0f, qf[s], p0, 0, 0, 0); p1 = __builtin_amdgcn_mfma_f32_32x32x16_bf16(k1f, qf[s], p1, 0, 0, 0); }
}
__device__ __forceinline__ float softmax(f32x16& p0, f32x16& p1, float& m, float& l, bf16x8 (&pb)[4]) {
    float mx = fmaxf(p0[0], p1[0]);
#pragma unroll
    for (int r = 1; r < 16; ++r) mx = fmaxf(mx, fmaxf(p0[r], p1[r]));
    mx = swap_max(mx);
    const float mn = fmaxf(m, mx * C2), alpha = __builtin_amdgcn_exp2f(m - mn); m = mn;
    float ps = 0.f;
#pragma unroll
    for (int r = 0; r < 16; ++r) { p0[r] = __builtin_amdgcn_exp2f(fmaf(p0[r], C2, -mn)); p1[r] = __builtin_amdgcn_exp2f(fmaf(p1[r], C2, -mn)); ps += p0[r] + p1[r]; }
    ps = swap_sum(ps); l = l * alpha + ps;
#pragma unroll
    for (int ks = 0; ks < 4; ++ks) { u32x4 w;
        if (ks < 2) { w.x = pk2(p0[8 * (ks & 1) + 0], p0[8 * (ks & 1) + 1]); w.y = pk2(p0[8 * (ks & 1) + 2], p0[8 * (ks & 1) + 3]); w.z = pk2(p0[8 * (ks & 1) + 4], p0[8 * (ks & 1) + 5]); w.w = pk2(p0[8 * (ks & 1) + 6], p0[8 * (ks & 1) + 7]); }
        else        { w.x = pk2(p1[8 * (ks & 1) + 0], p1[8 * (ks & 1) + 1]); w.y = pk2(p1[8 * (ks & 1) + 2], p1[8 * (ks & 1) + 3]); w.z = pk2(p1[8 * (ks & 1) + 4], p1[8 * (ks & 1) + 5]); w.w = pk2(p1[8 * (ks & 1) + 6], p1[8 * (ks & 1) + 7]); }
        pb[ks] = __builtin_bit_cast(bf16x8, w); }
    return alpha;
}
__device__ __forceinline__ void pv(f32x16 (&o)[4], LAS unsigned char* vs, int vbase, const bf16x8 (&pb)[4]) {
#pragma unroll
    for (int ks = 0; ks < 4; ++ks)
#pragma unroll
        for (int db = 0; db < 4; ++db) { const bf16x8 va = trA(vs + vbase + ks * 16 * VP + db * 64); o[db] = __builtin_amdgcn_mfma_f32_32x32x16_bf16(va, pb[ks], o[db], 0, 0, 0); }
}
template <int MODE>
__device__ __forceinline__ void unit(const bf16_t* Zs, int T, int h, int qb, const float* lamp, int layer, const float* lng, bf16_t* Ys, u32x4* oscr, LAS unsigned char* lds, const int wv) {
    const int tid = opaque_tid(wv), lane = tid & 63, wid = __builtin_amdgcn_readfirstlane(tid >> 6), r32 = lane & 31, hi = lane >> 5;
    const int qrow = qb * 256 + wid * 32 + r32, NT = T >> 6;
    const int ksr = tid >> 3, ksc = tid & 7, vr0 = tid >> 4, vc0 = tid & 15;
    const int vbase = (4 * hi + ((lane >> 2) & 3)) * VP + (16 * ((lane >> 4) & 1) + 4 * (lane & 3)) * 2;
    const int kw = ksr * KP + ksc * 16, vw = vr0 * VP + vc0 * 16;
#pragma unroll
    for (int c = 0; c < 2; ++c) {
        const bf16_t* Qp = Zs + zoff(qrow, 2048 + h * 128 + c * 64) + hi * 8;
        bf16x8 qf[4];
#pragma unroll
        for (int s = 0; s < 4; ++s) qf[s] = *(const bf16x8*)(Qp + 16 * s);
        LAS unsigned char* const qlds = lds + 59392 + wid * 4096 + lane * 16;
        const bf16_t* Kg = Zs + zoff(ksr, 2560 + h * 128 + c * 64) + ksc * 8;
        const bf16_t* Vg = Zs + zoff(vr0, 3072 + h * 128 + vc0 * 8);
        f32x16 o[4];
#pragma unroll
        for (int d = 0; d < 4; ++d) o[d] = (f32x16){0.f, 0.f, 0.f, 0.f, 0.f, 0.f, 0.f, 0.f, 0.f, 0.f, 0.f, 0.f, 0.f, 0.f, 0.f, 0.f};
        float m = -1e30f, l = 0.f;
        __syncthreads();
#pragma unroll
        for (int s = 0; s < 4; ++s) *(LAS bf16x8*)(qlds + s * 1024) = qf[s];
        { const bf16x8 k0 = *(const bf16x8*)Kg, k1 = *(const bf16x8*)(Kg + (size_t)64 * ZR), v0 = *(const bf16x8*)Vg, v1 = *(const bf16x8*)(Vg + (size_t)32 * ZR);
          *(LAS bf16x8*)(lds + KS0 + kw) = k0; *(LAS bf16x8*)(lds + KS1 + kw) = k1; *(LAS bf16x8*)(lds + VS0 + vw) = v0; *(LAS bf16x8*)(lds + VS0 + vw + 32 * VP) = v1; }
        __syncthreads();
        constexpr float THR = 8.0f;
        f32x16 pA0, pA1, pB0, pB1, negm; u32x4 pbA[4], pbB[4]; float mref = 0.f;
        negm = (f32x16){0.f, 0.f, 0.f, 0.f, 0.f, 0.f, 0.f, 0.f, 0.f, 0.f, 0.f, 0.f, 0.f, 0.f, 0.f, 0.f};
        qk(pA0, pA1, lds + KS0, qf, r32, hi);
        __syncthreads();
#define KFRAG(SL, G) (*(const LAS bf16x8*)((SL) + ((((G) & 1) ? 32 : 0) + r32) * KP + (16 * ((G) >> 1) + 8 * hi) * 2))
#define MX3(a, b, c) __builtin_fmaxf(__builtin_fmaxf((a), (b)), (c))
#define DSTEP(C0, C1, N0, N1, PBR, PBW, J) do { const int j_ = (J); const int jk_ = (j_ + 2 < NT) ? j_ + 2 : NT - 1; \
            LAS unsigned char* ksl_ = lds + (((j_ + 1) & 1) ? KS1 : KS0); LAS unsigned char* vsl_ = lds + (((j_ - 1) & 1) ? VS1 : VS0) + vbase; \
            bf16x8 kf_[8], va_[16], qs_[4]; float ps_ = 0.f; \
            const bf16x8 kreg_ = *(const bf16x8*)(Kg + (size_t)jk_ * 64 * ZR);        \
            const bf16x8 v0_ = *(const bf16x8*)(Vg + (size_t)j_ * 64 * ZR), v1_ = *(const bf16x8*)(Vg + (size_t)j_ * 64 * ZR + (size_t)32 * ZR); \
            kf_[0] = KFRAG(ksl_, 0); kf_[1] = KFRAG(ksl_, 1); qs_[0] = *(const LAS bf16x8*)(qlds); \
            __builtin_amdgcn_sched_barrier(0); \
            _Pragma("unroll") for (int g_ = 0; g_ < 8; ++g_) { \
                if (g_ + 2 < 8) kf_[g_ + 2] = KFRAG(ksl_, g_ + 2); \
                if (!(g_ & 1) && g_ + 2 < 8) qs_[(g_ >> 1) + 1] = *(const LAS bf16x8*)(qlds + ((g_ >> 1) + 1) * 1024); \
                if (g_ >= 6) va_[g_ - 6] = trA(vsl_ + (g_ - 6) * 64); \
                if (g_ == 0) N0 = __builtin_amdgcn_mfma_f32_32x32x16_bf16(kf_[0], qs_[0], negm, 0, 0, 0); else if (g_ == 1) N1 = __builtin_amdgcn_mfma_f32_32x32x16_bf16(kf_[1], qs_[0], negm, 0, 0, 0); \
                else if (g_ & 1) N1 = __builtin_amdgcn_mfma_f32_32x32x16_bf16(kf_[g_], qs_[g_ >> 1], N1, 0, 0, 0); else N0 = __builtin_amdgcn_mfma_f32_32x32x16_bf16(kf_[g_], qs_[g_ >> 1], N0, 0, 0, 0); \
                { const float e0_ = __builtin_amdgcn_exp2f(C0[2 * g_]), e1_ = __builtin_amdgcn_exp2f(C0[2 * g_ + 1]); ps_ += e0_; ps_ += e1_; PBW[g_ >> 2][g_ & 3] = pk2(e0_, e1_); } \
                __builtin_amdgcn_sched_barrier(0); } \
            float tn_ = -1e30f, ep_ = 0.f; \
            __builtin_amdgcn_sched_barrier(0); \
            _Pragma("unroll") for (int i_ = 0; i_ < 16; ++i_) { \
                if (i_ + 2 < 16) va_[i_ + 2] = trA(vsl_ + ((i_ + 2) >> 2) * 16 * VP + ((i_ + 2) & 3) * 64); \
                o[i_ & 3] = __builtin_amdgcn_mfma_f32_32x32x16_bf16(va_[i_], __builtin_bit_cast(bf16x8, PBR[i_ >> 2]), o[i_ & 3], 0, 0, 0); \
                { const float e_ = __builtin_amdgcn_exp2f(C1[i_]); ps_ += e_; if (i_ & 1) PBW[2 + (i_ >> 3)][(i_ >> 1) & 3] = pk2(ep_, e_); else ep_ = e_; } \
                tn_ = MX3(tn_, N0[i_], N1[i_]); asm volatile("" : "+v"(tn_)); \
                __builtin_amdgcn_sched_barrier(0); } \
            asm volatile("" : "+v"(PBW[0]), "+v"(PBW[1]), "+v"(PBW[2]), "+v"(PBW[3])); \
            ps_ = swap_sum(ps_); l += ps_; \
            if (__any(fcarry < 1.0f)) { _Pragma("unroll") for (int d = 0; d < 4; ++d) o[d] *= fcarry; } \
            fcarry = 1.0f; \
            { const float mx_ = swap_max(tn_); \
              if ((j_ + 1 < NT) && __any(mx_ > THR)) { const float d_ = fmaxf(mx_, 0.f); fcarry = __builtin_amdgcn_exp2f(-d_); mref += d_; l *= fcarry; \
                  _Pragma("unroll") for (int r = 0; r < 16; ++r) { N0[r] -= d_; N1[r] -= d_; negm[r] = -mref; } } } \
            *(LAS bf16x8*)(lds + ((j_ & 1) ? KS1 : KS0) + kw) = kreg_; \
            *(LAS bf16x8*)(lds + ((j_ & 1) ? VS1 : VS0) + vw) = v0_; *(LAS bf16x8*)(lds + ((j_ & 1) ? VS1 : VS0) + vw + 32 * VP) = v1_; \
            DBAR(); } while (0)
        float fcarry = 1.0f;
        {
            const bf16x8 kreg_ = *(const bf16x8*)(Kg + (size_t)(2 < NT ? 2 : NT - 1) * 64 * ZR);
            float mx = fmaxf(pA0[0], pA1[0]);
#pragma unroll
            for (int r = 1; r < 16; ++r) mx = fmaxf(mx, fmaxf(pA0[r], pA1[r]));
            mx = swap_max(mx); mref = mx;
#pragma unroll
            for (int r = 0; r < 16; ++r) negm[r] = -mref;
            float ps = 0.f;
#pragma unroll
            for (int r = 0; r < 16; ++r) { pA0[r] = __builtin_amdgcn_exp2f(pA0[r] - mx); pA1[r] = __builtin_amdgcn_exp2f(pA1[r] - mx); ps += pA0[r] + pA1[r]; }
            l = swap_sum(ps);
#pragma unroll
            for (int ks = 0; ks < 4; ++ks) { u32x4 w;
                if (ks < 2) { w.x = pk2(pA0[8 * (ks & 1) + 0], pA0[8 * (ks & 1) + 1]); w.y = pk2(pA0[8 * (ks & 1) + 2], pA0[8 * (ks & 1) + 3]); w.z = pk2(pA0[8 * (ks & 1) + 4], pA0[8 * (ks & 1) + 5]); w.w = pk2(pA0[8 * (ks & 1) + 6], pA0[8 * (ks & 1) + 7]); }
                else        { w.x = pk2(pA1[8 * (ks & 1) + 0], pA1[8 * (ks & 1) + 1]); w.y = pk2(pA1[8 * (ks & 1) + 2], pA1[8 * (ks & 1) + 3]); w.z = pk2(pA1[8 * (ks & 1) + 4], pA1[8 * (ks & 1) + 5]); w.w = pk2(pA1[8 * (ks & 1) + 6], pA1[8 * (ks & 1) + 7]); }
                pbA[ks] = w; }
            { LAS unsigned char* ksl_ = lds + KS1;
#pragma unroll
              for (int g = 0; g < 8; ++g) { const bf16x8 kf = KFRAG(ksl_, g);
                if (g == 0) pB0 = __builtin_amdgcn_mfma_f32_32x32x16_bf16(kf, qf[0], negm, 0, 0, 0); else if (g == 1) pB1 = __builtin_amdgcn_mfma_f32_32x32x16_bf16(kf, qf[0], negm, 0, 0, 0);
                else if (g & 1) pB1 = __builtin_amdgcn_mfma_f32_32x32x16_bf16(kf, qf[g >> 1], pB1, 0, 0, 0); else pB0 = __builtin_amdgcn_mfma_f32_32x32x16_bf16(kf, qf[g >> 1], pB0, 0, 0, 0); } }
            { float t1 = fmaxf(pB0[0], pB1[0]);
#pragma unroll
              for (int r = 1; r < 16; ++r) t1 = fmaxf(t1, fmaxf(pB0[r], pB1[r]));
              t1 = swap_max(t1);
              if ((1 < NT) && __any(t1 > THR)) { const float d_ = fmaxf(t1, 0.f); fcarry = __builtin_amdgcn_exp2f(-d_); mref += d_; l *= fcarry;
#pragma unroll
                  for (int r = 0; r < 16; ++r) { pB0[r] -= d_; pB1[r] -= d_; negm[r] = -mref; } } }
            *(LAS bf16x8*)(lds + KS0 + kw) = kreg_;
            DBAR(); }
        for (int j = 1; j + 1 < NT; j += 2) { DSTEP(pB0, pB1, pA0, pA1, pbA, pbB, j); DSTEP(pA0, pA1, pB0, pB1, pbB, pbA, j + 1); }
        DSTEP(pB0, pB1, pA0, pA1, pbA, pbB, NT - 1);
#undef DSTEP
#undef KFRAG
#undef MX3
        { bf16x8 pbl[4];
#pragma unroll
          for (int q = 0; q < 4; ++q) pbl[q] = __builtin_bit_cast(bf16x8, pbB[q]);
          pv(o, lds + (((NT - 1) & 1) ? VS1 : VS0), vbase, pbl); }
        const float inv = __builtin_amdgcn_rcpf(l);
        const int tidE = opaque_tid(wv), hiE = (tidE >> 5) & 1, qrowE = qb * 256 + (tidE >> 6) * 32 + (tidE & 31);
        if (c == 0) {
#pragma unroll
            for (int d = 0; d < 4; ++d)
#pragma unroll
                for (int i = 0; i < 2; ++i) { u32x4 w; w.x = pk2(o[d][8 * i] * inv, o[d][8 * i + 1] * inv); w.y = pk2(o[d][8 * i + 2] * inv, o[d][8 * i + 3] * inv); w.z = pk2(o[d][8 * i + 4] * inv, o[d][8 * i + 5] * inv); w.w = pk2(o[d][8 * i + 6] * inv, o[d][8 * i + 7] * inv);
                    oscr[(size_t)tidE * 8 + d * 2 + i] = w; }
        } else {
            float ss = 0.f; int ly = layer; asm volatile("" : "+s"(ly));
            const float lamv = lamp[ly], postv = ly == 0 ? 0.8f : 0.64449093240903066f;
#pragma unroll
            for (int d = 0; d < 4; ++d) {
#pragma unroll
                for (int i = 0; i < 2; ++i) { const u32x4 w = __builtin_nontemporal_load(oscr + (size_t)tidE * 8 + d * 2 + i); const float il = inv * lamv;
                    o[d][8 * i + 0] = bf_lo(w.x) - o[d][8 * i + 0] * il; o[d][8 * i + 1] = bf_hi(w.x) - o[d][8 * i + 1] * il; o[d][8 * i + 2] = bf_lo(w.y) - o[d][8 * i + 2] * il; o[d][8 * i + 3] = bf_hi(w.y) - o[d][8 * i + 3] * il;
                    o[d][8 * i + 4] = bf_lo(w.z) - o[d][8 * i + 4] * il; o[d][8 * i + 5] = bf_hi(w.z) - o[d][8 * i + 5] * il; o[d][8 * i + 6] = bf_lo(w.w) - o[d][8 * i + 6] * il; o[d][8 * i + 7] = bf_hi(w.w) - o[d][8 * i + 7] * il; }
#pragma unroll
                for (int r = 0; r < 16; ++r) ss += o[d][r] * o[d][r]; }
            ss = swap_sum(ss);
            const float rn = __builtin_amdgcn_rsqf(ss * (1.0f / 128.0f) + EPS) * postv;
            bf16_t* yp = Ys + (size_t)qrowE * DM + 1024 + h * 128;
            f32x4 gl[16];
#pragma unroll
            for (int i = 0; i < 16; ++i) gl[i] = *(const f32x4*)(lng + (i >> 2) * 32 + 8 * (i & 3) + 4 * hiE);
            __builtin_amdgcn_sched_barrier(0);
#pragma unroll
            for (int d = 0; d < 4; ++d)
#pragma unroll
                for (int a4 = 0; a4 < 4; ++a4) { const int d0 = d * 32 + 8 * a4 + 4 * hiE; const f32x4 g = gl[d * 4 + a4];
                    u32x2 w; w.x = pk2(o[d][4 * a4] * rn * g[0], o[d][4 * a4 + 1] * rn * g[1]); w.y = pk2(o[d][4 * a4 + 2] * rn * g[2], o[d][4 * a4 + 3] * rn * g[3]);
                    *(u32x2*)((char*)Ys + pg8::atile_off(qrowE, 1024 + h * 128 + d * 32 + 8 * a4, DM / 64) + 8 * hiE) = w; (void)yp; (void)d0; }
        }
    }
}
#undef DBAR
}

namespace wattn {
constexpr int VP = 192, VBUF = 32 * VP, KP = 144, KBUF = 32 * KP, WBUF = VBUF + KBUF;
constexpr float THR = 8.0f;
struct KV { bf16x8 kr[4], vr[4]; };
struct Geom { int kind, a0, a1, B, TS, KS, nt, QB, qsh, qcol, kcol, vcol; };
__device__ __forceinline__ unsigned kv_off0(const Geom& G, int lane) { return (unsigned)(zoff(G.B + (lane >> 3) * G.KS, G.kcol) + 8 * (lane & 7)) * 2u; }
__device__ __forceinline__ void load_kv(KV& t, const char* Zc, unsigned off, unsigned rsb, int dv) {
#pragma unroll
    for (int i = 0; i < 4; ++i) { const char* pk = Zc + (off + (unsigned)i * rsb); t.kr[i] = *(const bf16x8*)pk; t.vr[i] = *(const bf16x8*)(pk + dv); }
}
__device__ __forceinline__ void load_q(bf16x8 (&qf)[4], const char* Zc, const Geom& G, int lane) {
    const int r32 = lane & 31, hi = lane >> 5; const int qtok = G.QB + (G.qsh < 0 ? (r32 >> 4) * 64 + (r32 & 15) : (r32 << G.qsh));
    const char* Qp = Zc + (unsigned)(zoff(qtok, G.qcol) + 8 * hi) * 2u;
#pragma unroll
    for (int s = 0; s < 4; ++s) qf[s] = *(const bf16x8*)(Qp + 32 * s);
}
__device__ __forceinline__ void put_k(const KV& t, LAS unsigned char* kb, int lane) {
#pragma unroll
    for (int i = 0; i < 4; ++i) *(LAS bf16x8*)(kb + ((lane >> 3) + 8 * i) * KP + (lane & 7) * 16) = t.kr[i];
}
__device__ __forceinline__ f32x16 qk4(LAS unsigned char* kb, const bf16x8 (&qf)[4], int lane) {
    LAS unsigned char* p = kb + (lane & 31) * KP + (lane >> 5) * 16;
    bf16x8 kf[4];
#pragma unroll
    for (int st = 0; st < 4; ++st) kf[st] = *(const LAS bf16x8*)(p + st * 32);
    __builtin_amdgcn_sched_barrier(0);
    f32x16 s = __builtin_amdgcn_mfma_f32_32x32x16_bf16(kf[0], qf[0], (f32x16){0.f, 0.f, 0.f, 0.f, 0.f, 0.f, 0.f, 0.f, 0.f, 0.f, 0.f, 0.f, 0.f, 0.f, 0.f, 0.f}, 0, 0, 0);
#pragma unroll
    for (int st = 1; st < 4; ++st) s = __builtin_amdgcn_mfma_f32_32x32x16_bf16(kf[st], qf[st], s, 0, 0, 0);
    return s;
}
__device__ __forceinline__ void put_v(const KV& t, LAS unsigned char* vb, int lane) {
#pragma unroll
    for (int i = 0; i < 4; ++i) *(LAS bf16x8*)(vb + ((lane >> 3) + 8 * i) * VP + (lane & 7) * 16) = t.vr[i];
}
__device__ __forceinline__ void pv2(f32x16& o0, f32x16& o1, LAS unsigned char* vb, const u32x4 (&pb)[2], int lane) {
    const int hi = lane >> 5; LAS unsigned char* p0 = vb + (4 * hi + ((lane >> 2) & 3)) * VP + (16 * ((lane >> 4) & 1) + 4 * (lane & 3)) * 2;
    bf16x8 va[4];
#pragma unroll
    for (int i = 0; i < 4; ++i) { LAS unsigned char* p = p0 + (i >> 1) * 16 * VP + (i & 1) * 64;
        const s16x4 lo = __builtin_amdgcn_ds_read_tr16_b64_v4i16((LAS s16x4*)p), hh = __builtin_amdgcn_ds_read_tr16_b64_v4i16((LAS s16x4*)(p + 8 * VP));
        va[i] = (bf16x8){lo[0], lo[1], lo[2], lo[3], hh[0], hh[1], hh[2], hh[3]}; }
    __builtin_amdgcn_sched_barrier(0);
#pragma unroll
    for (int ks = 0; ks < 2; ++ks) { o0 = __builtin_amdgcn_mfma_f32_32x32x16_bf16(va[2 * ks], __builtin_bit_cast(bf16x8, pb[ks]), o0, 0, 0, 0); o1 = __builtin_amdgcn_mfma_f32_32x32x16_bf16(va[2 * ks + 1], __builtin_bit_cast(bf16x8, pb[ks]), o1, 0, 0, 0); }
}
template <class FixS>
__device__ __forceinline__ void run(f32x16& o0, f32x16& o1, float& l, float& mref, bf16x8 (&qf)[4], KV& kvA, KV& kvB, const char* Zc, const Geom& G, const Geom& N, const bool hasN, const FixS& fixs, LAS unsigned char* wbuf, int lane) {
    const f32x16 zero = (f32x16){0.f, 0.f, 0.f, 0.f, 0.f, 0.f, 0.f, 0.f, 0.f, 0.f, 0.f, 0.f, 0.f, 0.f, 0.f, 0.f};
    LAS unsigned char* const vbuf = wbuf; LAS unsigned char* const kbuf = wbuf + VBUF;
    const int nt = G.nt; const unsigned tsb = (unsigned)G.TS * (ZR * 2), rsb = (unsigned)G.KS * (8 * ZR * 2); const int dv = ((G.vcol - G.kcol) >> 6) * (GT * ZR * 2);
    unsigned off2 = kv_off0(G, lane) + 2u * tsb;
    o0 = zero; o1 = zero; l = 0.f;
    f32x16 sA, sB; u32x4 pbA[2], pbB[2]; float fcarry = 1.0f;
    asm volatile("" ::: "memory"); put_k(kvA, kbuf, lane); asm volatile("" ::: "memory");
    sA = qk4(kbuf, qf, lane); fixs(0, sA);
    { float mx = sA[0];
#pragma unroll
      for (int r = 1; r < 16; ++r) mx = fmaxf(mx, sA[r]);
      mx = swap_max(mx); mx = (mx > -1e30f) ? mx : 0.f; mref = mx;
#pragma unroll
      for (int r = 0; r < 16; ++r) sA[r] -= mx; }
#define WSTEP(SC, SN, PBR, PBW, KC, KN, TT, KCI) do { const int t_ = (TT); const bool nx_ = (t_ + 1 < nt); \
        asm volatile("" ::: "memory"); \
        if (nx_) { put_k(KN, kbuf, lane); asm volatile("" ::: "memory"); SN = qk4(kbuf, qf, lane); } \
        if (t_ >= 1) pv2(o0, o1, vbuf, PBR, lane); \
        asm volatile("" ::: "memory"); put_v(KC, vbuf, lane); asm volatile("" ::: "memory"); \
        if (t_ + 2 < nt) { load_kv(KC, Zc, off2, rsb, dv); off2 += tsb; } \
        else if (hasN) load_kv(KC, Zc, kv_off0(N, lane) + (KCI) * ((unsigned)N.TS * (ZR * 2)), (unsigned)N.KS * (8 * ZR * 2), ((N.vcol - N.kcol) >> 6) * (GT * ZR * 2));     \
        if (!nx_ && hasN) load_q(qf, Zc, N, lane); \
        float ps_ = 0.f; \
        _Pragma("unroll") for (int r = 0; r < 16; r += 2) { const float e0_ = __builtin_amdgcn_exp2f(SC[r]), e1_ = __builtin_amdgcn_exp2f(SC[r + 1]); ps_ += e0_; ps_ += e1_; PBW[r >> 3][(r >> 1) & 3] = pk2(e0_, e1_); } \
        ps_ = swap_sum(ps_); l += ps_; \
        if (__any(fcarry < 1.0f)) { o0 *= fcarry; o1 *= fcarry; } \
        fcarry = 1.0f; \
        if (nx_) { _Pragma("unroll") for (int r = 0; r < 16; ++r) SN[r] -= mref; \
            fixs(t_ + 1, SN); float tn_ = SN[0]; \
            _Pragma("unroll") for (int r = 1; r < 16; ++r) tn_ = fmaxf(tn_, SN[r]); \
            tn_ = swap_max(tn_); \
            if (__any(tn_ > THR)) { const float d_ = fmaxf(tn_, 0.f); fcarry = __builtin_amdgcn_exp2f(-d_); mref += d_; l *= fcarry; \
                _Pragma("unroll") for (int r = 0; r < 16; ++r) SN[r] -= d_; } } \
    } while (0)
    int t = 0;
    for (; t + 1 < nt; t += 2) { WSTEP(sA, sB, pbB, pbA, kvA, kvB, t, 0); WSTEP(sB, sA, pbA, pbB, kvB, kvA, t + 1, 1); }
    if (t < nt) { WSTEP(sA, sB, pbB, pbA, kvA, kvB, t, 0); asm volatile("" ::: "memory"); pv2(o0, o1, vbuf, pbA, lane); }
    else { asm volatile("" ::: "memory"); pv2(o0, o1, vbuf, pbB, lane); }
#undef WSTEP
    asm volatile("" ::: "memory");
}

__device__ __forceinline__ Geom nat_geom(int T, int qb, int h) {
    const int tok0 = qb * 32, seqrow0 = tok0 & ~(T - 1), bl = (tok0 & (T - 1)) >> 5, r = 2 * (bl >> 2), c0 = 16 * (bl & 3), rows = T >> 6;
    const int rsu = min(max(r - 4, 0), rows - 8), nt = min(max(r - 3, 0), rows - 8) + 8 - rsu, cst = min(min(max(c0 - 8, 0), 48), 32);
    return Geom{0, qb, 0, seqrow0 + rsu * 64 + cst, 64, 1, nt, seqrow0 + r * 64 + c0, -1, 512 + h * 64, 1024 + h * 64, 1536 + h * 64};
}
__device__ __forceinline__ Geom dil_geom(int T, int g, int qblk, int h) {
    const int ds = 2 * g, d = 1 << ds, nqs = T >> 5;
    const int seqrow0 = (qblk << 5) & ~(T - 1), qs = qblk & (nqs - 1), rho = qs & (d - 1), u0 = (qs >> ds) * 32, U = T >> ds;
    const int jlo = u0 >= 64 ? 0 : (u0 >= 32 ? 1 : 2), jhi = (u0 + 96 <= U) ? 4 : ((u0 + 64 <= U) ? 3 : 2);
    const int base = seqrow0 + rho, ub = u0 - 64 + 32 * jlo;
    return Geom{1, g, qblk, base + (ub << ds), 32 << ds, d, jhi - jlo + 1, base + (u0 << ds), ds, 3584 + g * 512 + h * 64, 5120 + g * 512 + h * 64, 6656 + g * 512 + h * 64};
}
__device__ __forceinline__ void task(const bf16_t* Z, bf16_t* Y, float* DO, float* DL, const LAS float* tabl, int T, int h, bf16x8 (&qf)[4], KV& kvA, KV& kvB, const Geom& G, const Geom& N, bool hasN, LAS unsigned char* vbuf) {
    const int lane = opaque_lane(), r32 = lane & 31, hi = lane >> 5;
    const bool nat = G.kind == 0;
    const int tok0 = G.a0 * 32, nsr0 = tok0 & ~(T - 1), bl = (tok0 & (T - 1)) >> 5, r = 2 * (bl >> 2), c0 = 16 * (bl & 3), rows = T >> 6;
    const int qr = r + (r32 >> 4), qc = c0 + (r32 & 15);
    const int rsu = min(max(r - 4, 0), rows - 8), cst = min(min(max(c0 - 8, 0), 48), 32);
    const int dlo = min(max(qr - 4, 0), rows - 8) - rsu, clo = min(max(qc - 8, 0), 48) - cst - 4 * hi;
    const LAS float* rbl = tabl + h * 465 + (rsu - qr + 7) * 31 + 15 - qc + cst + 4 * hi;
    const int g = G.a0, qblk = G.a1, ds = 2 * g, d = 1 << ds, nqs = T >> 5;
    const int dsr0 = (qblk << 5) & ~(T - 1), qs = qblk & (nqs - 1), rho = qs & (d - 1), u0 = (qs >> ds) * 32;
    const int jlo = u0 >= 64 ? 0 : (u0 >= 32 ? 1 : 2);
    const int qtok = nat ? nsr0 + qr * 64 + qc : dsr0 + rho + ((u0 + r32) << ds);
    const int keyl = r32 - 4 * hi;
    f32x16 o0, o1; float l, mref;
    run(o0, o1, l, mref, qf, kvA, kvB, (const char*)Z, G, N, hasN,
        [&](int t, f32x16& s) {
            if (nat) { const int cl = ((unsigned)(t - dlo) < 8u) ? clo : (1 << 20); const LAS float* bp = rbl + t * 31;
                float bv[16];
#pragma unroll
                for (int rr = 0; rr < 16; ++rr) bv[rr] = bp[(rr & 3) + 8 * (rr >> 2)];
#pragma unroll
                for (int rr = 0; rr < 16; ++rr) s[rr] = ((unsigned)((rr & 3) + 8 * (rr >> 2) - cl) < 16u) ? s[rr] + bv[rr] : -INFINITY; }
            else { const int jt = jlo + t;
                if (jt == 0) {
#pragma unroll
                    for (int rr = 0; rr < 16; ++rr) s[rr] = ((rr & 3) + 8 * (rr >> 2) >= keyl) ? s[rr] : -INFINITY; }
                else if (jt == 4) {
#pragma unroll
                    for (int rr = 0; rr < 16; ++rr) s[rr] = ((rr & 3) + 8 * (rr >> 2) <= keyl) ? s[rr] : -INFINITY; } } },
        vbuf, lane);
    const float inv = __builtin_amdgcn_rcpf(l);
    if (nat) {
        bf16_t* yp = Y + (size_t)qtok * DM + 512 + h * 64;
#pragma unroll
        for (int a4 = 0; a4 < 4; ++a4) { const int d0 = 8 * a4 + 4 * hi;
            u32x2 w; w.x = pk2(o0[4 * a4] * inv, o0[4 * a4 + 1] * inv); w.y = pk2(o0[4 * a4 + 2] * inv, o0[4 * a4 + 3] * inv); *(u32x2*)((char*)Y + pg8::atile_off(qtok, 512 + h * 64 + 8 * a4, DM / 64) + 8 * hi) = w;
            u32x2 w1; w1.x = pk2(o1[4 * a4] * inv, o1[4 * a4 + 1] * inv); w1.y = pk2(o1[4 * a4 + 2] * inv, o1[4 * a4 + 3] * inv); *(u32x2*)((char*)Y + pg8::atile_off(qtok, 512 + h * 64 + 32 + 8 * a4, DM / 64) + 8 * hi) = w1; (void)yp; (void)d0; }
    } else {
        bf16_t* op = (bf16_t*)DO + ((size_t)g * GT + qtok) * 512 + h * 64;
#pragma unroll
        for (int a4 = 0; a4 < 4; ++a4) { const int d0 = 8 * a4 + 4 * hi;
            u32x2 w; w.x = pk2(o0[4 * a4] * inv, o0[4 * a4 + 1] * inv); w.y = pk2(o0[4 * a4 + 2] * inv, o0[4 * a4 + 3] * inv); *(u32x2*)(op + d0) = w;
            u32x2 w1; w1.x = pk2(o1[4 * a4] * inv, o1[4 * a4 + 1] * inv); w1.y = pk2(o1[4 * a4 + 2] * inv, o1[4 * a4 + 3] * inv); *(u32x2*)(op + 32 + d0) = w1; }
        if (hi == 0) DL[((size_t)g * GT + qtok) * 8 + h] = mref + __log2f(l);
    }
}
__device__ __forceinline__ Geom stream_geom(int T, int h, int kk, int wx, int nwg) {
    const int i = wx + (kk >> 1) * nwg, k = kk & 1;
    return nat_geom(T, 2 * i + k, h);
}
__device__ __forceinline__ void stream(const bf16_t* Z, bf16_t* Y, float* DO, float* DL, const LAS float* tabl, int T, int h, int wx, int nwg, LAS unsigned char* vbuf) {
    const int total = 2 * ((256 - wx + nwg - 1) / nwg);
    if (total <= 0) return;
    Geom G = stream_geom(T, h, 0, wx, nwg), N = G; bf16x8 qf[4]; KV kvA, kvB;
    { const int lane = opaque_lane(); const unsigned o0 = kv_off0(G, lane), tsb = (unsigned)G.TS * (ZR * 2), rsb = (unsigned)G.KS * (8 * ZR * 2); const int dv = ((G.vcol - G.kcol) >> 6) * (GT * ZR * 2);
      load_q(qf, (const char*)Z, G, lane); load_kv(kvA, (const char*)Z, o0, rsb, dv); load_kv(kvB, (const char*)Z, o0 + tsb, rsb, dv); }
    for (int kk = 0; kk < total; ++kk) {
        const bool hasN = kk + 1 < total; if (hasN) N = stream_geom(T, h, kk + 1, wx, nwg);
        task(Z, Y, DO, DL, tabl, T, h, qf, kvA, kvB, G, N, hasN, vbuf);
        G = N;
    }
}

constexpr int SKT = 32 * KP, SVT = 32 * VP, SVOFF = 12 * SKT;
struct DTask { int g, h, ds, tok0, u0b, U; };
__device__ __forceinline__ DTask dtask_of(int T, int j) {
    const int g = j >> 9, rem = j & 511, h = rem & 7, jj = rem >> 3, ds = 2 * g, d = 1 << ds, per = T >> 8;
    const int seq = jj / per, q = jj % per, rho = q & (d - 1), ubg = q >> ds;
    return DTask{g, h, ds, seq * T + rho, ubg * 256, T >> ds};
}
__device__ __forceinline__ void dshared_prefetch(u32x4 (&pre)[12], bf16x8 (&qn)[4], const char* Zc, const DTask& D, int tid, int wave, int lane) {
    const int kv = tid >> 8, row = (tid >> 3) & 31, chunk = tid & 7;
    const int col = (kv ? 6656 : 5120) + D.g * 512 + D.h * 64 + chunk * 8;
#pragma unroll
    for (int j = 0; j < 12; ++j) { const int u = D.u0b - 64 + 32 * j;
        if (u >= 0 && u + 32 <= D.U) pre[j] = *(const u32x4*)(Zc + (unsigned)zoff(D.tok0 + ((u + row) << D.ds), col) * 2u); }
    const int r32 = lane & 31, hi = lane >> 5; const int tq = D.tok0 + ((D.u0b + 32 * wave + r32) << D.ds);
    const char* Qp = Zc + (unsigned)(zoff(tq, 3584 + D.g * 512 + D.h * 64) + 8 * hi) * 2u;
#pragma unroll
    for (int s = 0; s < 4; ++s) qn[s] = *(const bf16x8*)(Qp + 32 * s);
}
__device__ __forceinline__ void dshared_task(const bf16_t* Z, float* DO, float* DL, int T, const DTask& D, const DTask& Nx, bool hasN, u32x4 (&pre)[12], bf16x8 (&qn)[4], LAS unsigned char* lds, int tid, int wave) {
    const int lane = tid & 63, r32 = lane & 31, hi = lane >> 5;
    asm volatile("s_waitcnt lgkmcnt(0)\n\ts_barrier" ::: "memory");
    { const int kv = tid >> 8, row = (tid >> 3) & 31, chunk = tid & 7; LAS unsigned char* wp = lds + (kv ? SVOFF + row * VP : row * KP) + chunk * 16;
#pragma unroll
      for (int j = 0; j < 12; ++j) { const int u = D.u0b - 64 + 32 * j; if (u >= 0 && u + 32 <= D.U) *(LAS u32x4*)(wp + j * (kv ? SVT : SKT)) = pre[j]; } }
    bf16x8 qf[4];
#pragma unroll
    for (int s = 0; s < 4; ++s) qf[s] = qn[s];
    asm volatile("s_waitcnt lgkmcnt(0)\n\ts_barrier" ::: "memory");
    if (hasN) dshared_prefetch(pre, qn, (const char*)Z, Nx, tid, wave, lane);
    const int u0 = D.u0b + 32 * wave, jlo = u0 >= 64 ? 0 : (u0 >= 32 ? 1 : 2), jhi = (u0 + 96 <= D.U) ? 4 : ((u0 + 64 <= D.U) ? 3 : 2), nt = jhi - jlo + 1;
    const int keyl = r32 - 4 * hi;
    LAS unsigned char* kb0 = lds + (wave + jlo) * SKT; LAS unsigned char* vb0 = lds + SVOFF + (wave + jlo) * SVT;
    const f32x16 zero = (f32x16){0.f, 0.f, 0.f, 0.f, 0.f, 0.f, 0.f, 0.f, 0.f, 0.f, 0.f, 0.f, 0.f, 0.f, 0.f, 0.f};
    f32x16 o0 = zero, o1 = zero, sA, sB; u32x4 pbA[2], pbB[2]; float l = 0.f, mref, fcarry = 1.0f;
#define DFIX(TT, S) do { const int jt_ = jlo + (TT); \
        if (jt_ == 0) { _Pragma("unroll") for (int rr = 0; rr < 16; ++rr) S[rr] = ((rr & 3) + 8 * (rr >> 2) >= keyl) ? S[rr] : -INFINITY; } \
        else if (jt_ == 4) { _Pragma("unroll") for (int rr = 0; rr < 16; ++rr) S[rr] = ((rr & 3) + 8 * (rr >> 2) <= keyl) ? S[rr] : -INFINITY; } } while (0)
    sA = qk4(kb0, qf, lane); DFIX(0, sA);
    { float mx = sA[0];
#pragma unroll
      for (int r = 1; r < 16; ++r) mx = fmaxf(mx, sA[r]);
      mx = swap_max(mx); mx = (mx > -1e30f) ? mx : 0.f; mref = mx;
#pragma unroll
      for (int r = 0; r < 16; ++r) sA[r] -= mx; }
#define DSTEP2(SC, SN, PBR, PBW, TT) do { const int t_ = (TT); const bool nx_ = (t_ + 1 < nt); \
        if (nx_) SN = qk4(kb0 + (t_ + 1) * SKT, qf, lane); \
        if (t_ >= 1) pv2(o0, o1, vb0 + (t_ - 1) * SVT, PBR, lane); \
        float ps_ = 0.f; \
        _Pragma("unroll") for (int r = 0; r < 16; r += 2) { const float e0_ = __builtin_amdgcn_exp2f(SC[r]), e1_ = __builtin_amdgcn_exp2f(SC[r + 1]); ps_ += e0_; ps_ += e1_; PBW[r >> 3][(r >> 1) & 3] = pk2(e0_, e1_); } \
        ps_ = swap_sum(ps_); l += ps_; \
        if (__any(fcarry < 1.0f)) { o0 *= fcarry; o1 *= fcarry; } \
        fcarry = 1.0f; \
        if (nx_) { _Pragma("unroll") for (int r = 0; r < 16; ++r) SN[r] -= mref; \
            DFIX(t_ + 1, SN); float tn_ = SN[0]; \
            _Pragma("unroll") for (int r = 1; r < 16; ++r) tn_ = fmaxf(tn_, SN[r]); \
            tn_ = swap_max(tn_); \
            if (__any(tn_ > THR)) { const float d_ = fmaxf(tn_, 0.f); fcarry = __builtin_amdgcn_exp2f(-d_); mref += d_; l *= fcarry; \
                _Pragma("unroll") for (int r = 0; r < 16; ++r) SN[r] -= d_; } } \
    } while (0)
    int t = 0;
    for (; t + 1 < nt; t += 2) { DSTEP2(sA, sB, pbB, pbA, t); DSTEP2(sB, sA, pbA, pbB, t + 1); }
    if (t < nt) { DSTEP2(sA, sB, pbB, pbA, t); pv2(o0, o1, vb0 + (nt - 1) * SVT, pbA, lane); }
    else pv2(o0, o1, vb0 + (nt - 1) * SVT, pbB, lane);
#undef DSTEP2
#undef DFIX
    const float inv = __builtin_amdgcn_rcpf(l);
    const int tq = D.tok0 + ((u0 + r32) << D.ds);
    bf16_t* op = (bf16_t*)DO + ((size_t)D.g * GT + tq) * 512 + D.h * 64;
#pragma unroll
    for (int a4 = 0; a4 < 4; ++a4) { const int d0 = 8 * a4 + 4 * hi;
        u32x2 w; w.x = pk2(o0[4 * a4] * inv, o0[4 * a4 + 1] * inv); w.y = pk2(o0[4 * a4 + 2] * inv, o0[4 * a4 + 3] * inv); *(u32x2*)(op + d0) = w;
        u32x2 w1; w1.x = pk2(o1[4 * a4] * inv, o1[4 * a4 + 1] * inv); w1.y = pk2(o1[4 * a4 + 2] * inv, o1[4 * a4 + 3] * inv); *(u32x2*)(op + 32 + d0) = w1; }
    if (hi == 0) DL[((size_t)D.g * GT + tq) * 8 + D.h] = mref + __log2f(l);
}
__device__ __forceinline__ void dshared(const bf16_t* Z, float* DO, float* DL, int T, int wx, int nwg, LAS unsigned char* lds, int tid, int wave) {
    if (wx >= 1536) return;
    const int lane = tid & 63;
    DTask D = dtask_of(T, wx), Nx = D; u32x4 pre[12]; bf16x8 qn[4];
    dshared_prefetch(pre, qn, (const char*)Z, D, tid, wave, lane);
    for (int j = wx; j < 1536; j += nwg) {
        const bool hasN = j + nwg < 1536; if (hasN) Nx = dtask_of(T, j + nwg);
        dshared_task(Z, DO, DL, T, D, Nx, hasN, pre, qn, lds, tid, wave);
        D = Nx;
    }
}
}

namespace fftm {
constexpr int PP = 320, PLANE = 128 * PP;
__device__ __forceinline__ bf16x8 trB(LAS unsigned char* p) {
    const s16x4 lo = __builtin_amdgcn_ds_read_tr16_b64_v4i16((LAS s16x4*)p), hh = __builtin_amdgcn_ds_read_tr16_b64_v4i16((LAS s16x4*)(p + 4 * PP));
    return (bf16x8){lo[0], lo[1], lo[2], lo[3], hh[0], hh[1], hh[2], hh[3]};
}
__device__ __forceinline__ bf16_t bf1(float x) { return (bf16_t)(pk2(x, 0.f) & 0xffffu); }
constexpr int UP = 272, PLOFF = 36864;
template <int N1>
__device__ __forceinline__ void pass1(const bf16_t* Zs, bf16_t* Bs, int t2, int g4, int dftstep, const bf16_t* W, const bf16_t* W128, LAS unsigned char* lds, int tid) {
    __syncthreads();
    { bf16x8 uv[N1 / 32];
#pragma unroll
      for (int i = 0; i < N1 / 32; ++i) { const int idx = tid + 512 * i, t1 = idx >> 4, c = idx & 15; uv[i] = *(const bf16x8*)(Zs + zoff(t1 * 128 + t2, g4 * 128 + c * 8)); }
#pragma unroll
      for (int i = 0; i < N1 / 32; ++i) { const int idx = tid + 512 * i, t1 = idx >> 4, c = idx & 15; *(LAS bf16x8*)(lds + t1 * UP + c * 16) = uv[i]; } }
    __syncthreads();
    constexpr int KB = N1 / 32, TPW = N1 / 64;
    const int lane = tid & 63, wid = __builtin_amdgcn_readfirstlane(tid >> 6), r32 = lane & 31, hi = lane >> 5;
    LAS unsigned char* const pl = lds + PLOFF;
    {
        const int tb = wid & 3, ca0 = (wid >> 2) * 2;
        if (tb < KB) {
            f32x16 aP[2], aQ[2];
#pragma unroll
            for (int t = 0; t < 2; ++t) { aP[t] = (f32x16){0.f, 0.f, 0.f, 0.f, 0.f, 0.f, 0.f, 0.f, 0.f, 0.f, 0.f, 0.f, 0.f, 0.f, 0.f, 0.f}; aQ[t] = aP[t]; }
            const LAS unsigned char* up = lds + (tb * 32 + r32) * UP + 16 * hi;
#pragma unroll
            for (int kh = 0; kh < 2; ++kh) {
                bf16x8 wP[4][2], wQ[4][2];
#pragma unroll
                for (int k4 = 0; k4 < 4; ++k4)
#pragma unroll
                    for (int t = 0; t < 2; ++t) { const bf16_t* wr_ = W128 + ((ca0 + t) * 32 + r32) * 128 + 16 * (kh * 4 + k4) + 8 * hi;
                        wP[k4][t] = *(const bf16x8*)wr_; wQ[k4][t] = *(const bf16x8*)(wr_ + 16384); }
                __builtin_amdgcn_sched_barrier(0);
#pragma unroll
                for (int k4 = 0; k4 < 4; ++k4) { const bf16x8 au = *(const LAS bf16x8*)(up + (kh * 4 + k4) * 32);
#pragma unroll
                    for (int t = 0; t < 2; ++t) { aP[t] = __builtin_amdgcn_mfma_f32_32x32x16_bf16(au, wP[k4][t], aP[t], 0, 0, 0); aQ[t] = __builtin_amdgcn_mfma_f32_32x32x16_bf16(au, wQ[k4][t], aQ[t], 0, 0, 0); } }
                __builtin_amdgcn_sched_barrier(0); }
#pragma unroll
            for (int t = 0; t < 2; ++t)
#pragma unroll
                for (int r = 0; r < 16; ++r) { LAS bf16_t* o = (LAS bf16_t*)(pl + (tb * 32 + crow(r, hi)) * PP) + (ca0 + t) * 32 + r32; o[0] = bf1(aP[t][r]); *(LAS bf16_t*)((LAS unsigned char*)o + PLANE) = bf1(aQ[t][r]); }
        }
    }
    __syncthreads();
    const int kblk = wid % KB, cb0 = (wid / KB) * TPW;
    const bf16_t* wc = W + (kblk * 32 + r32) * N1 + 8 * hi; const bf16_t* wsn = wc + N1 * N1; const bf16_t* wn = wsn + N1 * N1;
    const int vb = (8 * hi + ((lane >> 2) & 3)) * PP + (16 * ((lane >> 4) & 1) + 4 * (lane & 3)) * 2;
    f32x16 re[TPW], im[TPW];
#pragma unroll
    for (int t = 0; t < TPW; ++t) { re[t] = (f32x16){0.f, 0.f, 0.f, 0.f, 0.f, 0.f, 0.f, 0.f, 0.f, 0.f, 0.f, 0.f, 0.f, 0.f, 0.f, 0.f}; im[t] = re[t]; }
#pragma unroll
    for (int kh = 0; kh < N1 / 64; ++kh) {
        bf16x8 ac[4], as[4], an[4];
#pragma unroll
        for (int k4 = 0; k4 < 4; ++k4) { const int ks = kh * 4 + k4; ac[k4] = *(const bf16x8*)(wc + 16 * ks); as[k4] = *(const bf16x8*)(wsn + 16 * ks); an[k4] = *(const bf16x8*)(wn + 16 * ks); }
        __builtin_amdgcn_sched_barrier(0);
#pragma unroll
        for (int k4 = 0; k4 < 4; ++k4) { const int ks = kh * 4 + k4;
#pragma unroll
            for (int t = 0; t < TPW; ++t) { LAS unsigned char* bp = pl + vb + ks * 16 * PP + (cb0 + t) * 64;
                const bf16x8 bP = trB(bp), bQ = trB(bp + PLANE);
                re[t] = __builtin_amdgcn_mfma_f32_32x32x16_bf16(ac[k4], bP, re[t], 0, 0, 0); re[t] = __builtin_amdgcn_mfma_f32_32x32x16_bf16(an[k4], bQ, re[t], 0, 0, 0);
                im[t] = __builtin_amdgcn_mfma_f32_32x32x16_bf16(as[k4], bP, im[t], 0, 0, 0); im[t] = __builtin_amdgcn_mfma_f32_32x32x16_bf16(ac[k4], bQ, im[t], 0, 0, 0); } }
        __builtin_amdgcn_sched_barrier(0);
    }
#pragma unroll
    for (int t = 0; t < TPW; ++t) { const int ch = (cb0 + t) * 32 + r32;
#pragma unroll
        for (int r = 0; r < 16; ++r) { const int k1 = kblk * 32 + crow(r, hi); const float x = (float)((k1 * t2 * dftstep) & 16383) * (1.0f / 16384.0f);
            const float c = __builtin_amdgcn_cosf(x), sn = __builtin_amdgcn_sinf(x);
            bf16_t* o = Bs + ((((size_t)k1 * 128 + t2) * 4 + g4) * 256 + ch);
            o[0] = bf1(re[t][r] * c - im[t][r] * sn); o[128] = bf1(re[t][r] * sn + im[t][r] * c); } }
}
template <int N1>
__device__ __forceinline__ void pass2(const bf16_t* Bs, bf16_t* Ys, int k1, int g4, float rsT, const bf16_t* W128, LAS unsigned char* lds, int tid) {
    __syncthreads();
    { bf16x8 rv[4], iv[4];
#pragma unroll
      for (int i = 0; i < 4; ++i) { const int idx = tid + 512 * i, t2 = idx >> 4, c = idx & 15; const bf16_t* p = Bs + ((((size_t)k1 * 128 + t2) * 4 + g4) * 256 + c * 8); rv[i] = *(const bf16x8*)p; iv[i] = *(const bf16x8*)(p + 128); }
#pragma unroll
      for (int i = 0; i < 4; ++i) { const int idx = tid + 512 * i, t2 = idx >> 4, c = idx & 15; *(LAS bf16x8*)(lds + t2 * PP + c * 16) = rv[i]; *(LAS bf16x8*)(lds + PLANE + t2 * PP + c * 16) = iv[i]; } }
    __syncthreads();
    const int lane = tid & 63, wid = __builtin_amdgcn_readfirstlane(tid >> 6), r32 = lane & 31, hi = lane >> 5;
    const int kblk = wid & 3, cb0 = (wid >> 2) * 2;
    const bf16_t* wc = W128 + (kblk * 32 + r32) * 128 + 8 * hi; const bf16_t* wn = wc + 2 * 128 * 128;
    const int vb = (8 * hi + ((lane >> 2) & 3)) * PP + (16 * ((lane >> 4) & 1) + 4 * (lane & 3)) * 2;
    f32x16 acc[2];
    acc[0] = (f32x16){0.f, 0.f, 0.f, 0.f, 0.f, 0.f, 0.f, 0.f, 0.f, 0.f, 0.f, 0.f, 0.f, 0.f, 0.f, 0.f}; acc[1] = acc[0];
    bf16x8 ac[8], an[8];
#pragma unroll
    for (int ks = 0; ks < 8; ++ks) { ac[ks] = *(const bf16x8*)(wc + 16 * ks); an[ks] = *(const bf16x8*)(wn + 16 * ks); }
    __builtin_amdgcn_sched_barrier(0);
#pragma unroll
    for (int ks = 0; ks < 8; ++ks) {
#pragma unroll
        for (int t = 0; t < 2; ++t) { LAS unsigned char* bp = lds + vb + ks * 16 * PP + (cb0 + t) * 64;
            const bf16x8 bR = trB(bp), bI = trB(bp + PLANE);
            acc[t] = __builtin_amdgcn_mfma_f32_32x32x16_bf16(ac[ks], bR, acc[t], 0, 0, 0); acc[t] = __builtin_amdgcn_mfma_f32_32x32x16_bf16(an[ks], bI, acc[t], 0, 0, 0); }
    }
#pragma unroll
    for (int t = 0; t < 2; ++t) { const int ch = (cb0 + t) * 32 + r32;
#pragma unroll
        for (int r = 0; r < 16; ++r) { const int k2 = kblk * 32 + crow(r, hi); *(bf16_t*)((char*)Ys + pg8::atile_off(k1 + N1 * k2, (g4 * 128 + ch) & ~7, DM / 64) + (ch & 7) * 2) = bf1(acc[t][r] * rsT); } }
}
}

constexpr int NPH = 52;
__global__ void __launch_bounds__(512, 2) fwd(Args a_unused) {
    extern __shared__ __attribute__((aligned(16))) unsigned char lds_raw[];
    LAS unsigned char* lds = (LAS unsigned char*)lds_raw;
    const int wg = blockIdx.x, nwg = gridDim.x;
    int wv = __builtin_amdgcn_readfirstlane((int)threadIdx.x >> 6); asm volatile("" : "+s"(wv));
    { const int tid0 = opaque_tid(wv); for (int u = tid0; u < (LDS_BYTES - LDSCTL_OFF) / 4; u += 512) ((LAS unsigned*)(lds + LDSCTL_OFF))[u] = 0u; }
    __syncthreads();
    int lo, hi; XcdBarrier bar;
    { KArgs* ka = kargs(); lo = ka->ph_lo; hi = ka->ph_hi; unsigned* barw = (unsigned*)(ka->ws + WS_CTL) + CW_BAR + ka->li * XCD_BAR_WORDS;
      bar.bar = barw; bar.x = 0; bar.st = (volatile LAS unsigned*)(lds + MISC_OFF + 32); bar.wv = wv;
      if (hi - lo > 1) bar = xcd_barrier_post(barw, (volatile LAS unsigned*)(lds + MISC_OFF + 32), wv); }
    int pi = 0;
#define PH_BEGIN if (pi >= lo && pi < hi) { KArgs& a = *kargs(); unsigned char* const ws = a.ws; (void)ws;
#define PH_END   if (pi + 1 < hi) xcd_barrier(bar); } ++pi;

    PH_BEGIN prologue_phase(a, lds, wg, nwg, opaque_tid(wv)); PH_END
    PH_BEGIN prologue2_phase(a, lds, wg, nwg, opaque_tid(wv)); PH_END
    PH_BEGIN { const int t_ = opaque_tid(wv); for (int rep = 0; rep < NREP(6); ++rep) norm_first_phase(a, wg, nwg, __builtin_amdgcn_readfirstlane(t_ >> 6), t_ & 63); } PH_END

    for (int l = 0; l < 2; ++l) {
        for (int s = 0; s < 3; ++s) {
            const bool first = (l == 0 && s == 0);
            if ((DBG_SKIP & 1) && s == 1) { pi += 20; continue; }
            if (s != 1) {
                PH_BEGIN { unsigned char* wl = ws + WS_W + (size_t)l * WLAYER; pg8::PlainOrder S; S.init(ws + WS_H, wl + (s == 0 ? WO_FF1I : WO_FF2I), NTOK, 2 * DFF, DM, DM, nwg, wg, WGM_FFI); S.atile = !first;        pg8::EpiSwiGLU E{(bf16_t*)(ws + WS_BIG), (const float*)(ws + WS_SS) + (size_t)(l * 3 + s) * NTOK, (const float*)(ws + WS_BW) + (size_t)l * 6 * BWL + (s == 0 ? 0 : 27392)};
                           for (int rep = 0; rep < NREP(0); ++rep) pg8::gemm_phase(lds, DM, DM, DM, S, E, wv); } PH_END
                PH_BEGIN { unsigned char* wl = ws + WS_W + (size_t)l * WLAYER; pg8::PlainOrder S; S.init(ws + WS_BIG, wl + (s == 0 ? WO_FF1O : WO_FF2O), NTOK, DM, DFF, DFF, nwg, wg, WGM_FFO);
                           const bool lastsub = (l == 1 && s == 2);
                           pg8::EpiResid E{first ? a.in[I_XP] : (const float*)nullptr, first ? a.in[I_XS] - (size_t)32768 * DM : (const float*)nullptr, (float*)(ws + WS_XF), lastsub ? a.out : (float*)nullptr,
                                           (const float*)(ws + WS_MOD) + (size_t)l * 6 * NMODC, (3 * s + 2) * DM, 0.5f, 0,
                                           lastsub ? (bf16_t*)nullptr : (bf16_t*)(ws + WS_H), (const float*)(ws + WS_AT) + (size_t)(l * 3 + s + 1) * 6 * DM, (float*)(ws + WS_SS) + (size_t)(l * 3 + s + 1) * NTOK};
                           pg8::gemm_phase(lds, DFF, DFF, DFF, S, E, wv); } PH_END
            } else {
                for (int g = 0; g < 4; ++g) {
                    const int T = g < 2 ? 16384 : 8192;
                    PH_BEGIN if (!(DBG_SKIP & 128)) { unsigned char* wl = ws + WS_W + (size_t)l * WLAYER; pg8::PlainOrder S; S.init((bf16_t*)(ws + WS_H) + (size_t)g * GT * DM, wl + WO_IN, GT, NINV, DM, DM, nwg, wg, WGM_INP);
                               pg8::EpiInProj E{(bf16_t*)(ws + WS_Z), (bf16_t*)(ws + WS_G), a.in[I_BGATE] + (size_t)l * 4 * DM, T - 1, (const float*)(ws + WS_SS) + (size_t)(l * 3 + 1) * NTOK, (const float*)(ws + WS_BW) + (size_t)l * 6 * BWL + 11008, g * GT};
                               for (int rep = 0; rep < NREP(1); ++rep) pg8::gemm_phase(lds, DM, DM, DM, S, E, wv); } PH_END
                    PH_BEGIN {
                        bf16_t* Zb = (bf16_t*)(ws + WS_Z); bf16_t* Yb = (bf16_t*)(ws + WS_Y);
                        { const float* lamp = (const float*)(ws + WS_LAM); const float* lng = a.in[I_DLNG] + l * 128;
                          if (!(DBG_SKIP & 2)) for (int rep = 0; rep < NREP(2); ++rep) for (int u = wg; u < 256; u += nwg) { const int x = u & 7, h = x >> 1; int seq, qb;
                            if (T == 16384) { seq = 0; qb = (u >> 3) * 2 + (x & 1); } else { seq = x & 1; qb = u >> 3; }
                            dattn::unit<0>(Zb + (size_t)seq * T * ZR, T, h, qb, lamp, l, lng, Yb + (size_t)seq * T * DM, (u32x4*)(ws + WS_DOS) + (size_t)u * 4096, lds, wv);
#if DBG_PROBE >= 0
                            dattn::unit<DBG_PROBE>(Zb + (size_t)seq * T * ZR, T, h, qb, lamp, l, lng, (bf16_t*)(ws + WS_MG) + (size_t)seq * T * DM, (u32x4*)(ws + WS_DOS) + (size_t)u * 4096, lds, wv);
#endif
                            } }
                        __syncthreads();
                        { const int tid = opaque_tid(wv), lane = tid & 63, wave = __builtin_amdgcn_readfirstlane(tid >> 6);
                          LAS unsigned char* vbuf = lds + wave * wattn::WBUF; const float* relb = a.in[I_RELB] + (size_t)l * 8 * 465;
                          LAS float* tabl = (LAS float*)(lds + 8 * wattn::WBUF);
                          { float tv[8];
#pragma unroll
                            for (int i = 0; i < 8; ++i) { const int e = tid + 512 * i; tv[i] = e < 8 * 465 ? relb[e] : 0.f; }
#pragma unroll
                            for (int i = 0; i < 8; ++i) { const int e = tid + 512 * i; if (e < 8 * 465) tabl[e] = tv[i] * LOG2E; } }
                          __syncthreads();
                          float* DO = (float*)(ws + WS_DILO); float* DL = (float*)(ws + WS_DILL);
                          for (int rep = 0; rep < NREP(3); ++rep) {
                          const int wx = (nwg == 256) ? ((wg & 7) * 32 + (wg >> 3)) : wg;
                          wattn::stream(Zb, Yb, DO, DL, tabl, T, wave, wx, nwg, vbuf);
                          __syncthreads();
                          wattn::dshared(Zb, DO, DL, T, wx, nwg, lds, opaque_tid(wv), wave); }
                          }
                        __syncthreads();
                        { const int tid = opaque_tid(wv); const bf16_t* dft = (const bf16_t*)(ws + WS_DFT); bf16_t* FB = (bf16_t*)(ws + WS_FFTB);
                          for (int rep = 0; rep < NREP(4); ++rep)
                          if (DBG_SKIP & 16) {} else if (T == 16384) { for (int u = wg; u < 512; u += nwg) fftm::pass1<128>(Zb, FB, u >> 2, u & 3, 1, dft, dft, lds, tid); }
                          else { for (int u = wg; u < 1024; u += nwg) { const int seq = u >> 9; fftm::pass1<64>(Zb + (size_t)seq * 8192 * ZR, FB + (size_t)seq * 64 * 128 * 1024, (u >> 2) & 127, u & 3, 2, dft + 49152, dft, lds, tid); } } }
                    } PH_END
                    PH_BEGIN {
                        const int tid = opaque_tid(wv); bf16_t* Yb = (bf16_t*)(ws + WS_Y); const bf16_t* FB = (const bf16_t*)(ws + WS_FFTB); const bf16_t* dft = (const bf16_t*)(ws + WS_DFT); const float* DO = (const float*)(ws + WS_DILO); const float* DL = (const float*)(ws + WS_DILL);
                        for (int rep = 0; rep < NREP(4); ++rep)
                        if (DBG_SKIP & 16) {} else if (T == 16384) { for (int u = wg; u < 512; u += nwg) fftm::pass2<128>(FB, Yb, u >> 2, u & 3, 0.0078125f * 0.08838834764831843f, dft, lds, tid); }
                        else { for (int u = wg; u < 512; u += nwg) { const int seq = u >> 8; fftm::pass2<64>(FB + (size_t)seq * 64 * 128 * 1024, Yb + (size_t)seq * 8192 * DM, (u >> 2) & 63, u & 3, 0.011048543456039806f * 0.08838834764831843f, dft, lds, tid); } }
                        if (DBG_SKIP & 30) { for (int item = wg * 512 + tid; item < GT * 512; item += nwg * 512) { const int row = item >> 9, c4 = item & 511, part = c4 >> 7;
                            const bool z = (part == 0 && (DBG_SKIP & 16)) || (part == 1 && (DBG_SKIP & 4)) || (part == 2 && (DBG_SKIP & 2)) || (part == 3 && (DBG_SKIP & 8));
                            if (z) *(u32x2*)(Yb + (size_t)row * DM + c4 * 4) = ((DBG_SKIP & 64) && part == 1) ? ((DBG_SKIP & 128) ? *(const u32x2*)((const bf16_t*)(ws + WS_H) + ((size_t)g * GT + row) * DM + (c4 - 128) * 4) : *(const u32x2*)((const bf16_t*)(ws + WS_Z) + (size_t)row * ZP + 512 + (c4 - 128) * 4)) : (u32x2){0u, 0u}; } }
                        if (!(DBG_SKIP & 8)) {
                            const bf16_t* DOb = (const bf16_t*)DO; const int istr = nwg * 512;
#pragma unroll 1
                            for (int item0 = wg * 512 + tid; item0 < GT * 128; item0 += 4 * istr) {
                                float Lv[4][3]; u32x2 pv[4][3];
#pragma unroll
                                for (int q = 0; q < 4; ++q) { const int item = item0 + q * istr; const bool ok = item < GT * 128; const int row = ok ? item >> 7 : 0, c4 = item & 127, h = c4 >> 4;
#pragma unroll
                                    for (int gq = 0; gq < 3; ++gq) { Lv[q][gq] = DL[((size_t)gq * GT + row) * 8 + h]; pv[q][gq] = *(const u32x2*)(DOb + ((size_t)gq * GT + row) * 512 + c4 * 4); } }
#pragma unroll
                                for (int q = 0; q < 4; ++q) { const int item = item0 + q * istr; if (item >= GT * 128) break; const int row = item >> 7, c4 = item & 127;
                                    const float L0 = Lv[q][0], L1 = Lv[q][1], L2 = Lv[q][2];
                                    const float mx = fmaxf(L0, fmaxf(L1, L2)); const float w0 = __builtin_amdgcn_exp2f(L0 - mx), w1 = __builtin_amdgcn_exp2f(L1 - mx), w2 = __builtin_amdgcn_exp2f(L2 - mx);
                                    const float inv = __builtin_amdgcn_rcpf(w0 + w1 + w2);
                                    const u32x2 p0 = pv[q][0], p1 = pv[q][1], p2 = pv[q][2];
                                    const f32x4 o = ((f32x4){bf_lo(p0.x), bf_hi(p0.x), bf_lo(p0.y), bf_hi(p0.y)} * w0 + (f32x4){bf_lo(p1.x), bf_hi(p1.x), bf_lo(p1.y), bf_hi(p1.y)} * w1 + (f32x4){bf_lo(p2.x), bf_hi(p2.x), bf_lo(p2.y), bf_hi(p2.y)} * w2) * inv;
                                    u32x2 w; w.x = pk2(o[0], o[1]); w.y = pk2(o[2], o[3]); *(u32x2*)((char*)Yb + pg8::atile_off(row, 1536 + (c4 >> 1) * 8, DM / 64) + (c4 & 1) * 8) = w; } } }
                    } PH_END
                    PH_BEGIN { unsigned char* wl = ws + WS_W + (size_t)l * WLAYER; pg8::MergeOrder S{(const char*)(ws + WS_Y), (const char*)(wl + WO_BR), nwg, wg}; pg8::EpiMerge E{(const bf16_t*)(ws + WS_G), (bf16_t*)(ws + WS_MG)};
                               for (int rep = 0; rep < NREP(5); ++rep) pg8::gemm_hm3(lds, DM, DM, DM, S, E, wv); } PH_END
                    PH_BEGIN { unsigned char* wl = ws + WS_W + (size_t)l * WLAYER; pg8::PlainOrder S; S.init(ws + WS_MG, wl + WO_OUT, GT, DM, DM, DM, nwg, wg);
                               pg8::EpiResid E{(const float*)nullptr, (const float*)nullptr, (float*)(ws + WS_XF), (float*)nullptr, (const float*)(ws + WS_MOD) + (size_t)l * 6 * NMODC, 5 * DM, 1.0f, g * GT,
                                               (bf16_t*)(ws + WS_H), (const float*)(ws + WS_AT) + (size_t)(l * 3 + 2) * 6 * DM, (float*)(ws + WS_SS) + (size_t)(l * 3 + 2) * NTOK};
                               pg8::gemm_phase(lds, DM, DM, DM, S, E, wv); } PH_END
                }
            }
        }
    }
    PH_BEGIN { const int t_ = opaque_tid(wv); final_phase(a, wg, nwg, __builtin_amdgcn_readfirstlane(t_ >> 6), t_ & 63); } PH_END
#undef PH_BEGIN
#undef PH_END
}

extern "C" void kernel_launch(void* const* d_in, const int* in_sizes, int n_in, void* d_out, int out_size, void* d_ws, size_t ws_size, hipStream_t stream) {
    static int grid = 0;
    if (grid == 0) {
        if (n_in != 24 || in_sizes[0] != 32768 * DM || out_size != NTOK * DM || ws_size < WS_END) { fprintf(stderr, "kernel_launch: unexpected shapes (n_in %d, out %d, ws %zu, need %zu)\n", n_in, out_size, ws_size, (size_t)WS_END); grid = -1; return; }
        int dev = 0, cus = 0, per_cu = 0;
        if (hipGetDevice(&dev) != hipSuccess || hipDeviceGetAttribute(&cus, hipDeviceAttributeMultiprocessorCount, dev) != hipSuccess) { grid = -1; return; }
        if (hipFuncSetAttribute((const void*)fwd, hipFuncAttributeMaxDynamicSharedMemorySize, LDS_BYTES) != hipSuccess) { fprintf(stderr, "kernel_launch: hipFuncSetAttribute failed\n"); grid = -1; return; }
        if (hipOccupancyMaxActiveBlocksPerMultiprocessor(&per_cu, (const void*)fwd, 512, LDS_BYTES) != hipSuccess || per_cu < 1) { fprintf(stderr, "kernel_launch: occupancy query says %d\n", per_cu); }
        (void)hipGetLastError();
        grid = cus > 256 ? 256 : cus;
    }
    if (grid < 0) return;
    if (hipMemsetAsync((char*)d_ws + WS_CTL, 0, CTL_ZERO_BYTES, stream) != hipSuccess) return;
    Args a{};
    for (int i = 0; i < 24; ++i) a.in[i] = (const float*)d_in[i];
    a.out = (float*)d_out; a.ws = (unsigned char*)d_ws; a.pad = 0;
#if MK_ONE_LAUNCH
    a.ph_lo = 0; a.ph_hi = NPH; a.li = 0;
    hipLaunchKernelGGL(fwd, dim3(grid), dim3(512), LDS_BYTES, stream, a);
#else
    for (int li = 0; li < NPH; ++li) { a.ph_lo = li; a.ph_hi = li + 1; a.li = 0; hipLaunchKernelGGL(fwd, dim3(grid), dim3(512), LDS_BYTES, stream, a); }
#endif
}
```

```cpp
#include <hip/hip_runtime.h>
#include <cstdio>
#include <cstdint>

#ifndef MK_ONE_LAUNCH
#define MK_ONE_LAUNCH 1
#endif
#ifndef DBG_SKIP
#define DBG_SKIP 0
#endif
#ifndef DBG_REP
#define DBG_REP 0
#endif
#ifndef DBG_PROBE
#define DBG_PROBE -1
#endif
#ifndef WGM_FFI
#define WGM_FFI 4
#endif
#ifndef WGM_INP
#define WGM_INP 4
#endif
#ifndef WGM_FFO
#define WGM_FFO 4
#endif
#ifndef DBG_WPROBE
#define DBG_WPROBE 0
#endif
#define NREP(k) (1 + ((DBG_REP >> (k)) & 1))

#define LAS __attribute__((address_space(3)))
typedef unsigned short bf16_t;
typedef short bf16x8 __attribute__((ext_vector_type(8)));
typedef short s16x4 __attribute__((ext_vector_type(4)));
typedef float f32x4 __attribute__((ext_vector_type(4)));
typedef float f32x2 __attribute__((ext_vector_type(2)));
typedef float f32x16 __attribute__((ext_vector_type(16)));
typedef unsigned u32x4 __attribute__((ext_vector_type(4)));
typedef unsigned u32x2 __attribute__((ext_vector_type(2)));

constexpr int DM = 2048, NTOK = 65536, DFF = 5504, GT = 16384, ZP = 8192, NINV = 16384, NMODC = 18432;
constexpr int ZR = 64;
__host__ __device__ __forceinline__ size_t zoff(int row, int col) { return ((size_t)(col >> 6) * GT + row) * ZR + (col & 63); }
constexpr float EPS = 1e-6f;
constexpr float LOG2E = 1.4426950408889634f;
constexpr float C2 = 0.125f * 1.4426950408889634f;

constexpr size_t MiB = 1u << 20;
constexpr size_t WS_CTL = 0, CTL_ZERO_BYTES = 1 * MiB;
constexpr size_t WS_MOD = 1 * MiB;
constexpr size_t WS_ROPE = 2 * MiB;
constexpr size_t WS_DFT = 3 * MiB;
constexpr size_t WS_LAM = 3 * MiB + 256 * 1024;
constexpr size_t WS_W = 4 * MiB;
constexpr size_t WO_FF1I = 0, WO_FF1O = 45088768, WO_IN = 67633152, WO_BR = 134742016, WO_OUT = 143130624, WO_FF2I = 151519232, WO_FF2O = 196608000, WLAYER = 219152384;
constexpr size_t WS_H = 426 * MiB;
constexpr size_t WS_BIG = 682 * MiB;
constexpr size_t WS_Z = WS_BIG, WS_G = WS_BIG + 272 * MiB, WS_Y = WS_BIG + 528 * MiB, WS_MG = WS_BIG + 592 * MiB, WS_FFTB = WS_BIG + 656 * MiB,
                 WS_DILO = WS_BIG + 688 * MiB, WS_DILL = WS_BIG + 784 * MiB, WS_DOS = WS_BIG + 786 * MiB,
                 WS_SS = WS_BIG + 802 * MiB  ,
                 WS_AT = WS_SS + 2 * MiB  , WS_BW = WS_AT + 1 * MiB  , WS_XF = WS_BW + 2 * MiB  , WS_END = WS_XF + 512 * MiB;
constexpr int BWL = 38400;
static_assert(WS_W + 2 * WLAYER <= WS_H, "weights region");
constexpr int CW_BAR = 4096;

constexpr int LDS_BYTES = 148480;
constexpr int LDSCTL_OFF = 147456;
constexpr int MISC_OFF = LDSCTL_OFF + 320;

__device__ __forceinline__ float bf_lo(unsigned w) { return __uint_as_float(w << 16); }
__device__ __forceinline__ float bf_hi(unsigned w) { return __uint_as_float(w & 0xffff0000u); }
typedef __bf16 bf16x2_t __attribute__((ext_vector_type(2)));
__device__ __forceinline__ unsigned pk2(float lo, float hi) { const f32x2 v = {lo, hi}; const bf16x2_t b = __builtin_convertvector(v, bf16x2_t); return __builtin_bit_cast(unsigned, b); }
__device__ __forceinline__ float swap_max(float x) { auto rr = __builtin_amdgcn_permlane32_swap(__float_as_uint(x), __float_as_uint(x), false, false); return fmaxf(__uint_as_float(rr[0]), __uint_as_float(rr[1])); }
__device__ __forceinline__ float swap_sum(float x) { auto rr = __builtin_amdgcn_permlane32_swap(__float_as_uint(x), __float_as_uint(x), false, false); return __uint_as_float(rr[0]) + __uint_as_float(rr[1]); }
__device__ __forceinline__ int lane_now() { int l; asm volatile("v_mbcnt_lo_u32_b32 %0, -1, 0\n\tv_mbcnt_hi_u32_b32 %0, -1, %0" : "=v"(l)); return l; }
__device__ __forceinline__ int opaque_tid(int wv) { return (wv << 6) | lane_now(); }
__device__ __forceinline__ float wave_sum(float v) {
    v += __uint_as_float((unsigned)__builtin_amdgcn_ds_swizzle((int)__float_as_uint(v), (1 << 10) | 0x1f));
    v += __uint_as_float((unsigned)__builtin_amdgcn_ds_swizzle((int)__float_as_uint(v), (2 << 10) | 0x1f));
    v += __uint_as_float((unsigned)__builtin_amdgcn_ds_swizzle((int)__float_as_uint(v), (4 << 10) | 0x1f));
    v += __uint_as_float((unsigned)__builtin_amdgcn_ds_swizzle((int)__float_as_uint(v), (8 << 10) | 0x1f));
    v += __uint_as_float((unsigned)__builtin_amdgcn_ds_swizzle((int)__float_as_uint(v), (16 << 10) | 0x1f));
    return swap_sum(v);
}
__device__ __forceinline__ int opaque_lane() { return lane_now(); }
__device__ __forceinline__ int brow_of(int row) { return row < 32768 ? (row >> 14) : 2 + ((row - 32768) >> 13); }
__device__ __forceinline__ int crow(int r, int hi) { return (r & 3) + 8 * (r >> 2) + 4 * hi; }

namespace pg8 {
constexpr float ROPE_C0[8] = {1.5915494309e-01f, 3.0863763405e-02f, 5.9851857127e-03f, 1.1606636412e-03f, 2.2507907904e-04f, 4.3647952793e-05f, 8.4643308082e-06f, 1.6414262628e-06f};
constexpr float ROPE_C1[8] = {3.7183271576e-01f, 9.5056171580e-01f, 7.6610377123e-01f, 1.4856494608e-01f, 2.8810122117e-02f, 5.5869379575e-03f, 1.0834343435e-03f, 2.1010256164e-04f};
constexpr int BM = 256, BK = 64, HALF = 128, HTB = HALF * BK * 2, STAGE_BYTES = 8 * HTB, NXCD = 8, WGM = 4;
__host__ __device__ __forceinline__ int lds_byte(int r, int c) { const int st = (r >> 4) * 2 + (c >> 5), rr = r & 15, cc = c & 31, ob = rr * 64 + cc * 2; return st * 1024 + (ob ^ (((ob >> 9) & 1) << 5)); }
__host__ __device__ __forceinline__ void stage_rc(int b, int& R, int& C) { const int st = b / 1024, sb = b % 1024, swz = sb ^ (((sb >> 9) & 1) << 5); R = (st >> 1) * 16 + swz / 64; C = (st & 1) * 32 + (swz % 64) / 2; }
__host__ __device__ __forceinline__ int perm32(int rho) { const int n = rho >> 4, i = rho & 15; return 8 * (i >> 2) + 4 * n + (i & 3); }
__host__ __device__ __forceinline__ size_t atile_off(int r, int k, int nkt) { return ((size_t)((r >> 8) * nkt + (k >> 6)) * 2 + ((r >> 7) & 1)) * 16384 + lds_byte(r & 127, k & 63); }
__host__ __device__ __forceinline__ size_t wtile_off(int v, int k, int nkt) {
    const int rb = v & 127, s = rb & 31, rho = 16 * ((s >> 2) & 1) + 4 * (s >> 3) + (s & 3), R = (rb & ~31) + rho;
    return ((size_t)((v >> 8) * nkt + (k >> 6)) * 2 + ((v >> 7) & 1)) * 16384 + lds_byte(R, k & 63);
}

struct Unit { int pm, pn, pz; const char* a; const char* b; };

__device__ __forceinline__ bool tile_of(int nM, int nN, int G, int c, int i, int& pm, int& pn, int wgm = WGM) {
    const int nwg = nM * nN; const long L = (long)i * G + c; if (L >= nwg) return false;
    int wgid = (int)L; { const int q = nwg / NXCD, r = nwg % NXCD, xcd = wgid % NXCD, off = wgid / NXCD; wgid = (xcd < r ? xcd * (q + 1) : r * (q + 1) + (xcd - r) * q) + off; }
    const int nig = wgm * nN, gid = wgid / nig, fm = gid * wgm, gsz = (nM - fm) < wgm ? (nM - fm) : wgm;
    pm = fm + ((wgid % nig) % gsz); pn = (wgid % nig) / gsz; return true;
}
struct PlainOrder {
    const char* A; const char* Bt; int nM, nN, G, c, wgm; size_t tA, tB; bool atile;
    __device__ __forceinline__ void init(const void* A_, const void* Bt_, int M, int N, int lda, int ldb, int G_, int c_, int wgm_ = WGM) { A = (const char*)A_; Bt = (const char*)Bt_; nM = M / BM; nN = N / BM; G = G_; c = c_; wgm = wgm_; tA = (size_t)BM * lda * 2; tB = (size_t)BM * ldb * 2; atile = true; }
    __device__ __forceinline__ bool next(int i, Unit& u) const { int pm, pn; if (!tile_of(nM, nN, G, c, i, pm, pn, wgm)) return false; u.pm = pm; u.pn = pn; u.pz = 0; u.a = A + (size_t)pm * tA; u.b = Bt + (size_t)pn * tB; return true; }
};
struct MergeOrder {
    const char* A; const char* Bt; int G, c; static constexpr bool atile = false;
    __device__ __forceinline__ bool next(int i, Unit& u) const { int pm, pn; if (!tile_of(64, 8, G, c, i >> 1, pm, pn)) return false; u.pm = pm; u.pn = pn; u.pz = i & 1;
        u.a = A + (size_t)pm * (32 * 32768) + (size_t)(i & 1) * 16384; u.b = Bt + (size_t)pn * (256 * 2048 * 2); return true; }
};

template <class Epi, class Sched, bool HM = false>
__device__ __forceinline__ void gemm_phase(LAS unsigned char* lds, const int K, const int lda, const int ldb, const Sched& S, const Epi& E, const int wv) {
    const int tid = opaque_tid(wv), wid = __builtin_amdgcn_readfirstlane(tid >> 6), lane = tid & 63, wr = wid >> 2, wc = wid & 3, fr = lane & 15, fq = lane >> 4;
    const int nt = K / BK;
    unsigned voffA[2], voffB[2];
#pragma unroll
    for (int i = 0; i < 2; ++i) { int R, C; stage_rc(tid * 16 + i * 8192, R, C); const int Rb = Epi::PERM ? ((R & ~31) + perm32(R & 31)) : R;
        voffA[i] = S.atile ? (unsigned)(tid * 16 + i * 8192) : (unsigned)(R * lda + C) * 2u; voffB[i] = (unsigned)(tid * 16 + i * 8192); (void)Rb; }
    const size_t kstep = S.atile ? (size_t)(2 * HTB) : (size_t)(BK * 2), kstepB = (size_t)(2 * HTB);
    const size_t hstepA = HM ? (size_t)0 : (S.atile ? (size_t)HTB : (size_t)HALF * lda * 2), hstepB = (size_t)HTB;
    const unsigned ldsw = (unsigned)wid * 1024u;
    const int aoff = lds_byte(wr * 64 + fr, fq * 8), boff = lds_byte(wc * 32 + fr, fq * 8);
#define PG8_SA(b, h) (((b) * 2 + (h)) * HTB)
#define PG8_SB(b, h) ((4 + (b) * 2 + (h)) * HTB)
#define PG8_STAGE(bufoff, gbase, voff) do { _Pragma("unroll") for (int _i = 0; _i < 2; ++_i) \
        __builtin_amdgcn_global_load_lds((const unsigned*)((const char*)(gbase) + (voff)[_i]), (LAS unsigned*)(lds + (bufoff) + ldsw + _i * 8192), 16, 0, 0); } while (0)
#define PG8_LDA(dst, b, h) do { _Pragma("unroll") for (int m = 0; m < 4; ++m) _Pragma("unroll") for (int k = 0; k < 2; ++k) dst[m][k] = *(const LAS bf16x8*)(lds + PG8_SA(b, h) + aoff + m * 2048 + k * 1024); } while (0)
#define PG8_LDB(dst, b, h) do { _Pragma("unroll") for (int n = 0; n < 2; ++n) _Pragma("unroll") for (int k = 0; k < 2; ++k) dst[n][k] = *(const LAS bf16x8*)(lds + PG8_SB(b, h) + boff + n * 2048 + k * 1024); } while (0)
#define PG8_MMA(ai, bj, At, Bt) do { __builtin_amdgcn_s_setprio(1); _Pragma("unroll") for (int m = 0; m < 4; ++m) _Pragma("unroll") for (int n = 0; n < 2; ++n) _Pragma("unroll") for (int k = 0; k < 2; ++k) \
        acc[ai][bj][m][n] = __builtin_amdgcn_mfma_f32_16x16x32_bf16(Bt[n][k], At[m][k], acc[ai][bj][m][n], 0, 0, 0); __builtin_amdgcn_s_setprio(0); } while (0)
#define PG8_WAIT_V(n) asm volatile("s_waitcnt vmcnt(" #n ")" ::: "memory")
#define PG8_WAIT_L(n) asm volatile("s_waitcnt lgkmcnt(" #n ")" ::: "memory")
#define PG8_BAR __builtin_amdgcn_s_barrier()
#define PG8_SCHED __builtin_amdgcn_sched_barrier(0)
    Unit cur, nxt; int ui = 0;
    if (!S.next(0, cur)) return;
    f32x4 acc[2][2][4][2];
#pragma unroll
    for (int a = 0; a < 2; ++a)
#pragma unroll
        for (int b = 0; b < 2; ++b)
#pragma unroll
            for (int m = 0; m < 4; ++m)
#pragma unroll
                for (int n = 0; n < 2; ++n) acc[a][b][m][n] = (f32x4){0.f, 0.f, 0.f, 0.f};
    bf16x8 At[4][2], B0[2][2], B1[2][2];
    const char* cA = cur.a; const char* cB = cur.b;
    PG8_STAGE(PG8_SB(0, 0), cB, voffB); PG8_STAGE(PG8_SB(0, 1), cB + hstepB, voffB); PG8_STAGE(PG8_SA(0, 0), cA, voffA); PG8_STAGE(PG8_SA(0, 1), cA + hstepA, voffA);
    if (wr == 1) PG8_BAR;
    PG8_WAIT_V(2); PG8_BAR;
    PG8_STAGE(PG8_SB(1, 0), cB + kstepB, voffB); PG8_STAGE(PG8_SA(1, 0), cA + kstep, voffA); PG8_STAGE(PG8_SB(1, 1), cB + hstepB + kstepB, voffB);
    PG8_WAIT_V(6); PG8_BAR;
    for (;;) {
        const bool has_next = S.next(ui + 1, nxt);
        const char* nA = has_next ? nxt.a : cA; const char* nB = has_next ? nxt.b : cB;
        for (int t = 0; t < nt; t += 2) {
            const bool last = (t == nt - 2);
            const char* a1 = cA + (size_t)(t + 1) * kstep;
            const char* a2 = last ? nA : cA + (size_t)(t + 2) * kstep; const char* b2 = last ? nB : cB + (size_t)(t + 2) * kstepB;
            const char* a3 = a2 + kstep; const char* b3 = b2 + kstepB;
            PG8_LDB(B0, 0, 0); PG8_LDB(B1, 0, 1); PG8_SCHED; PG8_LDA(At, 0, 0); PG8_STAGE(PG8_SA(1, 1), a1 + hstepA, voffA);
            PG8_WAIT_V(8); PG8_WAIT_L(0); PG8_BAR; PG8_MMA(0, 0, At, B0); PG8_MMA(0, 1, At, B1); PG8_BAR; PG8_SCHED;
            if constexpr (!HM) PG8_LDA(At, 0, 1); PG8_STAGE(PG8_SB(0, 0), b2, voffB); PG8_STAGE(PG8_SB(0, 1), b2 + hstepB, voffB); PG8_STAGE(PG8_SA(0, 0), a2, voffA);
            PG8_WAIT_V(8); PG8_WAIT_L(0); PG8_BAR; if constexpr (!HM) { PG8_MMA(1, 0, At, B0); PG8_MMA(1, 1, At, B1); } PG8_BAR; PG8_SCHED;
            PG8_LDB(B0, 1, 0); PG8_LDB(B1, 1, 1); PG8_SCHED; PG8_LDA(At, 1, 0); PG8_STAGE(PG8_SA(0, 1), a2 + hstepA, voffA);
            PG8_WAIT_V(8); PG8_WAIT_L(0); PG8_BAR; PG8_MMA(0, 0, At, B0); PG8_MMA(0, 1, At, B1); PG8_BAR; PG8_SCHED;
            if constexpr (!HM) PG8_LDA(At, 1, 1); PG8_STAGE(PG8_SB(1, 0), b3, voffB); PG8_STAGE(PG8_SB(1, 1), b3 + hstepB, voffB); PG8_STAGE(PG8_SA(1, 0), a3, voffA);
            PG8_WAIT_V(8); PG8_WAIT_L(0); PG8_BAR; if constexpr (!HM) { PG8_MMA(1, 0, At, B0); PG8_MMA(1, 1, At, B1); } PG8_BAR; PG8_SCHED;
            if constexpr (HM) { if (((t + 2) & 7) == 0) E.fold(acc, cur, t >> 3, wr, wc, fr, fq); }
        }
        if (wr == 0) PG8_BAR;
        E(acc, cur, wr, wc, fr, fq);
        if (!has_next) break;
#pragma unroll
        for (int a = 0; a < 2; ++a)
#pragma unroll
            for (int b = 0; b < 2; ++b)
#pragma unroll
                for (int m = 0; m < 4; ++m)
#pragma unroll
                    for (int n = 0; n < 2; ++n) acc[a][b][m][n] = (f32x4){0.f, 0.f, 0.f, 0.f};
        cur = nxt; cA = nA; cB = nB; ++ui;
        if (wr == 1) PG8_BAR;
    }
    PG8_WAIT_V(0);
    PG8_BAR;
#undef PG8_SA
#undef PG8_SB
#undef PG8_STAGE
#undef PG8_LDA
#undef PG8_LDB
#undef PG8_MMA
#undef PG8_WAIT_V
#undef PG8_WAIT_L
#undef PG8_BAR
#undef PG8_SCHED
}

template <class Epi, class Sched>
__device__ __forceinline__ void gemm_hm3(LAS unsigned char* lds, const int K, const int lda, const int ldb, const Sched& S, const Epi& E, const int wv) {
    const int tid = opaque_tid(wv), wid = __builtin_amdgcn_readfirstlane(tid >> 6), lane = tid & 63, wr = wid >> 2, wc = wid & 3, fr = lane & 15, fq = lane >> 4;
    const int nt = K / BK;
    unsigned voffA[2], voffB[2];
#pragma unroll
    for (int i = 0; i < 2; ++i) { int R, C; stage_rc(tid * 16 + i * 8192, R, C); const int Rb = Epi::PERM ? ((R & ~31) + perm32(R & 31)) : R;
        voffA[i] = (unsigned)(tid * 16 + i * 8192); voffB[i] = voffA[i]; (void)R; (void)C; (void)Rb; }
    const size_t kstep = (size_t)(2 * HTB), kstepB = (size_t)(2 * HTB), hstepB = (size_t)HTB;
    const unsigned ldsw = (unsigned)wid * 1024u;
    const int aoff = lds_byte(wr * 64 + fr, fq * 8), boff = lds_byte(wc * 32 + fr, fq * 8);
    constexpr int SLOT = 3 * HTB;
#define H3_STAGE(off, gbase, voff) do { _Pragma("unroll") for (int _i = 0; _i < 2; ++_i) \
        __builtin_amdgcn_global_load_lds((const unsigned*)((const char*)(gbase) + (voff)[_i]), (LAS unsigned*)(lds + (off) + ldsw + _i * 8192), 16, 0, 0); } while (0)
#define H3_STAGE3(sl, ga, gb) do { H3_STAGE((sl), (gb), voffB); H3_STAGE((sl) + HTB, (gb) + hstepB, voffB); H3_STAGE((sl) + 2 * HTB, (ga), voffA); } while (0)
#define H3_LDA(dst, sl) do { _Pragma("unroll") for (int m = 0; m < 4; ++m) _Pragma("unroll") for (int k = 0; k < 2; ++k) dst[m][k] = *(const LAS bf16x8*)(lds + (sl) + 2 * HTB + aoff + m * 2048 + k * 1024); } while (0)
#define H3_LDB(dst, sl, h) do { _Pragma("unroll") for (int n = 0; n < 2; ++n) _Pragma("unroll") for (int k = 0; k < 2; ++k) dst[n][k] = *(const LAS bf16x8*)(lds + (sl) + (h) * HTB + boff + n * 2048 + k * 1024); } while (0)
#define H3_MMA(bj, At, Bt) do { __builtin_amdgcn_s_setprio(1); _Pragma("unroll") for (int m = 0; m < 4; ++m) _Pragma("unroll") for (int n = 0; n < 2; ++n) _Pragma("unroll") for (int k = 0; k < 2; ++k) \
        acc[0][bj][m][n] = __builtin_amdgcn_mfma_f32_16x16x32_bf16(Bt[n][k], At[m][k], acc[0][bj][m][n], 0, 0, 0); __builtin_amdgcn_s_setprio(0); } while (0)
#define H3_BAR __builtin_amdgcn_s_barrier()
    Unit cur, nxt; int ui = 0;
    if (!S.next(0, cur)) return;
    f32x4 acc[2][2][4][2];
#pragma unroll
    for (int a = 0; a < 2; ++a)
#pragma unroll
        for (int b = 0; b < 2; ++b)
#pragma unroll
            for (int m = 0; m < 4; ++m)
#pragma unroll
                for (int n = 0; n < 2; ++n) acc[a][b][m][n] = (f32x4){0.f, 0.f, 0.f, 0.f};
    bf16x8 At[4][2], B0[2][2], B1[2][2]; u32x2 gw[4][2];
    const char* cA = cur.a; const char* cB = cur.b;
    int sl = 0, sl2 = 2 * SLOT;
    H3_STAGE3(0, cA, cB); H3_STAGE3(SLOT, cA + kstep, cB + kstepB);
    asm volatile("s_waitcnt vmcnt(6)" ::: "memory"); H3_BAR;
    if (wr == 1) H3_BAR;
    for (;;) {
        const bool has_next = S.next(ui + 1, nxt);
        const char* nA = has_next ? nxt.a : cA; const char* nB = has_next ? nxt.b : cB;
        for (int t = 0; t < nt; ++t) {
            const bool own = (t + 2 < nt);
            const char* a2 = (own ? cA : nA) + (size_t)(own ? t + 2 : t + 2 - nt) * kstep; const char* b2 = (own ? cB : nB) + (size_t)(own ? t + 2 : t + 2 - nt) * kstepB;
            H3_LDB(B0, sl, 0); H3_LDB(B1, sl, 1); __builtin_amdgcn_sched_barrier(0); H3_LDA(At, sl); H3_STAGE3(sl2, a2, b2);
            const int ph_ = t & 7;
            if (ph_ == 6) { E.fold_load(gw, cur, t >> 3, wr, wc, fr, fq); __builtin_amdgcn_sched_barrier(0); }
            if (ph_ >= 6) asm volatile("s_waitcnt vmcnt(14)" ::: "memory"); else asm volatile("s_waitcnt vmcnt(6)" ::: "memory");
            asm volatile("s_waitcnt lgkmcnt(0)" ::: "memory"); H3_BAR; H3_MMA(0, At, B0); H3_MMA(1, At, B1); H3_BAR; __builtin_amdgcn_sched_barrier(0);
            sl = (sl == 2 * SLOT) ? 0 : sl + SLOT; sl2 = (sl2 == 2 * SLOT) ? 0 : sl2 + SLOT;
            if (ph_ == 7) E.fold_apply(acc, gw, t >> 3);
        }
        if (wr == 0) H3_BAR;
        E(acc, cur, wr, wc, fr, fq);
        if (!has_next) break;
#pragma unroll
        for (int a = 0; a < 2; ++a)
#pragma unroll
            for (int b = 0; b < 2; ++b)
#pragma unroll
                for (int m = 0; m < 4; ++m)
#pragma unroll
                    for (int n = 0; n < 2; ++n) acc[a][b][m][n] = (f32x4){0.f, 0.f, 0.f, 0.f};
        cur = nxt; cA = nA; cB = nB; ++ui;
        if (wr == 1) H3_BAR;
    }
    asm volatile("s_waitcnt vmcnt(0)" ::: "memory");
    H3_BAR;
#undef H3_STAGE
#undef H3_STAGE3
#undef H3_LDA
#undef H3_LDB
#undef H3_MMA
#undef H3_BAR
}

__device__ __forceinline__ float silu_f(float a) { return a * __builtin_amdgcn_rcpf(1.0f + __builtin_amdgcn_exp2f(-a * LOG2E)); }
__device__ __forceinline__ float sigm_f(float a) { return __builtin_amdgcn_rcpf(1.0f + __builtin_amdgcn_exp2f(-a * LOG2E)); }
__device__ __forceinline__ unsigned gq8(float g) { return (unsigned)(g * 255.0f + 0.5f); }
__device__ __forceinline__ unsigned gq8x4(float a, float b, float c, float d) { return gq8(a) | (gq8(b) << 8) | (gq8(c) << 16) | (gq8(d) << 24); }

struct EpiSwiGLU {
    static constexpr bool PERM = true;
    bf16_t* O; const float* ss; const float* bwl;
    __device__ __forceinline__ void operator()(const f32x4 (&acc)[2][2][4][2], const Unit& u, int wr, int wc, int fr, int fq) const {
        const int row0 = u.pm * BM + wr * 64 + fr, col0 = u.pn * 128 + wc * 32 + 8 * fq;
        const float* bw = bwl + (size_t)brow_of(u.pm * BM) * BWL + u.pn * BM + wc * 32 + 8 * fq;
        const f32x4 ba0 = *(const f32x4*)bw, ba1 = *(const f32x4*)(bw + 4), bb0 = *(const f32x4*)(bw + HALF), bb1 = *(const f32x4*)(bw + HALF + 4);
        float rsv[2][4];
#pragma unroll
        for (int ai = 0; ai < 2; ++ai)
#pragma unroll
            for (int m = 0; m < 4; ++m) rsv[ai][m] = ss[row0 + ai * HALF + m * 16];
#pragma unroll
        for (int ai = 0; ai < 2; ++ai)
#pragma unroll
            for (int m = 0; m < 4; ++m) rsv[ai][m] = __builtin_amdgcn_rsqf(rsv[ai][m] * (1.0f / DM) + EPS);
#pragma unroll
        for (int ai = 0; ai < 2; ++ai)
#pragma unroll
            for (int m = 0; m < 4; ++m) { const int row = row0 + ai * HALF + m * 16; const float rs = rsv[ai][m];
                const f32x4 a0 = acc[ai][0][m][0] * rs + ba0, a1 = acc[ai][0][m][1] * rs + ba1, b0 = acc[ai][1][m][0] * rs + bb0, b1 = acc[ai][1][m][1] * rs + bb1;
                u32x4 w;
                w.x = pk2(silu_f(a0[0]) * b0[0], silu_f(a0[1]) * b0[1]); w.y = pk2(silu_f(a0[2]) * b0[2], silu_f(a0[3]) * b0[3]);
                w.z = pk2(silu_f(a1[0]) * b1[0], silu_f(a1[1]) * b1[1]); w.w = pk2(silu_f(a1[2]) * b1[2], silu_f(a1[3]) * b1[3]);
                __builtin_nontemporal_store(w, (u32x4*)((char*)O + atile_off(row, col0, DFF / 64)));
            }
    }
};
struct EpiResid {
    static constexpr bool PERM = true;
    const float* base_p; const float* base_s;
    float* xf; float* out;
    const float* mod_l; int gofs; float coef; int rowbase;
    bf16_t* xa; const float* atab; float* ssn;
    __device__ __forceinline__ void operator()(const f32x4 (&acc)[2][2][4][2], const Unit& u, int wr, int wc, int fr, int fq) const {
        const int rabs0 = rowbase + u.pm * BM; const int br = brow_of(rabs0);
        const float* base = rabs0 < 32768 ? base_p : base_s;
        const float* g = mod_l + (size_t)br * NMODC + gofs;
        const int row0 = rabs0 + wr * 64 + fr, col0 = u.pn * BM + wc * 32 + 8 * fq;
        float* xt = xf + ((size_t)((rabs0 >> 8) * 8 + u.pn) << 16) + ((wr * 4 + wc) * 64 + fq * 16 + fr) * 4;
        f32x4 gv[2][2], av[2][2];
#pragma unroll
        for (int bj = 0; bj < 2; ++bj)
#pragma unroll
            for (int n = 0; n < 2; ++n) { gv[bj][n] = *(const f32x4*)(g + col0 + bj * HALF + n * 4) * coef; av[bj][n] = xa ? *(const f32x4*)(atab + (size_t)br * DM + col0 + bj * HALF + n * 4) : (f32x4){0.f, 0.f, 0.f, 0.f}; }
#pragma unroll
        for (int aq = 0; aq < 4; ++aq) { const int ai = aq >> 1, mb = (aq & 1) * 2;
            f32x4 bs[2][2][2];
#pragma unroll
            for (int mi = 0; mi < 2; ++mi) { const size_t off = (size_t)(row0 + ai * HALF + (mb + mi) * 16) * DM + col0; const int pc = ((ai * 4 + mb + mi) * 2) * 2;
#pragma unroll
                for (int bj = 0; bj < 2; ++bj)
#pragma unroll
                    for (int n = 0; n < 2; ++n) bs[mi][bj][n] = base_p ? __builtin_nontemporal_load((const f32x4*)(base + off + bj * HALF + n * 4)) : __builtin_nontemporal_load((const f32x4*)(xt + (pc + bj * 2 + n) * 2048)); }
#pragma unroll
            for (int mi = 0; mi < 2; ++mi) { const int m = mb + mi; const size_t off = (size_t)(row0 + ai * HALF + m * 16) * DM + col0; const int pc = ((ai * 4 + m) * 2) * 2; float sq = 0.f;
#pragma unroll
                for (int bj = 0; bj < 2; ++bj) { const f32x4 x0 = bs[mi][bj][0] + gv[bj][0] * acc[ai][bj][m][0], x1 = bs[mi][bj][1] + gv[bj][1] * acc[ai][bj][m][1];
                    if (out) { __builtin_nontemporal_store(x0, (f32x4*)(out + off + bj * HALF)); __builtin_nontemporal_store(x1, (f32x4*)(out + off + bj * HALF + 4)); }
                    else { __builtin_nontemporal_store(x0, (f32x4*)(xt + (pc + bj * 2) * 2048)); __builtin_nontemporal_store(x1, (f32x4*)(xt + (pc + bj * 2 + 1) * 2048)); }
                    if (xa) { const f32x4 y0 = x0 * av[bj][0], y1 = x1 * av[bj][1]; u32x4 w; w.x = pk2(y0[0], y0[1]); w.y = pk2(y0[2], y0[3]); w.z = pk2(y1[0], y1[1]); w.w = pk2(y1[2], y1[3]);
                              __builtin_nontemporal_store(w, (u32x4*)((char*)xa + atile_off(row0 + ai * HALF + m * 16, col0 + bj * HALF, DM / 64)));
                              sq += ((x0[0] * x0[0] + x0[1] * x0[1]) + (x0[2] * x0[2] + x0[3] * x0[3])) + ((x1[0] * x1[0] + x1[1] * x1[1]) + (x1[2] * x1[2] + x1[3] * x1[3])); } }
                if (xa) {
                    sq += __uint_as_float((unsigned)__builtin_amdgcn_ds_swizzle((int)__float_as_uint(sq), (16 << 10) | 0x1f)); sq = swap_sum(sq);
                    if (fq == 0) atomicAdd(ssn + row0 + ai * HALF + m * 16, sq); } }
        }
    }
};
struct EpiInProj {
    static constexpr bool PERM = true;
    bf16_t* Z; bf16_t* G; const float* bgate; int tmask; const float* ss; const float* bw; int rowbase;
    __device__ __forceinline__ void operator()(const f32x4 (&acc)[2][2][4][2], const Unit& u, int wr, int wc, int fr, int fq) const {
        const int row0 = u.pm * BM + wr * 64 + fr;
        const float* bwp = bw + (size_t)brow_of(rowbase + u.pm * BM) * BWL + u.pn * BM + wc * 32 + 8 * fq;
        const f32x4 bq00 = *(const f32x4*)bwp, bq01 = *(const f32x4*)(bwp + 4), bq10 = *(const f32x4*)(bwp + HALF), bq11 = *(const f32x4*)(bwp + HALF + 4);
        float rsv[2][4];
#pragma unroll
        for (int ai = 0; ai < 2; ++ai)
#pragma unroll
            for (int m = 0; m < 4; ++m) rsv[ai][m] = ss[rowbase + row0 + ai * HALF + m * 16];
#pragma unroll
        for (int ai = 0; ai < 2; ++ai)
#pragma unroll
            for (int m = 0; m < 4; ++m) rsv[ai][m] = __builtin_amdgcn_rsqf(rsv[ai][m] * (1.0f / DM) + EPS);
        if (u.pn < 32) {
            const int col0 = u.pn * BM + wc * 32 + 8 * fq;
            const bool ropet = (u.pn >= 8 && u.pn < 12) || (u.pn >= 14 && u.pn < 26);
            const bool rot = ropet && ((wc & 1) == 0) && (fq < 2);
            float rc0[4] = {0.f, 0.f, 0.f, 0.f}, rc1[4] = {0.f, 0.f, 0.f, 0.f};
            if (rot) {
#pragma unroll
                for (int e = 0; e < 4; ++e) { rc0[e] = fq ? ROPE_C0[4 + e] : ROPE_C0[e]; rc1[e] = fq ? ROPE_C1[4 + e] : ROPE_C1[e]; } }
#pragma unroll
            for (int ai = 0; ai < 2; ++ai)
#pragma unroll
                for (int m = 0; m < 4; ++m) { const int row = row0 + ai * HALF + m * 16; const float rs = rsv[ai][m];
                    float cc[4] = {1.f, 1.f, 1.f, 1.f}, sn[4] = {0.f, 0.f, 0.f, 0.f};
                    if (rot) { const int pos = row & tmask; const float ph = (float)(pos >> 7), pl = (float)(pos & 127);
#pragma unroll
                        for (int e = 0; e < 4; ++e) { const float c0 = rc0[e], c1 = rc1[e];
                            float rev = ph * c1 + pl * c0; rev = rev - __builtin_floorf(rev); cc[e] = __builtin_amdgcn_cosf(rev); sn[e] = __builtin_amdgcn_sinf(rev); } }
#pragma unroll
                    for (int bj = 0; bj < 2; ++bj) { f32x4 v0 = acc[ai][bj][m][0] * rs + (bj ? bq10 : bq00), v1 = acc[ai][bj][m][1] * rs + (bj ? bq11 : bq01);
                        if (u.pn == 2 || u.pn == 3 || u.pn == 8 || u.pn == 9 || (u.pn >= 14 && u.pn < 20)) { v0 *= C2; v1 *= C2; }
                        if (rot) {
#pragma unroll
                            for (int e = 0; e < 4; ++e) { const float x1 = v0[e], x2 = v1[e]; v0[e] = x1 * cc[e] - x2 * sn[e]; v1[e] = x2 * cc[e] + x1 * sn[e]; } }
                        u32x4 w; w.x = pk2(v0[0], v0[1]); w.y = pk2(v0[2], v0[3]); w.z = pk2(v1[0], v1[1]); w.w = pk2(v1[2], v1[3]);
                        __builtin_nontemporal_store(w, (u32x4*)(Z + zoff(row, col0 + bj * HALF))); } }
        } else {
            const int col0 = (u.pn - 32) * BM + wc * 32 + 8 * fq;
            f32x4 bv[2][2];
#pragma unroll
            for (int bj = 0; bj < 2; ++bj)
#pragma unroll
                for (int n = 0; n < 2; ++n) bv[bj][n] = *(const f32x4*)(bgate + col0 + bj * HALF + 4 * n);
#pragma unroll
            for (int ai = 0; ai < 2; ++ai)
#pragma unroll
                for (int m = 0; m < 4; ++m) { const int row = row0 + ai * HALF + m * 16; const float rs = rsv[ai][m];
#pragma unroll
                    for (int bj = 0; bj < 2; ++bj) { const f32x4 v0 = acc[ai][bj][m][0] * rs + (bv[bj][0] + (bj ? bq10 : bq00)), v1 = acc[ai][bj][m][1] * rs + (bv[bj][1] + (bj ? bq11 : bq01));
                        u32x2 w; w.x = gq8x4(sigm_f(v0[0]), sigm_f(v0[1]), sigm_f(v0[2]), sigm_f(v0[3])); w.y = gq8x4(sigm_f(v1[0]), sigm_f(v1[1]), sigm_f(v1[2]), sigm_f(v1[3]));
                        __builtin_nontemporal_store(w, (u32x2*)((unsigned char*)G + ((size_t)(u.pm * 32 + (u.pn - 32)) << 16) + ai * 32768 + (m * 2 + bj) * 4096 + (wr * 4 + wc) * 512 + (fq * 16 + fr) * 8)); } }
        }
    }
};
struct EpiMerge {
    static constexpr bool PERM = true;
    const bf16_t* G; bf16_t* Mg;
    __device__ __forceinline__ void fold_load(u32x2 (&gw)[4][2], const Unit& u, int n, int wr, int wc, int fr, int fq) const {
        const int row0 = u.pm * BM + u.pz * HALF + wr * 64 + fr, col0 = u.pn * BM + wc * 32 + 8 * fq;
#pragma unroll
        for (int m = 0; m < 4; ++m)
#pragma unroll
            for (int bj = 0; bj < 2; ++bj) gw[m][bj] = __builtin_nontemporal_load((const u32x2*)((const unsigned char*)G + ((size_t)(u.pm * 32 + n * 8 + u.pn) << 16) + u.pz * 32768 + (m * 2 + bj) * 4096 + (wr * 4 + wc) * 512 + (fq * 16 + fr) * 8));
    }
    __device__ __forceinline__ void fold_apply(f32x4 (&acc)[2][2][4][2], const u32x2 (&gw)[4][2], int n) const {
#pragma unroll
        for (int m = 0; m < 4; ++m)
#pragma unroll
            for (int bj = 0; bj < 2; ++bj) { const u32x2 g = gw[m][bj]; f32x4& v0 = acc[0][bj][m][0]; f32x4& v1 = acc[0][bj][m][1];
                const f32x4 g0 = (f32x4){(float)(g.x & 255u), (float)((g.x >> 8) & 255u), (float)((g.x >> 16) & 255u), (float)(g.x >> 24)} * (1.0f / 255.0f);
                const f32x4 g1 = (f32x4){(float)(g.y & 255u), (float)((g.y >> 8) & 255u), (float)((g.y >> 16) & 255u), (float)(g.y >> 24)} * (1.0f / 255.0f);
                if (n == 0) { acc[1][bj][m][0] = g0 * v0; acc[1][bj][m][1] = g1 * v1; }
                else { acc[1][bj][m][0] += g0 * v0; acc[1][bj][m][1] += g1 * v1; }
                v0 = (f32x4){0.f, 0.f, 0.f, 0.f}; v1 = (f32x4){0.f, 0.f, 0.f, 0.f}; }
    }
    __device__ __forceinline__ void fold(f32x4 (&acc)[2][2][4][2], const Unit& u, int n, int wr, int wc, int fr, int fq) const { u32x2 gw[4][2]; fold_load(gw, u, n, wr, wc, fr, fq); fold_apply(acc, gw, n); }
    __device__ __forceinline__ void operator()(const f32x4 (&acc)[2][2][4][2], const Unit& u, int wr, int wc, int fr, int fq) const {
        const int row0 = u.pm * BM + u.pz * HALF + wr * 64 + fr, col0 = u.pn * BM + wc * 32 + 8 * fq;
#pragma unroll
        for (int m = 0; m < 4; ++m)
#pragma unroll
            for (int bj = 0; bj < 2; ++bj) { const f32x4 v0 = acc[1][bj][m][0], v1 = acc[1][bj][m][1];
                u32x4 w; w.x = pk2(v0[0], v0[1]); w.y = pk2(v0[2], v0[3]); w.z = pk2(v1[0], v1[1]); w.w = pk2(v1[2], v1[3]);
                __builtin_nontemporal_store(w, (u32x4*)((char*)Mg + atile_off(row0 + m * 16, col0 + bj * HALF, DM / 64))); }
    }
};
}

#define XB_TMO      128
#define XB_XCNT(j)  (256  + 64 * (j))
#define XB_XSUB(j)  (1280 + 64 * (j))
#define XB_XGEN(j)  (2304 + 64 * (j))
#define XB_TOP      3328
#define XB_TOPGEN   3392
#define XCD_BAR_WORDS 3456
#define XB_SPIN_CAP (1u << 24)
__device__ __forceinline__ unsigned xb_ld(unsigned* p)              { return __hip_atomic_load(p, __ATOMIC_RELAXED, __HIP_MEMORY_SCOPE_AGENT); }
__device__ __forceinline__ unsigned xb_add(unsigned* p, unsigned v) { return __hip_atomic_fetch_add(p, v, __ATOMIC_RELAXED, __HIP_MEMORY_SCOPE_AGENT); }
__device__ __forceinline__ unsigned xb_xcc_id() { return (unsigned)__builtin_amdgcn_s_getreg((3 << 11) | 20) & 0xFu; }
#define XB_SPIN(cond, bar) do { unsigned _sp = 0; while (cond) { __builtin_amdgcn_s_sleep(1); \
    if ((++_sp & 255u) == 0u) { if (xb_ld(&(bar)[XB_TMO])) break; if (_sp > XB_SPIN_CAP) { atomicAdd(&(bar)[XB_TMO], 1u); break; } } } } while (0)
struct XcdBarrier { unsigned* bar; unsigned x; volatile LAS unsigned* st; int wv; };
__device__ __forceinline__ XcdBarrier xcd_barrier_post(unsigned* bar, volatile LAS unsigned* st, int wv) {
    XcdBarrier b; b.bar = bar; b.x = xb_xcc_id(); b.st = st; b.wv = wv;
    if (opaque_tid(wv) == 0) (void)xb_add(&bar[XB_XCNT(b.x)], 1u);
    return b;
}
__device__ __forceinline__ void xcd_barrier_complete(unsigned* bar, unsigned x, unsigned& nloc, unsigned& nx) {
    const unsigned G = gridDim.x * gridDim.y * gridDim.z;
    unsigned sum, cnt, mine, sp = 0u;
    for (;;) {
        sum = 0u; cnt = 0u; mine = 0u;
#pragma unroll
        for (unsigned j = 0; j < 16; ++j) { const unsigned c = xb_ld(&bar[XB_XCNT(j)]); sum += c; cnt += (c > 0u) ? 1u : 0u; mine = (j == x) ? c : mine; }
        if (sum == G) break;
        __builtin_amdgcn_s_sleep(1);
        if ((++sp & 255u) == 0u) { if (xb_ld(&bar[XB_TMO])) break; if (sp > XB_SPIN_CAP) { atomicAdd(&bar[XB_TMO], 1u); break; } }
    }
    nloc = mine > 0u ? mine : 1u; nx = cnt > 0u ? cnt : 1u;
}
__device__ __forceinline__ void xcd_barrier(const XcdBarrier& b) {
    asm volatile("s_waitcnt vmcnt(0)" ::: "memory");
    __syncthreads();
    if (opaque_tid(b.wv) == 0) {
        unsigned* bar = b.bar;
        __builtin_amdgcn_s_waitcnt(0);
        unsigned nloc = b.st[0], nx = b.st[1];
        if (nloc == 0u) { xcd_barrier_complete(bar, b.x, nloc, nx); b.st[0] = nloc; b.st[1] = nx; }
        const unsigned old = xb_add(&bar[XB_XSUB(b.x)], 1u);
        const unsigned gen = old / nloc;
        if (old + 1u == (gen + 1u) * nloc) {
            __builtin_amdgcn_fence(__ATOMIC_RELEASE, "agent");
            asm volatile("s_waitcnt vmcnt(0)" ::: "memory");
            const unsigned og = xb_add(&bar[XB_TOP], 1u);
            const unsigned tg = og / nx;
            if (og + 1u == (tg + 1u) * nx) xb_add(&bar[XB_TOPGEN], 1u);
            else XB_SPIN(xb_ld(&bar[XB_TOPGEN]) == tg, bar);
            __builtin_amdgcn_fence(__ATOMIC_ACQUIRE, "agent");
            xb_add(&bar[XB_XGEN(b.x)], 1u);
            asm volatile("s_waitcnt vmcnt(0)" ::: "memory");
        } else {
            XB_SPIN(xb_ld(&bar[XB_XGEN(b.x)]) == gen, bar);
            __builtin_amdgcn_fence(__ATOMIC_ACQUIRE, "agent");
            asm volatile("s_waitcnt vmcnt(0)" ::: "memory");
        }
    }
    __syncthreads();
}

struct Args { const float* in[24]; float* out; unsigned char* ws; int ph_lo, ph_hi, li, pad; };
typedef const __attribute__((address_space(4))) Args KArgs;
__device__ __forceinline__ KArgs* kargs() { KArgs* p = (KArgs*)__builtin_amdgcn_kernarg_segment_ptr(); asm volatile("" : "+s"(p)); return p; }
enum { I_XP = 0, I_XS, I_CP, I_CS, I_WADA, I_BADA, I_GFF1, I_WFF1I, I_WFF1O, I_GMIX, I_WIN, I_BGATE, I_RELB, I_LQ1, I_LK1, I_LQ2, I_LK2, I_DLNG, I_WBR, I_WOUT, I_GFF2, I_WFF2I, I_WFF2O, I_GFIN };

__device__ __forceinline__ int srcmap(int kind, int v) {
    if (kind == 1) return ((v >> 7) & 1) * DFF + (v >> 8) * 128 + (v & 127);
    if (kind == 2) { const int o = v; const bool rp = (o >= 2048 && o < 3072) || (o >= 3584 && o < 6656);
        if (rp && (o & 63) < 16) { const int d = o & 15; const int pd = (d & 3) | ((d & 4) << 1) | ((d & 8) >> 1); return (o & ~15) + pd; }
        return o; }
    return v;
}
__device__ __forceinline__ void conv_tile(const float* src, int ldsrc, bf16_t* dst, int K, int v0, int k0, int kind, LAS float* tile, int tid) {
    __syncthreads();
#pragma unroll
    for (int i = 0; i < 8; ++i) { const int idx = tid + 512 * i, kk = idx >> 6, vv = idx & 63;
        tile[vv * 65 + kk] = src[(size_t)(k0 + kk) * ldsrc + srcmap(kind, v0 + vv)]; }
    __syncthreads();
    const int vv = tid >> 3, kc = tid & 7; const LAS float* s = tile + vv * 65 + kc * 8;
    u32x4 o; o.x = pk2(s[0], s[1]); o.y = pk2(s[2], s[3]); o.z = pk2(s[4], s[5]); o.w = pk2(s[6], s[7]);
    *(u32x4*)((char*)dst + pg8::wtile_off(v0 + vv, k0 + kc * 8, K >> 6)) = o;
}
__device__ __forceinline__ void fold_tile(const float* win_l, bf16_t* dst, int v0, int k0, LAS float* S  , LAS float* tc, LAS float* tsn, int tid) {
    __syncthreads();
    if (tid < 128) { const float x = (float)tid * (1.0f / 128.0f); tc[tid] = __builtin_amdgcn_cosf(x) * 0.08838834764831843f; tsn[tid] = __builtin_amdgcn_sinf(x) * 0.08838834764831843f; }
    const int g = v0 >> 8, isq = (v0 >> 7) & 1, cp0 = v0 & 127;
#pragma unroll
    for (int i = 0; i < 16; ++i) { const int idx = tid + 512 * i, kk = idx >> 7, c = idx & 127;
        S[kk * 129 + c] = win_l[(size_t)(k0 + kk) * 16384 + g * 128 + c]; }
    __syncthreads();
    const int vv = tid >> 3, kc = tid & 7, cp = cp0 + vv; const LAS float* tr = isq ? tsn : tc;
    float o[8] = {0.f, 0.f, 0.f, 0.f, 0.f, 0.f, 0.f, 0.f};
    for (int c = 0; c < 128; ++c) { const float w = tr[(c * cp) & 127];
#pragma unroll
        for (int j = 0; j < 8; ++j) o[j] += S[(kc * 8 + j) * 129 + c] * w; }
    u32x4 ov; ov.x = pk2(o[0], o[1]); ov.y = pk2(o[2], o[3]); ov.z = pk2(o[4], o[5]); ov.w = pk2(o[6], o[7]);
    *(u32x4*)(dst + (size_t)(v0 + vv) * DM + k0 + kc * 8) = ov;
}
__device__ __forceinline__ bf16_t fftm_bf1(float x) { return (bf16_t)(pk2(x, 0.f) & 0xffffu); }
__constant__ double ROPE_INV[8] = {1.0, 0.19392274474868576, 0.03760603093086393, 0.007292664737217109, 0.001414213562373095, 0.0002742481756762073, 5.318295896944988e-05, 1.031338537721246e-05};

__device__ __forceinline__ void ada_task(KArgs& a, int l, int jb, float* mod, LAS float* sc  , LAS float* red  , int tid) {
    __syncthreads();
#pragma unroll 1
    for (int i0 = 0; i0 < 6 * DM; i0 += 8 * 512) {
        float cv[8];
#pragma unroll
        for (int j = 0; j < 8; ++j) { const int i = i0 + j * 512 + tid, br = i >> 11, k = i & 2047; cv[j] = br < 2 ? a.in[I_CP][br * DM + k] : a.in[I_CS][(br - 2) * DM + k]; }
#pragma unroll
        for (int j = 0; j < 8; ++j) sc[i0 + j * 512 + tid] = cv[j] * pg8::sigm_f(cv[j]); }
    __syncthreads();
    const int jq = tid & 7, kp = tid >> 3, j0 = jb * 32;
    const float* w = a.in[I_WADA] + ((size_t)l * DM + kp * 32) * NMODC + j0 + 4 * jq;
    f32x4 acc[6];
#pragma unroll
    for (int br = 0; br < 6; ++br) acc[br] = (f32x4){0.f, 0.f, 0.f, 0.f};
    for (int k = 0; k < 32; ++k) { const f32x4 wv = *(const f32x4*)(w + (size_t)k * NMODC);
#pragma unroll
        for (int br = 0; br < 6; ++br) acc[br] += wv * sc[br * DM + kp * 32 + k]; }
#pragma unroll
    for (int br = 0; br < 6; ++br) *(LAS f32x4*)(red + (kp * 6 + br) * 32 + 4 * jq) = acc[br];
    __syncthreads();
    if (tid < 192) { const int br = tid >> 5, j = tid & 31; float s = a.in[I_BADA][(size_t)l * NMODC + j0 + j];
        for (int k = 0; k < 64; ++k) s += red[(k * 6 + br) * 32 + j];
        mod[((size_t)l * 6 + br) * NMODC + j0 + j] = s; }
}

constexpr int NT_ADA = 2 * 576, NT_FOLD = 0, NT_FFI = 5504, NT_FFO = 2752, NT_IN = 8192, NT_BR = 1024, NT_OUT = 1024;
constexpr int NT_LAYER = 2 * NT_FFI + 2 * NT_FFO + NT_IN + NT_BR + NT_OUT;
constexpr int NT_ROPE = 256, NT_DFT = 40, NT_ZSS = 192, NT_LAM = 1;
constexpr int NT_PRO = NT_ADA + NT_FOLD + 2 * NT_LAYER + NT_ROPE + NT_DFT + NT_ZSS + NT_LAM;

__device__ __forceinline__ void prologue_phase(KArgs& a, LAS unsigned char* lds, int wg, int nwg, int tid) {
    unsigned char* ws = a.ws;
    float* mod = (float*)(ws + WS_MOD);
    LAS float* L = (LAS float*)lds;
    for (int t = wg; t < NT_PRO; t += nwg) {
        int r = t;
        if (r < NT_ADA) { ada_task(a, r / 576, r % 576, mod, L, L + 6 * DM, tid); continue; } r -= NT_ADA;
        if (r < NT_FOLD) { const int l = r >> 9, q = r & 511; fold_tile(a.in[I_WIN] + (size_t)l * DM * 16384, (bf16_t*)(ws + WS_W + l * WLAYER + WO_IN), (q >> 5) * 64, (q & 31) * 64, L, L + 64 * 129, L + 64 * 129 + 128, tid); continue; } r -= NT_FOLD;
        if (r < 2 * NT_LAYER) { const int l = r / NT_LAYER; int q = r % NT_LAYER; unsigned char* wl = ws + WS_W + l * WLAYER;
            if (q < NT_FFI) { conv_tile(a.in[I_WFF1I] + (size_t)l * DM * 11008, 11008, (bf16_t*)(wl + WO_FF1I), DM, (q >> 5) * 64, (q & 31) * 64, 1, L, tid); continue; } q -= NT_FFI;
            if (q < NT_FFI) { conv_tile(a.in[I_WFF2I] + (size_t)l * DM * 11008, 11008, (bf16_t*)(wl + WO_FF2I), DM, (q >> 5) * 64, (q & 31) * 64, 1, L, tid); continue; } q -= NT_FFI;
            if (q < NT_FFO) { conv_tile(a.in[I_WFF1O] + (size_t)l * DFF * DM, DM, (bf16_t*)(wl + WO_FF1O), DFF, (q / 86) * 64, (q % 86) * 64, 0, L, tid); continue; } q -= NT_FFO;
            if (q < NT_FFO) { conv_tile(a.in[I_WFF2O] + (size_t)l * DFF * DM, DM, (bf16_t*)(wl + WO_FF2O), DFF, (q / 86) * 64, (q % 86) * 64, 0, L, tid); continue; } q -= NT_FFO;
            if (q < NT_IN) { conv_tile(a.in[I_WIN] + (size_t)l * DM * 16384, 16384, (bf16_t*)(wl + WO_IN), DM, (q >> 5) * 64, (q & 31) * 64, 2, L, tid); continue; } q -= NT_IN;
            if (q < NT_BR) { const int n = q >> 8, tt = q & 255; conv_tile(a.in[I_WBR] + (size_t)l * 4 * 512 * DM, DM, (bf16_t*)(wl + WO_BR), DM, (tt >> 3) * 64, n * 512 + (tt & 7) * 64, 0, L, tid); continue; } q -= NT_BR;
            conv_tile(a.in[I_WOUT] + (size_t)l * DM * DM, DM, (bf16_t*)(wl + WO_OUT), DM, (q >> 5) * 64, (q & 31) * 64, 0, L, tid); continue; }
        r -= 2 * NT_LAYER;
        if (r < NT_ROPE) { const int idx = r * 512 + tid, pos = idx >> 3, i = idx & 7; double rev = (double)pos * ROPE_INV[i] * 0.15915494309189535; rev -= floor(rev); const float fr = (float)rev;
            float* rp = (float*)(ws + WS_ROPE) + (size_t)idx * 2; rp[0] = __builtin_amdgcn_cosf(fr); rp[1] = __builtin_amdgcn_sinf(fr); continue; } r -= NT_ROPE;
        if (r < NT_DFT) {
            const bool big = r < 32; const int N = big ? 128 : 64, m = (big ? r : r - 32) * 512 + tid, k = m / N, t = m % N;
            const float x = (float)((k * t) & (N - 1)) / (float)N; const float c = __builtin_amdgcn_cosf(x), sn = __builtin_amdgcn_sinf(x);
            bf16_t* dp = (bf16_t*)(ws + WS_DFT + (big ? 0 : 98304)); dp[m] = fftm_bf1(c); dp[N * N + m] = fftm_bf1(sn); dp[2 * N * N + m] = fftm_bf1(-sn); continue; }
        r -= NT_DFT;
        if (r < NT_ZSS) { ((f32x4*)(ws + WS_SS))[r * 512 + tid] = (f32x4){0.f, 0.f, 0.f, 0.f}; continue; }
        if (tid < 2) { const int l = tid; float s1 = 0.f, s2 = 0.f;
            for (int k = 0; k < 64; ++k) { s1 += a.in[I_LQ1][l * 64 + k] * a.in[I_LK1][l * 64 + k]; s2 += a.in[I_LQ2][l * 64 + k] * a.in[I_LK2][l * 64 + k]; }
            const float li = l == 0 ? 0.2f : 0.35550906759096934f;
            ((float*)(ws + WS_LAM))[l] = __expf(s1) - __expf(s2) + li; }
    }
}

constexpr int NT_AT = 144, NT_BWT = 1200, NT_PRO2 = NT_AT + NT_BWT;
__device__ __forceinline__ void prologue2_phase(KArgs& a, LAS unsigned char* lds, int wg, int nwg, int tid) {
    unsigned char* ws = a.ws; const float* mod = (const float*)(ws + WS_MOD);
    LAS float* sh = (LAS float*)lds;
    const int lane = tid & 63, wid = tid >> 6;
    for (int t = wg; t < NT_PRO2; t += nwg) {
        if (t < NT_AT) { const int idx = t * 512 + tid, inst = idx / 12288, rem = idx % 12288, br = rem >> 11, col = rem & 2047, l = inst / 3, sl = inst % 3;
            const float g = a.in[sl == 0 ? I_GFF1 : (sl == 1 ? I_GMIX : I_GFF2)][l * DM + col];
            ((float*)(ws + WS_AT))[idx] = g * (1.0f + mod[((size_t)l * 6 + br) * NMODC + (3 * sl + 1) * DM + col]); continue; }
        const int R0 = (t - NT_AT) * 64, l = R0 / BWL, rr = R0 % BWL, sl = rr < 11008 ? 0 : (rr < 27392 ? 1 : 2), v0 = rr - (sl == 0 ? 0 : (sl == 1 ? 11008 : 27392));
        __syncthreads();
#pragma unroll 1
        for (int i0 = 0; i0 < 6 * DM; i0 += 8 * 512) {
            float mv[8];
#pragma unroll
            for (int j = 0; j < 8; ++j) { const int i = i0 + j * 512 + tid, br = i >> 11, k = i & 2047; mv[j] = mod[((size_t)l * 6 + br) * NMODC + 3 * sl * DM + k]; }
#pragma unroll
            for (int j = 0; j < 8; ++j) { const int i = i0 + j * 512 + tid, br = i >> 11, k = i & 2047; sh[(br * 8 + (k >> 8)) * 260 + (k & 255)] = mv[j]; } }
        __syncthreads();
        const bf16_t* W = (const bf16_t*)(ws + WS_W + (size_t)l * WLAYER + (sl == 0 ? WO_FF1I : (sl == 1 ? WO_IN : WO_FF2I)));
        const int v = v0 + wid * 8 + (lane >> 3), kq = lane & 7;
        float acc[6] = {0.f, 0.f, 0.f, 0.f, 0.f, 0.f};
        for (int i = 0; i < 32; ++i) { const u32x4 wv = *(const u32x4*)((const char*)W + pg8::wtile_off(v, kq * 256 + i * 8, DM / 64));
            const float w8[8] = {bf_lo(wv.x), bf_hi(wv.x), bf_lo(wv.y), bf_hi(wv.y), bf_lo(wv.z), bf_hi(wv.z), bf_lo(wv.w), bf_hi(wv.w)};
#pragma unroll
            for (int br = 0; br < 6; ++br) { const LAS float* sp = sh + (br * 8 + kq) * 260 + i * 8; const f32x4 s0 = *(const LAS f32x4*)sp, s1 = *(const LAS f32x4*)(sp + 4);
                acc[br] += (w8[0] * s0[0] + w8[1] * s0[1]) + (w8[2] * s0[2] + w8[3] * s0[3]) + (w8[4] * s1[0] + w8[5] * s1[1]) + (w8[6] * s1[2] + w8[7] * s1[3]); } }
#pragma unroll
        for (int br = 0; br < 6; ++br) { float x = acc[br];
            x += __uint_as_float((unsigned)__builtin_amdgcn_ds_swizzle((int)__float_as_uint(x), (1 << 10) | 0x1f));
            x += __uint_as_float((unsigned)__builtin_amdgcn_ds_swizzle((int)__float_as_uint(x), (2 << 10) | 0x1f));
            x += __uint_as_float((unsigned)__builtin_amdgcn_ds_swizzle((int)__float_as_uint(x), (4 << 10) | 0x1f));
            if (kq == 0) ((float*)(ws + WS_BW))[((size_t)l * 6 + br) * BWL + rr + wid * 8 + (lane >> 3)] = x; }
    }
}
__device__ __forceinline__ void norm_first_phase(KArgs& a, int wg, int nwg, int wave, int lane) {
    bf16_t* XA = (bf16_t*)(a.ws + WS_H); float* ss0 = (float*)(a.ws + WS_SS); const float* at = (const float*)(a.ws + WS_AT);
    const int stride = nwg * 8; int row = wg * 8 + wave; if (row >= NTOK) return;
    f32x4 v[8], vn[8], av[8]; int brc = -1;
    { const float* x = row < 32768 ? a.in[I_XP] + (size_t)row * DM : a.in[I_XS] + (size_t)(row - 32768) * DM;
#pragma unroll
      for (int i = 0; i < 8; ++i) v[i] = *(const f32x4*)(x + (i * 64 + lane) * 4); }
    for (; row < NTOK; row += stride) {
        const int rn = row + stride; const int br = brow_of(row);
        if (rn < NTOK) { const float* xn = rn < 32768 ? a.in[I_XP] + (size_t)rn * DM : a.in[I_XS] + (size_t)(rn - 32768) * DM;
#pragma unroll
            for (int i = 0; i < 8; ++i) vn[i] = *(const f32x4*)(xn + (i * 64 + lane) * 4); }
        if (br != brc) { brc = br;
#pragma unroll
            for (int i = 0; i < 8; ++i) av[i] = *(const f32x4*)(at + (size_t)br * DM + (i * 64 + lane) * 4); }
        float ss = 0.f;
#pragma unroll
        for (int i = 0; i < 8; ++i) ss += (v[i][0] * v[i][0] + v[i][1] * v[i][1]) + (v[i][2] * v[i][2] + v[i][3] * v[i][3]);
        ss = wave_sum(ss); if (lane == 0) ss0[row] = ss;
#pragma unroll
        for (int i = 0; i < 8; ++i) { const int col = (i * 64 + lane) * 4; const f32x4 o = v[i] * av[i]; u32x2 w; w.x = pk2(o[0], o[1]); w.y = pk2(o[2], o[3]);
            *(u32x2*)(XA + (size_t)row * DM + col) = w; }
#pragma unroll
        for (int i = 0; i < 8; ++i) v[i] = vn[i];
    }
}
__device__ __forceinline__ void final_phase(KArgs& a, int wg, int nwg, int wave, int lane) {
    const float* gw = a.in[I_GFIN];
    const int stride = nwg * 8; int row = wg * 8 + wave; if (row >= NTOK) return;
    f32x4 v[8], vn[8], gv[8];
#pragma unroll
    for (int i = 0; i < 8; ++i) { gv[i] = *(const f32x4*)(gw + (i * 64 + lane) * 4); v[i] = *(const f32x4*)(a.out + (size_t)row * DM + (i * 64 + lane) * 4); }
    for (; row < NTOK; row += stride) {
        const int rn = row + stride; float* x = a.out + (size_t)row * DM;
        if (rn < NTOK) {
#pragma unroll
            for (int i = 0; i < 8; ++i) vn[i] = *(const f32x4*)(a.out + (size_t)rn * DM + (i * 64 + lane) * 4); }
        float ss = 0.f;
#pragma unroll
        for (int i = 0; i < 8; ++i) ss += (v[i][0] * v[i][0] + v[i][1] * v[i][1]) + (v[i][2] * v[i][2] + v[i][3] * v[i][3]);
        ss = wave_sum(ss); const float rstd = __builtin_amdgcn_rsqf(ss * (1.0f / DM) + EPS);
#pragma unroll
        for (int i = 0; i < 8; ++i) { const int col = (i * 64 + lane) * 4; *(f32x4*)(x + col) = v[i] * rstd * gv[i]; }
#pragma unroll
        for (int i = 0; i < 8; ++i) v[i] = vn[i];
    }
}

namespace dattn {
constexpr int KP = 144, VP = 320, KT = 64 * KP, VT = 64 * VP;
constexpr int KS0 = 0, KS1 = KT, VS0 = 2 * KT, VS1 = 2 * KT + VT;
#define DBAR() asm volatile("s_waitcnt lgkmcnt(0)\n\ts_barrier" ::: "memory")
__device__ __forceinline__ bf16x8 trA(LAS unsigned char* p) {
    const s16x4 lo = __builtin_amdgcn_ds_read_tr16_b64_v4i16((LAS s16x4*)p), hi = __builtin_amdgcn_ds_read_tr16_b64_v4i16((LAS s16x4*)(p + 8 * VP));
    return (bf16x8){lo[0], lo[1], lo[2], lo[3], hi[0], hi[1], hi[2], hi[3]};
}
__device__ __forceinline__ void qk(f32x16& p0, f32x16& p1, LAS unsigned char* ks, const bf16x8 (&qf)[4], int r32, int hi) {
    p0 = (f32x16){0.f, 0.f, 0.f, 0.f, 0.f, 0.f, 0.f, 0.f, 0.f, 0.f, 0.f, 0.f, 0.f, 0.f, 0.f, 0.f}; p1 = p0;
#pragma unroll
    for (int s = 0; s < 4; ++s) { const bf16x8 k0f = *(const LAS bf16x8*)(ks + r32 * KP + (16 * s + 8 * hi) * 2), k1f = *(const LAS bf16x8*)(ks + (32 + r32) * KP + (16 * s + 8 * hi) * 2);
        p0 = __builtin_amdgcn_mfma_f32_32x32x16_bf16(k0f, qf[s], p0, 0, 0, 0); p1 = __builtin_amdgcn_mfma_f32_32x32x16_bf16(k1f, qf[s], p1, 0, 0, 0); }
}
__device__ __forceinline__ float softmax(f32x16& p0, f32x16& p1, float& m, float& l, bf16x8 (&pb)[4]) {
    float mx = fmaxf(p0[0], p1[0]);
#pragma unroll
    for (int r = 1; r < 16; ++r) mx = fmaxf(mx, fmaxf(p0[r], p1[r]));
    mx = swap_max(mx);
    const float mn = fmaxf(m, mx * C2), alpha = __builtin_amdgcn_exp2f(m - mn); m = mn;
    float ps = 0.f;
#pragma unroll
    for (int r = 0; r < 16; ++r) { p0[r] = __builtin_amdgcn_exp2f(fmaf(p0[r], C2, -mn)); p1[r] = __builtin_amdgcn_exp2f(fmaf(p1[r], C2, -mn)); ps += p0[r] + p1[r]; }
    ps = swap_sum(ps); l = l * alpha + ps;
#pragma unroll
    for (int ks = 0; ks < 4; ++ks) { u32x4 w;
        if (ks < 2) { w.x = pk2(p0[8 * (ks & 1) + 0], p0[8 * (ks & 1) + 1]); w.y = pk2(p0[8 * (ks & 1) + 2], p0[8 * (ks & 1) + 3]); w.z = pk2(p0[8 * (ks & 1) + 4], p0[8 * (ks & 1) + 5]); w.w = pk2(p0[8 * (ks & 1) + 6], p0[8 * (ks & 1) + 7]); }
        else        { w.x = pk2(p1[8 * (ks & 1) + 0], p1[8 * (ks & 1) + 1]); w.y = pk2(p1[8 * (ks & 1) + 2], p1[8 * (ks & 1) + 3]); w.z = pk2(p1[8 * (ks & 1) + 4], p1[8 * (ks & 1) + 5]); w.w = pk2(p1[8 * (ks & 1) + 6], p1[8 * (ks & 1) + 7]); }
        pb[ks] = __builtin_bit_cast(bf16x8, w); }
    return alpha;
}
__device__ __forceinline__ void pv(f32x16 (&o)[4], LAS unsigned char* vs, int vbase, const bf16x8 (&pb)[4]) {
#pragma unroll
    for (int ks = 0; ks < 4; ++ks)
#pragma unroll
        for (int db = 0; db < 4; ++db) { const bf16x8 va = trA(vs + vbase + ks * 16 * VP + db * 64); o[db] = __builtin_amdgcn_mfma_f32_32x32x16_bf16(va, pb[ks], o[db], 0, 0, 0); }
}
template <int MODE>
__device__ __forceinline__ void unit(const bf16_t* Zs, int T, int h, int qb, const float* lamp, int layer, const float* lng, bf16_t* Ys, u32x4* oscr, LAS unsigned char* lds, const int wv) {
    const int tid = opaque_tid(wv), lane = tid & 63, wid = __builtin_amdgcn_readfirstlane(tid >> 6), r32 = lane & 31, hi = lane >> 5;
    const int qrow = qb * 256 + wid * 32 + r32, NT = T >> 6;
    const int ksr = tid >> 3, ksc = tid & 7, vr0 = tid >> 4, vc0 = tid & 15;
    const int vbase = (4 * hi + ((lane >> 2) & 3)) * VP + (16 * ((lane >> 4) & 1) + 4 * (lane & 3)) * 2;
    const int kw = ksr * KP + ksc * 16, vw = vr0 * VP + vc0 * 16;
#pragma unroll
    for (int c = 0; c < 2; ++c) {
        const bf16_t* Qp = Zs + zoff(qrow, 2048 + h * 128 + c * 64) + hi * 8;
        bf16x8 qf[4];
#pragma unroll
        for (int s = 0; s < 4; ++s) qf[s] = *(const bf16x8*)(Qp + 16 * s);
        LAS unsigned char* const qlds = lds + 59392 + wid * 4096 + lane * 16;
        const bf16_t* Kg = Zs + zoff(ksr, 2560 + h * 128 + c * 64) + ksc * 8;
        const bf16_t* Vg = Zs + zoff(vr0, 3072 + h * 128 + vc0 * 8);
        f32x16 o[4];
#pragma unroll
        for (int d = 0; d < 4; ++d) o[d] = (f32x16){0.f, 0.f, 0.f, 0.f, 0.f, 0.f, 0.f, 0.f, 0.f, 0.f, 0.f, 0.f, 0.f, 0.f, 0.f, 0.f};
        float m = -1e30f, l = 0.f;
        __syncthreads();
#pragma unroll
        for (int s = 0; s < 4; ++s) *(LAS bf16x8*)(qlds + s * 1024) = qf[s];
        { const bf16x8 k0 = *(const bf16x8*)Kg, k1 = *(const bf16x8*)(Kg + (size_t)64 * ZR), v0 = *(const bf16x8*)Vg, v1 = *(const bf16x8*)(Vg + (size_t)32 * ZR);
          *(LAS bf16x8*)(lds + KS0 + kw) = k0; *(LAS bf16x8*)(lds + KS1 + kw) = k1; *(LAS bf16x8*)(lds + VS0 + vw) = v0; *(LAS bf16x8*)(lds + VS0 + vw + 32 * VP) = v1; }
        __syncthreads();
        constexpr float THR = 8.0f;
        f32x16 pA0, pA1, pB0, pB1, negm; u32x4 pbA[4], pbB[4]; float mref = 0.f;
        negm = (f32x16){0.f, 0.f, 0.f, 0.f, 0.f, 0.f, 0.f, 0.f, 0.f, 0.f, 0.f, 0.f, 0.f, 0.f, 0.f, 0.f};
        qk(pA0, pA1, lds + KS0, qf, r32, hi);
        __syncthreads();
#define KFRAG(SL, G) (*(const LAS bf16x8*)((SL) + ((((G) & 1) ? 32 : 0) + r32) * KP + (16 * ((G) >> 1) + 8 * hi) * 2))
#define MX3(a, b, c) __builtin_fmaxf(__builtin_fmaxf((a), (b)), (c))
#define DSTEP(C0, C1, N0, N1, PBR, PBW, J) do { const int j_ = (J); const int jk_ = (j_ + 2 < NT) ? j_ + 2 : NT - 1; \
            LAS unsigned char* ksl_ = lds + (((j_ + 1) & 1) ? KS1 : KS0); LAS unsigned char* vsl_ = lds + (((j_ - 1) & 1) ? VS1 : VS0) + vbase; \
            bf16x8 kf_[8], va_[16], qs_[4]; float ps_ = 0.f; \
            const bf16x8 kreg_ = *(const bf16x8*)(Kg + (size_t)jk_ * 64 * ZR);        \
            const bf16x8 v0_ = *(const bf16x8*)(Vg + (size_t)j_ * 64 * ZR), v1_ = *(const bf16x8*)(Vg + (size_t)j_ * 64 * ZR + (size_t)32 * ZR); \
            kf_[0] = KFRAG(ksl_, 0); kf_[1] = KFRAG(ksl_, 1); qs_[0] = *(const LAS bf16x8*)(qlds); \
            __builtin_amdgcn_sched_barrier(0); \
            _Pragma("unroll") for (int g_ = 0; g_ < 8; ++g_) { \
                if (g_ + 2 < 8) kf_[g_ + 2] = KFRAG(ksl_, g_ + 2); \
                if (!(g_ & 1) && g_ + 2 < 8) qs_[(g_ >> 1) + 1] = *(const LAS bf16x8*)(qlds + ((g_ >> 1) + 1) * 1024); \
                if (g_ >= 6) va_[g_ - 6] = trA(vsl_ + (g_ - 6) * 64); \
                if (g_ == 0) N0 = __builtin_amdgcn_mfma_f32_32x32x16_bf16(kf_[0], qs_[0], negm, 0, 0, 0); else if (g_ == 1) N1 = __builtin_amdgcn_mfma_f32_32x32x16_bf16(kf_[1], qs_[0], negm, 0, 0, 0); \
                else if (g_ & 1) N1 = __builtin_amdgcn_mfma_f32_32x32x16_bf16(kf_[g_], qs_[g_ >> 1], N1, 0, 0, 0); else N0 = __builtin_amdgcn_mfma_f32_32x32x16_bf16(kf_[g_], qs_[g_ >> 1], N0, 0, 0, 0); \
                { const float e0_ = __builtin_amdgcn_exp2f(C0[2 * g_]), e1_ = __builtin_amdgcn_exp2f(C0[2 * g_ + 1]); ps_ += e0_; ps_ += e1_; PBW[g_ >> 2][g_ & 3] = pk2(e0_, e1_); } \
                __builtin_amdgcn_sched_barrier(0); } \
            float tn_ = -1e30f, ep_ = 0.f; \
            __builtin_amdgcn_sched_barrier(0); \
            _Pragma("unroll") for (int i_ = 0; i_ < 16; ++i_) { \
                if (i_ + 2 < 16) va_[i_ + 2] = trA(vsl_ + ((i_ + 2) >> 2) * 16 * VP + ((i_ + 2) & 3) * 64); \
                o[i_ & 3] = __builtin_amdgcn_mfma_f32_32x32x16_bf16(va_[i_], __builtin_bit_cast(bf16x8, PBR[i_ >> 2]), o[i_ & 3], 0, 0, 0); \
                { const float e_ = __builtin_amdgcn_exp2f(C1[i_]); ps_ += e_; if (i_ & 1) PBW[2 + (i_ >> 3)][(i_ >> 1) & 3] = pk2(ep_, e_); else ep_ = e_; } \
                tn_ = MX3(tn_, N0[i_], N1[i_]); asm volatile("" : "+v"(tn_)); \
                __builtin_amdgcn_sched_barrier(0); } \
            asm volatile("" : "+v"(PBW[0]), "+v"(PBW[1]), "+v"(PBW[2]), "+v"(PBW[3])); \
            ps_ = swap_sum(ps_); l += ps_; \
            if (__any(fcarry < 1.0f)) { _Pragma("unroll") for (int d = 0; d < 4; ++d) o[d] *= fcarry; } \
            fcarry = 1.0f; \
            { const float mx_ = swap_max(tn_); \
              if ((j_ + 1 < NT) && __any(mx_ > THR)) { const float d_ = fmaxf(mx_, 0.f); fcarry = __builtin_amdgcn_exp2f(-d_); mref += d_; l *= fcarry; \
                  _Pragma("unroll") for (int r = 0; r < 16; ++r) { N0[r] -= d_; N1[r] -= d_; negm[r] = -mref; } } } \
            *(LAS bf16x8*)(lds + ((j_ & 1) ? KS1 : KS0) + kw) = kreg_; \
            *(LAS bf16x8*)(lds + ((j_ & 1) ? VS1 : VS0) + vw) = v0_; *(LAS bf16x8*)(lds + ((j_ & 1) ? VS1 : VS0) + vw + 32 * VP) = v1_; \
            DBAR(); } while (0)
        float fcarry = 1.0f;
        {
            const bf16x8 kreg_ = *(const bf16x8*)(Kg + (size_t)(2 < NT ? 2 : NT - 1) * 64 * ZR);
            float mx = fmaxf(pA0[0], pA1[0]);
#pragma unroll
            for (int r = 1; r < 16; ++r) mx = fmaxf(mx, fmaxf(pA0[r], pA1[r]));
            mx = swap_max(mx); mref = mx;
#pragma unroll
            for (int r = 0; r < 16; ++r) negm[r] = -mref;
            float ps = 0.f;
#pragma unroll
            for (int r = 0; r < 16; ++r) { pA0[r] = __builtin_amdgcn_exp2f(pA0[r] - mx); pA1[r] = __builtin_amdgcn_exp2f(pA1[r] - mx); ps += pA0[r] + pA1[r]; }
            l = swap_sum(ps);
#pragma unroll
            for (int ks = 0; ks < 4; ++ks) { u32x4 w;
                if (ks < 2) { w.x = pk2(pA0[8 * (ks & 1) + 0], pA0[8 * (ks & 1) + 1]); w.y = pk2(pA0[8 * (ks & 1) + 2], pA0[8 * (ks & 1) + 3]); w.z = pk2(pA0[8 * (ks & 1) + 4], pA0[8 * (ks & 1) + 5]); w.w = pk2(pA0[8 * (ks & 1) + 6], pA0[8 * (ks & 1) + 7]); }
                else        { w.x = pk2(pA1[8 * (ks & 1) + 0], pA1[8 * (ks & 1) + 1]); w.y = pk2(pA1[8 * (ks & 1) + 2], pA1[8 * (ks & 1) + 3]); w.z = pk2(pA1[8 * (ks & 1) + 4], pA1[8 * (ks & 1) + 5]); w.w = pk2(pA1[8 * (ks & 1) + 6], pA1[8 * (ks & 1) + 7]); }
                pbA[ks] = w; }
            { LAS unsigned char* ksl_ = lds + KS1;
#pragma unroll
              for (int g = 0; g < 8; ++g) { const bf16x8 kf = KFRAG(ksl_, g);
                if (g == 0) pB0 = __builtin_amdgcn_mfma_f32_32x32x16_bf16(kf, qf[0], negm, 0, 0, 0); else if (g == 1) pB1 = __builtin_amdgcn_mfma_f32_32x32x16_bf16(kf, qf[0], negm, 0, 0, 0);
                else if (g & 1) pB1 = __builtin_amdgcn_mfma_f32_32x32x16_bf16(kf, qf[g >> 1], pB1, 0, 0, 0); else pB0 = __builtin_amdgcn_mfma_f32_32x32x16_bf16(kf, qf[g >> 1], pB0, 0, 0, 0); } }
            { float t1 = fmaxf(pB0[0], pB1[0]);
#pragma unroll
              for (int r = 1; r < 16; ++r) t1 = fmaxf(t1, fmaxf(pB0[r], pB1[r]));
              t1 = swap_max(t1);
              if ((1 < NT) && __any(t1 > THR)) { const float d_ = fmaxf(t1, 0.f); fcarry = __builtin_amdgcn_exp2f(-d_); mref += d_; l *= fcarry;
#pragma unroll
                  for (int r = 0; r < 16; ++r) { pB0[r] -= d_; pB1[r] -= d_; negm[r] = -mref; } } }
            *(LAS bf16x8*)(lds + KS0 + kw) = kreg_;
            DBAR(); }
        for (int j = 1; j + 1 < NT; j += 2) { DSTEP(pB0, pB1, pA0, pA1, pbA, pbB, j); DSTEP(pA0, pA1, pB0, pB1, pbB, pbA, j + 1); }
        DSTEP(pB0, pB1, pA0, pA1, pbA, pbB, NT - 1);
#undef DSTEP
#undef KFRAG
#undef MX3
        { bf16x8 pbl[4];
#pragma unroll
          for (int q = 0; q < 4; ++q) pbl[q] = __builtin_bit_cast(bf16x8, pbB[q]);
          pv(o, lds + (((NT - 1) & 1) ? VS1 : VS0), vbase, pbl); }
        const float inv = __builtin_amdgcn_rcpf(l);
        const int tidE = opaque_tid(wv), hiE = (tidE >> 5) & 1, qrowE = qb * 256 + (tidE >> 6) * 32 + (tidE & 31);
        if (c == 0) {
#pragma unroll
            for (int d = 0; d < 4; ++d)
#pragma unroll
                for (int i = 0; i < 2; ++i) { u32x4 w; w.x = pk2(o[d][8 * i] * inv, o[d][8 * i + 1] * inv); w.y = pk2(o[d][8 * i + 2] * inv, o[d][8 * i + 3] * inv); w.z = pk2(o[d][8 * i + 4] * inv, o[d][8 * i + 5] * inv); w.w = pk2(o[d][8 * i + 6] * inv, o[d][8 * i + 7] * inv);
                    oscr[(size_t)tidE * 8 + d * 2 + i] = w; }
        } else {
            float ss = 0.f; int ly = layer; asm volatile("" : "+s"(ly));
            const float lamv = lamp[ly], postv = ly == 0 ? 0.8f : 0.64449093240903066f;
#pragma unroll
            for (int d = 0; d < 4; ++d) {
#pragma unroll
                for (int i = 0; i < 2; ++i) { const u32x4 w = __builtin_nontemporal_load(oscr + (size_t)tidE * 8 + d * 2 + i); const float il = inv * lamv;
                    o[d][8 * i + 0] = bf_lo(w.x) - o[d][8 * i + 0] * il; o[d][8 * i + 1] = bf_hi(w.x) - o[d][8 * i + 1] * il; o[d][8 * i + 2] = bf_lo(w.y) - o[d][8 * i + 2] * il; o[d][8 * i + 3] = bf_hi(w.y) - o[d][8 * i + 3] * il;
                    o[d][8 * i + 4] = bf_lo(w.z) - o[d][8 * i + 4] * il; o[d][8 * i + 5] = bf_hi(w.z) - o[d][8 * i + 5] * il; o[d][8 * i + 6] = bf_lo(w.w) - o[d][8 * i + 6] * il; o[d][8 * i + 7] = bf_hi(w.w) - o[d][8 * i + 7] * il; }
#pragma unroll
                for (int r = 0; r < 16; ++r) ss += o[d][r] * o[d][r]; }
            ss = swap_sum(ss);
            const float rn = __builtin_amdgcn_rsqf(ss * (1.0f / 128.0f) + EPS) * postv;
            bf16_t* yp = Ys + (size_t)qrowE * DM + 1024 + h * 128;
            f32x4 gl[16];
#pragma unroll
            for (int i = 0; i < 16; ++i) gl[i] = *(const f32x4*)(lng + (i >> 2) * 32 + 8 * (i & 3) + 4 * hiE);
            __builtin_amdgcn_sched_barrier(0);
#pragma unroll
            for (int d = 0; d < 4; ++d)
#pragma unroll
                for (int a4 = 0; a4 < 4; ++a4) { const int d0 = d * 32 + 8 * a4 + 4 * hiE; const f32x4 g = gl[d * 4 + a4];
                    u32x2 w; w.x = pk2(o[d][4 * a4] * rn * g[0], o[d][4 * a4 + 1] * rn * g[1]); w.y = pk2(o[d][4 * a4 + 2] * rn * g[2], o[d][4 * a4 + 3] * rn * g[3]);
                    *(u32x2*)((char*)Ys + pg8::atile_off(qrowE, 1024 + h * 128 + d * 32 + 8 * a4, DM / 64) + 8 * hiE) = w; (void)yp; (void)d0; }
        }
    }
}
#undef DBAR
}

namespace wattn {
constexpr int VP = 192, VBUF = 32 * VP, KP = 144, KBUF = 32 * KP, WBUF = VBUF + KBUF;
constexpr float THR = 8.0f;
struct KV { bf16x8 kr[4], vr[4]; };
struct Geom { int kind, a0, a1, B, TS, KS, nt, QB, qsh, qcol, kcol, vcol; };
__device__ __forceinline__ unsigned kv_off0(const Geom& G, int lane) { return (unsigned)(zoff(G.B + (lane >> 3) * G.KS, G.kcol) + 8 * (lane & 7)) * 2u; }
__device__ __forceinline__ void load_kv(KV& t, const char* Zc, unsigned off, unsigned rsb, int dv) {
#pragma unroll
    for (int i = 0; i < 4; ++i) { const char* pk = Zc + (off + (unsigned)i * rsb); t.kr[i] = *(const bf16x8*)pk; t.vr[i] = *(const bf16x8*)(pk + dv); }
}
__device__ __forceinline__ void load_q(bf16x8 (&qf)[4], const char* Zc, const Geom& G, int lane) {
    const int r32 = lane & 31, hi = lane >> 5; const int qtok = G.QB + (G.qsh < 0 ? (r32 >> 4) * 64 + (r32 & 15) : (r32 << G.qsh));
    const char* Qp = Zc + (unsigned)(zoff(qtok, G.qcol) + 8 * hi) * 2u;
#pragma unroll
    for (int s = 0; s < 4; ++s) qf[s] = *(const bf16x8*)(Qp + 32 * s);
}
__device__ __forceinline__ void put_k(const KV& t, LAS unsigned char* kb, int lane) {
#pragma unroll
    for (int i = 0; i < 4; ++i) *(LAS bf16x8*)(kb + ((lane >> 3) + 8 * i) * KP + (lane & 7) * 16) = t.kr[i];
}
__device__ __forceinline__ f32x16 qk4(LAS unsigned char* kb, const bf16x8 (&qf)[4], int lane) {
    LAS unsigned char* p = kb + (lane & 31) * KP + (lane >> 5) * 16;
    bf16x8 kf[4];
#pragma unroll
    for (int st = 0; st < 4; ++st) kf[st] = *(const LAS bf16x8*)(p + st * 32);
    __builtin_amdgcn_sched_barrier(0);
    f32x16 s = __builtin_amdgcn_mfma_f32_32x32x16_bf16(kf[0], qf[0], (f32x16){0.f, 0.f, 0.f, 0.f, 0.f, 0.f, 0.f, 0.f, 0.f, 0.f, 0.f, 0.f, 0.f, 0.f, 0.f, 0.f}, 0, 0, 0);
#pragma unroll
    for (int st = 1; st < 4; ++st) s = __builtin_amdgcn_mfma_f32_32x32x16_bf16(kf[st], qf[st], s, 0, 0, 0);
    return s;
}
__device__ __forceinline__ void put_v(const KV& t, LAS unsigned char* vb, int lane) {
#pragma unroll
    for (int i = 0; i < 4; ++i) *(LAS bf16x8*)(vb + ((lane >> 3) + 8 * i) * VP + (lane & 7) * 16) = t.vr[i];
}
__device__ __forceinline__ void pv2(f32x16& o0, f32x16& o1, LAS unsigned char* vb, const u32x4 (&pb)[2], int lane) {
    const int hi = lane >> 5; LAS unsigned char* p0 = vb + (4 * hi + ((lane >> 2) & 3)) * VP + (16 * ((lane >> 4) & 1) + 4 * (lane & 3)) * 2;
    bf16x8 va[4];
#pragma unroll
    for (int i = 0; i < 4; ++i) { LAS unsigned char* p = p0 + (i >> 1) * 16 * VP + (i & 1) * 64;
        const s16x4 lo = __builtin_amdgcn_ds_read_tr16_b64_v4i16((LAS s16x4*)p), hh = __builtin_amdgcn_ds_read_tr16_b64_v4i16((LAS s16x4*)(p + 8 * VP));
        va[i] = (bf16x8){lo[0], lo[1], lo[2], lo[3], hh[0], hh[1], hh[2], hh[3]}; }
    __builtin_amdgcn_sched_barrier(0);
#pragma unroll
    for (int ks = 0; ks < 2; ++ks) { o0 = __builtin_amdgcn_mfma_f32_32x32x16_bf16(va[2 * ks], __builtin_bit_cast(bf16x8, pb[ks]), o0, 0, 0, 0); o1 = __builtin_amdgcn_mfma_f32_32x32x16_bf16(va[2 * ks + 1], __builtin_bit_cast(bf16x8, pb[ks]), o1, 0, 0, 0); }
}
template <class FixS>
__device__ __forceinline__ void run(f32x16& o0, f32x16& o1, float& l, float& mref, bf16x8 (&qf)[4], KV& kvA, KV& kvB, const char* Zc, const Geom& G, const Geom& N, const bool hasN, const FixS& fixs, LAS unsigned char* wbuf, int lane) {
    const f32x16 zero = (f32x16){0.f, 0.f, 0.f, 0.f, 0.f, 0.f, 0.f, 0.f, 0.f, 0.f, 0.f, 0.f, 0.f, 0.f, 0.f, 0.f};
    LAS unsigned char* const vbuf = wbuf; LAS unsigned char* const kbuf = wbuf + VBUF;
    const int nt = G.nt; const unsigned tsb = (unsigned)G.TS * (ZR * 2), rsb = (unsigned)G.KS * (8 * ZR * 2); const int dv = ((G.vcol - G.kcol) >> 6) * (GT * ZR * 2);
    unsigned off2 = kv_off0(G, lane) + 2u * tsb;
    o0 = zero; o1 = zero; l = 0.f;
    f32x16 sA, sB; u32x4 pbA[2], pbB[2]; float fcarry = 1.0f;
    asm volatile("" ::: "memory"); put_k(kvA, kbuf, lane); asm volatile("" ::: "memory");
    sA = qk4(kbuf, qf, lane); fixs(0, sA);
    { float mx = sA[0];
#pragma unroll
      for (int r = 1; r < 16; ++r) mx = fmaxf(mx, sA[r]);
      mx = swap_max(mx); mx = (mx > -1e30f) ? mx : 0.f; mref = mx;
#pragma unroll
      for (int r = 0; r < 16; ++r) sA[r] -= mx; }
#define WSTEP(SC, SN, PBR, PBW, KC, KN, TT, KCI) do { const int t_ = (TT); const bool nx_ = (t_ + 1 < nt); \
        asm volatile("" ::: "memory"); \
        if (nx_) { put_k(KN, kbuf, lane); asm volatile("" ::: "memory"); SN = qk4(kbuf, qf, lane); } \
        if (t_ >= 1) pv2(o0, o1, vbuf, PBR, lane); \
        asm volatile("" ::: "memory"); put_v(KC, vbuf, lane); asm volatile("" ::: "memory"); \
        if (t_ + 2 < nt) { load_kv(KC, Zc, off2, rsb, dv); off2 += tsb; } \
        else if (hasN) load_kv(KC, Zc, kv_off0(N, lane) + (KCI) * ((unsigned)N.TS * (ZR * 2)), (unsigned)N.KS * (8 * ZR * 2), ((N.vcol - N.kcol) >> 6) * (GT * ZR * 2));     \
        if (!nx_ && hasN) load_q(qf, Zc, N, lane); \
        float ps_ = 0.f; \
        _Pragma("unroll") for (int r = 0; r < 16; r += 2) { const float e0_ = __builtin_amdgcn_exp2f(SC[r]), e1_ = __builtin_amdgcn_exp2f(SC[r + 1]); ps_ += e0_; ps_ += e1_; PBW[r >> 3][(r >> 1) & 3] = pk2(e0_, e1_); } \
        ps_ = swap_sum(ps_); l += ps_; \
        if (__any(fcarry < 1.0f)) { o0 *= fcarry; o1 *= fcarry; } \
        fcarry = 1.0f; \
        if (nx_) { _Pragma("unroll") for (int r = 0; r < 16; ++r) SN[r] -= mref; \
            fixs(t_ + 1, SN); float tn_ = SN[0]; \
            _Pragma("unroll") for (int r = 1; r < 16; ++r) tn_ = fmaxf(tn_, SN[r]); \
            tn_ = swap_max(tn_); \
            if (__any(tn_ > THR)) { const float d_ = fmaxf(tn_, 0.f); fcarry = __builtin_amdgcn_exp2f(-d_); mref += d_; l *= fcarry; \
                _Pragma("unroll") for (int r = 0; r < 16; ++r) SN[r] -= d_; } } \
    } while (0)
    int t = 0;
    for (; t + 1 < nt; t += 2) { WSTEP(sA, sB, pbB, pbA, kvA, kvB, t, 0); WSTEP(sB, sA, pbA, pbB, kvB, kvA, t + 1, 1); }
    if (t < nt) { WSTEP(sA, sB, pbB, pbA, kvA, kvB, t, 0); asm volatile("" ::: "memory"); pv2(o0, o1, vbuf, pbA, lane); }
    else { asm volatile("" ::: "memory"); pv2(o0, o1, vbuf, pbB, lane); }
#undef WSTEP
    asm volatile("" ::: "memory");
}

__device__ __forceinline__ Geom nat_geom(int T, int qb, int h) {
    const int tok0 = qb * 32, seqrow0 = tok0 & ~(T - 1), bl = (tok0 & (T - 1)) >> 5, r = 2 * (bl >> 2), c0 = 16 * (bl & 3), rows = T >> 6;
    const int rsu = min(max(r - 4, 0), rows - 8), nt = min(max(r - 3, 0), rows - 8) + 8 - rsu, cst = min(min(max(c0 - 8, 0), 48), 32);
    return Geom{0, qb, 0, seqrow0 + rsu * 64 + cst, 64, 1, nt, seqrow0 + r * 64 + c0, -1, 512 + h * 64, 1024 + h * 64, 1536 + h * 64};
}
__device__ __forceinline__ Geom dil_geom(int T, int g, int qblk, int h) {
    const int ds = 2 * g, d = 1 << ds, nqs = T >> 5;
    const int seqrow0 = (qblk << 5) & ~(T - 1), qs = qblk & (nqs - 1), rho = qs & (d - 1), u0 = (qs >> ds) * 32, U = T >> ds;
    const int jlo = u0 >= 64 ? 0 : (u0 >= 32 ? 1 : 2), jhi = (u0 + 96 <= U) ? 4 : ((u0 + 64 <= U) ? 3 : 2);
    const int base = seqrow0 + rho, ub = u0 - 64 + 32 * jlo;
    return Geom{1, g, qblk, base + (ub << ds), 32 << ds, d, jhi - jlo + 1, base + (u0 << ds), ds, 3584 + g * 512 + h * 64, 5120 + g * 512 + h * 64, 6656 + g * 512 + h * 64};
}
__device__ __forceinline__ void task(const bf16_t* Z, bf16_t* Y, float* DO, float* DL, const LAS float* tabl, int T, int h, bf16x8 (&qf)[4], KV& kvA, KV& kvB, const Geom& G, const Geom& N, bool hasN, LAS unsigned char* vbuf) {
    const int lane = opaque_lane(), r32 = lane & 31, hi = lane >> 5;
    const bool nat = G.kind == 0;
    const int tok0 = G.a0 * 32, nsr0 = tok0 & ~(T - 1), bl = (tok0 & (T - 1)) >> 5, r = 2 * (bl >> 2), c0 = 16 * (bl & 3), rows = T >> 6;
    const int qr = r + (r32 >> 4), qc = c0 + (r32 & 15);
    const int rsu = min(max(r - 4, 0), rows - 8), cst = min(min(max(c0 - 8, 0), 48), 32);
    const int dlo = min(max(qr - 4, 0), rows - 8) - rsu, clo = min(max(qc - 8, 0), 48) - cst - 4 * hi;
    const LAS float* rbl = tabl + h * 465 + (rsu - qr + 7) * 31 + 15 - qc + cst + 4 * hi;
    const int g = G.a0, qblk = G.a1, ds = 2 * g, d = 1 << ds, nqs = T >> 5;
    const int dsr0 = (qblk << 5) & ~(T - 1), qs = qblk & (nqs - 1), rho = qs & (d - 1), u0 = (qs >> ds) * 32;
    const int jlo = u0 >= 64 ? 0 : (u0 >= 32 ? 1 : 2);
    const int qtok = nat ? nsr0 + qr * 64 + qc : dsr0 + rho + ((u0 + r32) << ds);
    const int keyl = r32 - 4 * hi;
    f32x16 o0, o1; float l, mref;
    run(o0, o1, l, mref, qf, kvA, kvB, (const char*)Z, G, N, hasN,
        [&](int t, f32x16& s) {
            if (nat) { const int cl = ((unsigned)(t - dlo) < 8u) ? clo : (1 << 20); const LAS float* bp = rbl + t * 31;
                float bv[16];
#pragma unroll
                for (int rr = 0; rr < 16; ++rr) bv[rr] = bp[(rr & 3) + 8 * (rr >> 2)];
#pragma unroll
                for (int rr = 0; rr < 16; ++rr) s[rr] = ((unsigned)((rr & 3) + 8 * (rr >> 2) - cl) < 16u) ? s[rr] + bv[rr] : -INFINITY; }
            else { const int jt = jlo + t;
                if (jt == 0) {
#pragma unroll
                    for (int rr = 0; rr < 16; ++rr) s[rr] = ((rr & 3) + 8 * (rr >> 2) >= keyl) ? s[rr] : -INFINITY; }
                else if (jt == 4) {
#pragma unroll
                    for (int rr = 0; rr < 16; ++rr) s[rr] = ((rr & 3) + 8 * (rr >> 2) <= keyl) ? s[rr] : -INFINITY; } } },
        vbuf, lane);
    const float inv = __builtin_amdgcn_rcpf(l);
    if (nat) {
        bf16_t* yp = Y + (size_t)qtok * DM + 512 + h * 64;
#pragma unroll
        for (int a4 = 0; a4 < 4; ++a4) { const int d0 = 8 * a4 + 4 * hi;
            u32x2 w; w.x = pk2(o0[4 * a4] * inv, o0[4 * a4 + 1] * inv); w.y = pk2(o0[4 * a4 + 2] * inv, o0[4 * a4 + 3] * inv); *(u32x2*)((char*)Y + pg8::atile_off(qtok, 512 + h * 64 + 8 * a4, DM / 64) + 8 * hi) = w;
            u32x2 w1; w1.x = pk2(o1[4 * a4] * inv, o1[4 * a4 + 1] * inv); w1.y = pk2(o1[4 * a4 + 2] * inv, o1[4 * a4 + 3] * inv); *(u32x2*)((char*)Y + pg8::atile_off(qtok, 512 + h * 64 + 32 + 8 * a4, DM / 64) + 8 * hi) = w1; (void)yp; (void)d0; }
    } else {
        bf16_t* op = (bf16_t*)DO + ((size_t)g * GT + qtok) * 512 + h * 64;
#pragma unroll
        for (int a4 = 0; a4 < 4; ++a4) { const int d0 = 8 * a4 + 4 * hi;
            u32x2 w; w.x = pk2(o0[4 * a4] * inv, o0[4 * a4 + 1] * inv); w.y = pk2(o0[4 * a4 + 2] * inv, o0[4 * a4 + 3] * inv); *(u32x2*)(op + d0) = w;
            u32x2 w1; w1.x = pk2(o1[4 * a4] * inv, o1[4 * a4 + 1] * inv); w1.y = pk2(o1[4 * a4 + 2] * inv, o1[4 * a4 + 3] * inv); *(u32x2*)(op + 32 + d0) = w1; }
        if (hi == 0) DL[((size_t)g * GT + qtok) * 8 + h] = mref + __log2f(l);
    }
}
__device__ __forceinline__ Geom stream_geom(int T, int h, int kk, int wx, int nwg) {
    const int i = wx + (kk >> 1) * nwg, k = kk & 1;
    return nat_geom(T, 2 * i + k, h);
}
__device__ __forceinline__ void stream(const bf16_t* Z, bf16_t* Y, float* DO, float* DL, const LAS float* tabl, int T, int h, int wx, int nwg, LAS unsigned char* vbuf) {
    const int total = 2 * ((256 - wx + nwg - 1) / nwg);
    if (total <= 0) return;
    Geom G = stream_geom(T, h, 0, wx, nwg), N = G; bf16x8 qf[4]; KV kvA, kvB;
    { const int lane = opaque_lane(); const unsigned o0 = kv_off0(G, lane), tsb = (unsigned)G.TS * (ZR * 2), rsb = (unsigned)G.KS * (8 * ZR * 2); const int dv = ((G.vcol - G.kcol) >> 6) * (GT * ZR * 2);
      load_q(qf, (const char*)Z, G, lane); load_kv(kvA, (const char*)Z, o0, rsb, dv); load_kv(kvB, (const char*)Z, o0 + tsb, rsb, dv); }
    for (int kk = 0; kk < total; ++kk) {
        const bool hasN = kk + 1 < total; if (hasN) N = stream_geom(T, h, kk + 1, wx, nwg);
        task(Z, Y, DO, DL, tabl, T, h, qf, kvA, kvB, G, N, hasN, vbuf);
        G = N;
    }
}

constexpr int SKT = 32 * KP, SVT = 32 * VP, SVOFF = 12 * SKT;
struct DTask { int g, h, ds, tok0, u0b, U; };
__device__ __forceinline__ DTask dtask_of(int T, int j) {
    const int g = j >> 9, rem = j & 511, h = rem & 7, jj = rem >> 3, ds = 2 * g, d = 1 << ds, per = T >> 8;
    const int seq = jj / per, q = jj % per, rho = q & (d - 1), ubg = q >> ds;
    return DTask{g, h, ds, seq * T + rho, ubg * 256, T >> ds};
}
__device__ __forceinline__ void dshared_prefetch(u32x4 (&pre)[12], bf16x8 (&qn)[4], const char* Zc, const DTask& D, int tid, int wave, int lane) {
    const int kv = tid >> 8, row = (tid >> 3) & 31, chunk = tid & 7;
    const int col = (kv ? 6656 : 5120) + D.g * 512 + D.h * 64 + chunk * 8;
#pragma unroll
    for (int j = 0; j < 12; ++j) { const int u = D.u0b - 64 + 32 * j;
        if (u >= 0 && u + 32 <= D.U) pre[j] = *(const u32x4*)(Zc + (unsigned)zoff(D.tok0 + ((u + row) << D.ds), col) * 2u); }
    const int r32 = lane & 31, hi = lane >> 5; const int tq = D.tok0 + ((D.u0b + 32 * wave + r32) << D.ds);
    const char* Qp = Zc + (unsigned)(zoff(tq, 3584 + D.g * 512 + D.h * 64) + 8 * hi) * 2u;
#pragma unroll
    for (int s = 0; s < 4; ++s) qn[s] = *(const bf16x8*)(Qp + 32 * s);
}
__device__ __forceinline__ void dshared_task(const bf16_t* Z, float* DO, float* DL, int T, const DTask& D, const DTask& Nx, bool hasN, u32x4 (&pre)[12], bf16x8 (&qn)[4], LAS unsigned char* lds, int tid, int wave) {
    const int lane = tid & 63, r32 = lane & 31, hi = lane >> 5;
    asm volatile("s_waitcnt lgkmcnt(0)\n\ts_barrier" ::: "memory");
    { const int kv = tid >> 8, row = (tid >> 3) & 31, chunk = tid & 7; LAS unsigned char* wp = lds + (kv ? SVOFF + row * VP : row * KP) + chunk * 16;
#pragma unroll
      for (int j = 0; j < 12; ++j) { const int u = D.u0b - 64 + 32 * j; if (u >= 0 && u + 32 <= D.U) *(LAS u32x4*)(wp + j * (kv ? SVT : SKT)) = pre[j]; } }
    bf16x8 qf[4];
#pragma unroll
    for (int s = 0; s < 4; ++s) qf[s] = qn[s];
    asm volatile("s_waitcnt lgkmcnt(0)\n\ts_barrier" ::: "memory");
    if (hasN) dshared_prefetch(pre, qn, (const char*)Z, Nx, tid, wave, lane);
    const int u0 = D.u0b + 32 * wave, jlo = u0 >= 64 ? 0 : (u0 >= 32 ? 1 : 2), jhi = (u0 + 96 <= D.U) ? 4 : ((u0 + 64 <= D.U) ? 3 : 2), nt = jhi - jlo + 1;
    const int keyl = r32 - 4 * hi;
    LAS unsigned char* kb0 = lds + (wave + jlo) * SKT; LAS unsigned char* vb0 = lds + SVOFF + (wave + jlo) * SVT;
    const f32x16 zero = (f32x16){0.f, 0.f, 0.f, 0.f, 0.f, 0.f, 0.f, 0.f, 0.f, 0.f, 0.f, 0.f, 0.f, 0.f, 0.f, 0.f};
    f32x16 o0 = zero, o1 = zero, sA, sB; u32x4 pbA[2], pbB[2]; float l = 0.f, mref, fcarry = 1.0f;
#define DFIX(TT, S) do { const int jt_ = jlo + (TT); \
        if (jt_ == 0) { _Pragma("unroll") for (int rr = 0; rr < 16; ++rr) S[rr] = ((rr & 3) + 8 * (rr >> 2) >= keyl) ? S[rr] : -INFINITY; } \
        else if (jt_ == 4) { _Pragma("unroll") for (int rr = 0; rr < 16; ++rr) S[rr] = ((rr & 3) + 8 * (rr >> 2) <= keyl) ? S[rr] : -INFINITY; } } while (0)
    sA = qk4(kb0, qf, lane); DFIX(0, sA);
    { float mx = sA[0];
#pragma unroll
      for (int r = 1; r < 16; ++r) mx = fmaxf(mx, sA[r]);
      mx = swap_max(mx); mx = (mx > -1e30f) ? mx : 0.f; mref = mx;
#pragma unroll
      for (int r = 0; r < 16; ++r) sA[r] -= mx; }
#define DSTEP2(SC, SN, PBR, PBW, TT) do { const int t_ = (TT); const bool nx_ = (t_ + 1 < nt); \
        if (nx_) SN = qk4(kb0 + (t_ + 1) * SKT, qf, lane); \
        if (t_ >= 1) pv2(o0, o1, vb0 + (t_ - 1) * SVT, PBR, lane); \
        float ps_ = 0.f; \
        _Pragma("unroll") for (int r = 0; r < 16; r += 2) { const float e0_ = __builtin_amdgcn_exp2f(SC[r]), e1_ = __builtin_amdgcn_exp2f(SC[r + 1]); ps_ += e0_; ps_ += e1_; PBW[r >> 3][(r >> 1) & 3] = pk2(e0_, e1_); } \
        ps_ = swap_sum(ps_); l += ps_; \
        if (__any(fcarry < 1.0f)) { o0 *= fcarry; o1 *= fcarry; } \
        fcarry = 1.0f; \
        if (nx_) { _Pragma("unroll") for (int r = 0; r < 16; ++r) SN[r] -= mref; \
            DFIX(t_ + 1, SN); float tn_ = SN[0]; \
            _Pragma("unroll") for (int r = 1; r < 16; ++r) tn_ = fmaxf(tn_, SN[r]); \
            tn_ = swap_max(tn_); \
            if (__any(tn_ > THR)) { const float d_ = fmaxf(tn_, 0.f); fcarry = __builtin_amdgcn_exp2f(-d_); mref += d_; l *= fcarry; \
                _Pragma("unroll") for (int r = 0; r < 16; ++r) SN[r] -= d_; } } \
    } while (0)
    int t = 0;
    for (; t + 1 < nt; t += 2) { DSTEP2(sA, sB, pbB, pbA, t); DSTEP2(sB, sA, pbA, pbB, t + 1); }
    if (t < nt) { DSTEP2(sA, sB, pbB, pbA, t); pv2(o0, o1, vb0 + (nt - 1) * SVT, pbA, lane); }
    else pv2(o0, o1, vb0 + (nt - 1) * SVT, pbB, lane);
#undef DSTEP2
#undef DFIX
    const float inv = __builtin_amdgcn_rcpf(l);
    const int tq = D.tok0 + ((u0 + r32) << D.ds);
    bf16_t* op = (bf16_t*)DO + ((size_t)D.g * GT + tq) * 512 + D.h * 64;
#pragma unroll
    for (int a4 = 0; a4 < 4; ++a4) { const int d0 = 8 * a4 + 4 * hi;
        u32x2 w; w.x = pk2(o0[4 * a4] * inv, o0[4 * a4 + 1] * inv); w.y = pk2(o0[4 * a4 + 2] * inv, o0[4 * a4 + 3] * inv); *(u32x2*)(op + d0) = w;
        u32x2 w1; w1.x = pk2(o1[4 * a4] * inv, o1[4 * a4 + 1] * inv); w1.y = pk2(o1[4 * a4 + 2] * inv, o1[4 * a4 + 3] * inv); *(u32x2*)(op + 32 + d0) = w1; }
    if (hi == 0) DL[((size_t)D.g * GT + tq) * 8 + D.h] = mref + __log2f(l);
}
__device__ __forceinline__ void dshared(const bf16_t* Z, float* DO, float* DL, int T, int wx, int nwg, LAS unsigned char* lds, int tid, int wave) {
    if (wx >= 1536) return;
    const int lane = tid & 63;
    DTask D = dtask_of(T, wx), Nx = D; u32x4 pre[12]; bf16x8 qn[4];
    dshared_prefetch(pre, qn, (const char*)Z, D, tid, wave, lane);
    for (int j = wx; j < 1536; j += nwg) {
        const bool hasN = j + nwg < 1536; if (hasN) Nx = dtask_of(T, j + nwg);
        dshared_task(Z, DO, DL, T, D, Nx, hasN, pre, qn, lds, tid, wave);
        D = Nx;
    }
}
}

namespace fftm {
constexpr int PP = 320, PLANE = 128 * PP;
__device__ __forceinline__ bf16x8 trB(LAS unsigned char* p) {
    const s16x4 lo = __builtin_amdgcn_ds_read_tr16_b64_v4i16((LAS s16x4*)p), hh = __builtin_amdgcn_ds_read_tr16_b64_v4i16((LAS s16x4*)(p + 4 * PP));
    return (bf16x8){lo[0], lo[1], lo[2], lo[3], hh[0], hh[1], hh[2], hh[3]};
}
__device__ __forceinline__ bf16_t bf1(float x) { return (bf16_t)(pk2(x, 0.f) & 0xffffu); }
constexpr int UP = 272, PLOFF = 36864;
template <int N1>
__device__ __forceinline__ void pass1(const bf16_t* Zs, bf16_t* Bs, int t2, int g4, int dftstep, const bf16_t* W, const bf16_t* W128, LAS unsigned char* lds, int tid) {
    __syncthreads();
    { bf16x8 uv[N1 / 32];
#pragma unroll
      for (int i = 0; i < N1 / 32; ++i) { const int idx = tid + 512 * i, t1 = idx >> 4, c = idx & 15; uv[i] = *(const bf16x8*)(Zs + zoff(t1 * 128 + t2, g4 * 128 + c * 8)); }
#pragma unroll
      for (int i = 0; i < N1 / 32; ++i) { const int idx = tid + 512 * i, t1 = idx >> 4, c = idx & 15; *(LAS bf16x8*)(lds + t1 * UP + c * 16) = uv[i]; } }
    __syncthreads();
    constexpr int KB = N1 / 32, TPW = N1 / 64;
    const int lane = tid & 63, wid = __builtin_amdgcn_readfirstlane(tid >> 6), r32 = lane & 31, hi = lane >> 5;
    LAS unsigned char* const pl = lds + PLOFF;
    {
        const int tb = wid & 3, ca0 = (wid >> 2) * 2;
        if (tb < KB) {
            f32x16 aP[2], aQ[2];
#pragma unroll
            for (int t = 0; t < 2; ++t) { aP[t] = (f32x16){0.f, 0.f, 0.f, 0.f, 0.f, 0.f, 0.f, 0.f, 0.f, 0.f, 0.f, 0.f, 0.f, 0.f, 0.f, 0.f}; aQ[t] = aP[t]; }
            const LAS unsigned char* up = lds + (tb * 32 + r32) * UP + 16 * hi;
#pragma unroll
            for (int kh = 0; kh < 2; ++kh) {
                bf16x8 wP[4][2], wQ[4][2];
#pragma unroll
                for (int k4 = 0; k4 < 4; ++k4)
#pragma unroll
                    for (int t = 0; t < 2; ++t) { const bf16_t* wr_ = W128 + ((ca0 + t) * 32 + r32) * 128 + 16 * (kh * 4 + k4) + 8 * hi;
                        wP[k4][t] = *(const bf16x8*)wr_; wQ[k4][t] = *(const bf16x8*)(wr_ + 16384); }
                __builtin_amdgcn_sched_barrier(0);
#pragma unroll
                for (int k4 = 0; k4 < 4; ++k4) { const bf16x8 au = *(const LAS bf16x8*)(up + (kh * 4 + k4) * 32);
#pragma unroll
                    for (int t = 0; t < 2; ++t) { aP[t] = __builtin_amdgcn_mfma_f32_32x32x16_bf16(au, wP[k4][t], aP[t], 0, 0, 0); aQ[t] = __builtin_amdgcn_mfma_f32_32x32x16_bf16(au, wQ[k4][t], aQ[t], 0, 0, 0); } }
                __builtin_amdgcn_sched_barrier(0); }
#pragma unroll
            for (int t = 0; t < 2; ++t)
#pragma unroll
                for (int r = 0; r < 16; ++r) { LAS bf16_t* o = (LAS bf16_t*)(pl + (tb * 32 + crow(r, hi)) * PP) + (ca0 + t) * 32 + r32; o[0] = bf1(aP[t][r]); *(LAS bf16_t*)((LAS unsigned char*)o + PLANE) = bf1(aQ[t][r]); }
        }
    }
    __syncthreads();
    const int kblk = wid % KB, cb0 = (wid / KB) * TPW;
    const bf16_t* wc = W + (kblk * 32 + r32) * N1 + 8 * hi; const bf16_t* wsn = wc + N1 * N1; const bf16_t* wn = wsn + N1 * N1;
    const int vb = (8 * hi + ((lane >> 2) & 3)) * PP + (16 * ((lane >> 4) & 1) + 4 * (lane & 3)) * 2;
    f32x16 re[TPW], im[TPW];
#pragma unroll
    for (int t = 0; t < TPW; ++t) { re[t] = (f32x16){0.f, 0.f, 0.f, 0.f, 0.f, 0.f, 0.f, 0.f, 0.f, 0.f, 0.f, 0.f, 0.f, 0.f, 0.f, 0.f}; im[t] = re[t]; }
#pragma unroll
    for (int kh = 0; kh < N1 / 64; ++kh) {
        bf16x8 ac[4], as[4], an[4];
#pragma unroll
        for (int k4 = 0; k4 < 4; ++k4) { const int ks = kh * 4 + k4; ac[k4] = *(const bf16x8*)(wc + 16 * ks); as[k4] = *(const bf16x8*)(wsn + 16 * ks); an[k4] = *(const bf16x8*)(wn + 16 * ks); }
        __builtin_amdgcn_sched_barrier(0);
#pragma unroll
        for (int k4 = 0; k4 < 4; ++k4) { const int ks = kh * 4 + k4;
#pragma unroll
            for (int t = 0; t < TPW; ++t) { LAS unsigned char* bp = pl + vb + ks * 16 * PP + (cb0 + t) * 64;
                const bf16x8 bP = trB(bp), bQ = trB(bp + PLANE);
                re[t] = __builtin_amdgcn_mfma_f32_32x32x16_bf16(ac[k4], bP, re[t], 0, 0, 0); re[t] = __builtin_amdgcn_mfma_f32_32x32x16_bf16(an[k4], bQ, re[t], 0, 0, 0);
                im[t] = __builtin_amdgcn_mfma_f32_32x32x16_bf16(as[k4], bP, im[t], 0, 0, 0); im[t] = __builtin_amdgcn_mfma_f32_32x32x16_bf16(ac[k4], bQ, im[t], 0, 0, 0); } }
        __builtin_amdgcn_sched_barrier(0);
    }
#pragma unroll
    for (int t = 0; t < TPW; ++t) { const int ch = (cb0 + t) * 32 + r32;
#pragma unroll
        for (int r = 0; r < 16; ++r) { const int k1 = kblk * 32 + crow(r, hi); const float x = (float)((k1 * t2 * dftstep) & 16383) * (1.0f / 16384.0f);
            const float c = __builtin_amdgcn_cosf(x), sn = __builtin_amdgcn_sinf(x);
            bf16_t* o = Bs + ((((size_t)k1 * 128 + t2) * 4 + g4) * 256 + ch);
            o[0] = bf1(re[t][r] * c - im[t][r] * sn); o[128] = bf1(re[t][r] * sn + im[t][r] * c); } }
}
template <int N1>
__device__ __forceinline__ void pass2(const bf16_t* Bs, bf16_t* Ys, int k1, int g4, float rsT, const bf16_t* W128, LAS unsigned char* lds, int tid) {
    __syncthreads();
    { bf16x8 rv[4], iv[4];
#pragma unroll
      for (int i = 0; i < 4; ++i) { const int idx = tid + 512 * i, t2 = idx >> 4, c = idx & 15; const bf16_t* p = Bs + ((((size_t)k1 * 128 + t2) * 4 + g4) * 256 + c * 8); rv[i] = *(const bf16x8*)p; iv[i] = *(const bf16x8*)(p + 128); }
#pragma unroll
      for (int i = 0; i < 4; ++i) { const int idx = tid + 512 * i, t2 = idx >> 4, c = idx & 15; *(LAS bf16x8*)(lds + t2 * PP + c * 16) = rv[i]; *(LAS bf16x8*)(lds + PLANE + t2 * PP + c * 16) = iv[i]; } }
    __syncthreads();
    const int lane = tid & 63, wid = __builtin_amdgcn_readfirstlane(tid >> 6), r32 = lane & 31, hi = lane >> 5;
    const int kblk = wid & 3, cb0 = (wid >> 2) * 2;
    const bf16_t* wc = W128 + (kblk * 32 + r32) * 128 + 8 * hi; const bf16_t* wn = wc + 2 * 128 * 128;
    const int vb = (8 * hi + ((lane >> 2) & 3)) * PP + (16 * ((lane >> 4) & 1) + 4 * (lane & 3)) * 2;
    f32x16 acc[2];
    acc[0] = (f32x16){0.f, 0.f, 0.f, 0.f, 0.f, 0.f, 0.f, 0.f, 0.f, 0.f, 0.f, 0.f, 0.f, 0.f, 0.f, 0.f}; acc[1] = acc[0];
    bf16x8 ac[8], an[8];
#pragma unroll
    for (int ks = 0; ks < 8; ++ks) { ac[ks] = *(const bf16x8*)(wc + 16 * ks); an[ks] = *(const bf16x8*)(wn + 16 * ks); }
    __builtin_amdgcn_sched_barrier(0);
#pragma unroll
    for (int ks = 0; ks < 8; ++ks) {
#pragma unroll
        for (int t = 0; t < 2; ++t) { LAS unsigned char* bp = lds + vb + ks * 16 * PP + (cb0 + t) * 64;
            const bf16x8 bR = trB(bp), bI = trB(bp + PLANE);
            acc[t] = __builtin_amdgcn_mfma_f32_32x32x16_bf16(ac[ks], bR, acc[t], 0, 0, 0); acc[t] = __builtin_amdgcn_mfma_f32_32x32x16_bf16(an[ks], bI, acc[t], 0, 0, 0); }
    }
#pragma unroll
    for (int t = 0; t < 2; ++t) { const int ch = (cb0 + t) * 32 + r32;
#pragma unroll
        for (int r = 0; r < 16; ++r) { const int k2 = kblk * 32 + crow(r, hi); *(bf16_t*)((char*)Ys + pg8::atile_off(k1 + N1 * k2, (g4 * 128 + ch) & ~7, DM / 64) + (ch & 7) * 2) = bf1(acc[t][r] * rsT); } }
}
}

constexpr int NPH = 52;
__global__ void __launch_bounds__(512, 2) fwd(Args a_unused) {
    extern __shared__ __attribute__((aligned(16))) unsigned char lds_raw[];
    LAS unsigned char* lds = (LAS unsigned char*)lds_raw;
    const int wg = blockIdx.x, nwg = gridDim.x;
    int wv = __builtin_amdgcn_readfirstlane((int)threadIdx.x >> 6); asm volatile("" : "+s"(wv));
    { const int tid0 = opaque_tid(wv); for (int u = tid0; u < (LDS_BYTES - LDSCTL_OFF) / 4; u += 512) ((LAS unsigned*)(lds + LDSCTL_OFF))[u] = 0u; }
    __syncthreads();
    int lo, hi; XcdBarrier bar;
    { KArgs* ka = kargs(); lo = ka->ph_lo; hi = ka->ph_hi; unsigned* barw = (unsigned*)(ka->ws + WS_CTL) + CW_BAR + ka->li * XCD_BAR_WORDS;
      bar.bar = barw; bar.x = 0; bar.st = (volatile LAS unsigned*)(lds + MISC_OFF + 32); bar.wv = wv;
      if (hi - lo > 1) bar = xcd_barrier_post(barw, (volatile LAS unsigned*)(lds + MISC_OFF + 32), wv); }
    int pi = 0;
#define PH_BEGIN if (pi >= lo && pi < hi) { KArgs& a = *kargs(); unsigned char* const ws = a.ws; (void)ws;
#define PH_END   if (pi + 1 < hi) xcd_barrier(bar); } ++pi;

    PH_BEGIN prologue_phase(a, lds, wg, nwg, opaque_tid(wv)); PH_END
    PH_BEGIN prologue2_phase(a, lds, wg, nwg, opaque_tid(wv)); PH_END
    PH_BEGIN { const int t_ = opaque_tid(wv); for (int rep = 0; rep < NREP(6); ++rep) norm_first_phase(a, wg, nwg, __builtin_amdgcn_readfirstlane(t_ >> 6), t_ & 63); } PH_END

    for (int l = 0; l < 2; ++l) {
        for (int s = 0; s < 3; ++s) {
            const bool first = (l == 0 && s == 0);
            if ((DBG_SKIP & 1) && s == 1) { pi += 20; continue; }
            if (s != 1) {
                PH_BEGIN { unsigned char* wl = ws + WS_W + (size_t)l * WLAYER; pg8::PlainOrder S; S.init(ws + WS_H, wl + (s == 0 ? WO_FF1I : WO_FF2I), NTOK, 2 * DFF, DM, DM, nwg, wg, WGM_FFI); S.atile = !first;        pg8::EpiSwiGLU E{(bf16_t*)(ws + WS_BIG), (const float*)(ws + WS_SS) + (size_t)(l * 3 + s) * NTOK, (const float*)(ws + WS_BW) + (size_t)l * 6 * BWL + (s == 0 ? 0 : 27392)};
                           for (int rep = 0; rep < NREP(0); ++rep) pg8::gemm_phase(lds, DM, DM, DM, S, E, wv); } PH_END
                PH_BEGIN { unsigned char* wl = ws + WS_W + (size_t)l * WLAYER; pg8::PlainOrder S; S.init(ws + WS_BIG, wl + (s == 0 ? WO_FF1O : WO_FF2O), NTOK, DM, DFF, DFF, nwg, wg, WGM_FFO);
                           const bool lastsub = (l == 1 && s == 2);
                           pg8::EpiResid E{first ? a.in[I_XP] : (const float*)nullptr, first ? a.in[I_XS] - (size_t)32768 * DM : (const float*)nullptr, (float*)(ws + WS_XF), lastsub ? a.out : (float*)nullptr,
                                           (const float*)(ws + WS_MOD) + (size_t)l * 6 * NMODC, (3 * s + 2) * DM, 0.5f, 0,
                                           lastsub ? (bf16_t*)nullptr : (bf16_t*)(ws + WS_H), (const float*)(ws + WS_AT) + (size_t)(l * 3 + s + 1) * 6 * DM, (float*)(ws + WS_SS) + (size_t)(l * 3 + s + 1) * NTOK};
                           pg8::gemm_phase(lds, DFF, DFF, DFF, S, E, wv); } PH_END
            } else {
                for (int g = 0; g < 4; ++g) {
                    const int T = g < 2 ? 16384 : 8192;
                    PH_BEGIN if (!(DBG_SKIP & 128)) { unsigned char* wl = ws + WS_W + (size_t)l * WLAYER; pg8::PlainOrder S; S.init((bf16_t*)(ws + WS_H) + (size_t)g * GT * DM, wl + WO_IN, GT, NINV, DM, DM, nwg, wg, WGM_INP);
                               pg8::EpiInProj E{(bf16_t*)(ws + WS_Z), (bf16_t*)(ws + WS_G), a.in[I_BGATE] + (size_t)l * 4 * DM, T - 1, (const float*)(ws + WS_SS) + (size_t)(l * 3 + 1) * NTOK, (const float*)(ws + WS_BW) + (size_t)l * 6 * BWL + 11008, g * GT};
                               for (int rep = 0; rep < NREP(1); ++rep) pg8::gemm_phase(lds, DM, DM, DM, S, E, wv); } PH_END
                    PH_BEGIN {
                        bf16_t* Zb = (bf16_t*)(ws + WS_Z); bf16_t* Yb = (bf16_t*)(ws + WS_Y);
                        { const float* lamp = (const float*)(ws + WS_LAM); const float* lng = a.in[I_DLNG] + l * 128;
                          if (!(DBG_SKIP & 2)) for (int rep = 0; rep < NREP(2); ++rep) for (int u = wg; u < 256; u += nwg) { const int x = u & 7, h = x >> 1; int seq, qb;
                            if (T == 16384) { seq = 0; qb = (u >> 3) * 2 + (x & 1); } else { seq = x & 1; qb = u >> 3; }
                            dattn::unit<0>(Zb + (size_t)seq * T * ZR, T, h, qb, lamp, l, lng, Yb + (size_t)seq * T * DM, (u32x4*)(ws + WS_DOS) + (size_t)u * 4096, lds, wv);
#if DBG_PROBE >= 0
                            dattn::unit<DBG_PROBE>(Zb + (size_t)seq * T * ZR, T, h, qb, lamp, l, lng, (bf16_t*)(ws + WS_MG) + (size_t)seq * T * DM, (u32x4*)(ws + WS_DOS) + (size_t)u * 4096, lds, wv);
#endif
                            } }
                        __syncthreads();
                        { const int tid = opaque_tid(wv), lane = tid & 63, wave = __builtin_amdgcn_readfirstlane(tid >> 6);
                          LAS unsigned char* vbuf = lds + wave * wattn::WBUF; const float* relb = a.in[I_RELB] + (size_t)l * 8 * 465;
                          LAS float* tabl = (LAS float*)(lds + 8 * wattn::WBUF);
                          { float tv[8];
#pragma unroll
                            for (int i = 0; i < 8; ++i) { const int e = tid + 512 * i; tv[i] = e < 8 * 465 ? relb[e] : 0.f; }
#pragma unroll
                            for (int i = 0; i < 8; ++i) { const int e = tid + 512 * i; if (e < 8 * 465) tabl[e] = tv[i] * LOG2E; } }
                          __syncthreads();
                          float* DO = (float*)(ws + WS_DILO); float* DL = (float*)(ws + WS_DILL);
                          for (int rep = 0; rep < NREP(3); ++rep) {
                          const int wx = (nwg == 256) ? ((wg & 7) * 32 + (wg >> 3)) : wg;
                          wattn::stream(Zb, Yb, DO, DL, tabl, T, wave, wx, nwg, vbuf);
                          __syncthreads();
                          wattn::dshared(Zb, DO, DL, T, wx, nwg, lds, opaque_tid(wv), wave); }
                          }
                        __syncthreads();
                        { const int tid = opaque_tid(wv); const bf16_t* dft = (const bf16_t*)(ws + WS_DFT); bf16_t* FB = (bf16_t*)(ws + WS_FFTB);
                          for (int rep = 0; rep < NREP(4); ++rep)
                          if (DBG_SKIP & 16) {} else if (T == 16384) { for (int u = wg; u < 512; u += nwg) fftm::pass1<128>(Zb, FB, u >> 2, u & 3, 1, dft, dft, lds, tid); }
                          else { for (int u = wg; u < 1024; u += nwg) { const int seq = u >> 9; fftm::pass1<64>(Zb + (size_t)seq * 8192 * ZR, FB + (size_t)seq * 64 * 128 * 1024, (u >> 2) & 127, u & 3, 2, dft + 49152, dft, lds, tid); } } }
                    } PH_END
                    PH_BEGIN {
                        const int tid = opaque_tid(wv); bf16_t* Yb = (bf16_t*)(ws + WS_Y); const bf16_t* FB = (const bf16_t*)(ws + WS_FFTB); const bf16_t* dft = (const bf16_t*)(ws + WS_DFT); const float* DO = (const float*)(ws + WS_DILO); const float* DL = (const float*)(ws + WS_DILL);
                        for (int rep = 0; rep < NREP(4); ++rep)
                        if (DBG_SKIP & 16) {} else if (T == 16384) { for (int u = wg; u < 512; u += nwg) fftm::pass2<128>(FB, Yb, u >> 2, u & 3, 0.0078125f * 0.08838834764831843f, dft, lds, tid); }
                        else { for (int u = wg; u < 512; u += nwg) { const int seq = u >> 8; fftm::pass2<64>(FB + (size_t)seq * 64 * 128 * 1024, Yb + (size_t)seq * 8192 * DM, (u >> 2) & 63, u & 3, 0.011048543456039806f * 0.08838834764831843f, dft, lds, tid); } }
                        if (DBG_SKIP & 30) { for (int item = wg * 512 + tid; item < GT * 512; item += nwg * 512) { const int row = item >> 9, c4 = item & 511, part = c4 >> 7;
                            const bool z = (part == 0 && (DBG_SKIP & 16)) || (part == 1 && (DBG_SKIP & 4)) || (part == 2 && (DBG_SKIP & 2)) || (part == 3 && (DBG_SKIP & 8));
                            if (z) *(u32x2*)(Yb + (size_t)row * DM + c4 * 4) = ((DBG_SKIP & 64) && part == 1) ? ((DBG_SKIP & 128) ? *(const u32x2*)((const bf16_t*)(ws + WS_H) + ((size_t)g * GT + row) * DM + (c4 - 128) * 4) : *(const u32x2*)((const bf16_t*)(ws + WS_Z) + (size_t)row * ZP + 512 + (c4 - 128) * 4)) : (u32x2){0u, 0u}; } }
                        if (!(DBG_SKIP & 8)) {
                            const bf16_t* DOb = (const bf16_t*)DO; const int istr = nwg * 512;
#pragma unroll 1
                            for (int item0 = wg * 512 + tid; item0 < GT * 128; item0 += 4 * istr) {
                                float Lv[4][3]; u32x2 pv[4][3];
#pragma unroll
                                for (int q = 0; q < 4; ++q) { const int item = item0 + q * istr; const bool ok = item < GT * 128; const int row = ok ? item >> 7 : 0, c4 = item & 127, h = c4 >> 4;
#pragma unroll
                                    for (int gq = 0; gq < 3; ++gq) { Lv[q][gq] = DL[((size_t)gq * GT + row) * 8 + h]; pv[q][gq] = *(const u32x2*)(DOb + ((size_t)gq * GT + row) * 512 + c4 * 4); } }
#pragma unroll
                                for (int q = 0; q < 4; ++q) { const int item = item0 + q * istr; if (item >= GT * 128) break; const int row = item >> 7, c4 = item & 127;
                                    const float L0 = Lv[q][0], L1 = Lv[q][1], L2 = Lv[q][2];
                                    const float mx = fmaxf(L0, fmaxf(L1, L2)); const float w0 = __builtin_amdgcn_exp2f(L0 - mx), w1 = __builtin_amdgcn_exp2f(L1 - mx), w2 = __builtin_amdgcn_exp2f(L2 - mx);
                                    const float inv = __builtin_amdgcn_rcpf(w0 + w1 + w2);
                                    const u32x2 p0 = pv[q][0], p1 = pv[q][1], p2 = pv[q][2];
                                    const f32x4 o = ((f32x4){bf_lo(p0.x), bf_hi(p0.x), bf_lo(p0.y), bf_hi(p0.y)} * w0 + (f32x4){bf_lo(p1.x), bf_hi(p1.x), bf_lo(p1.y), bf_hi(p1.y)} * w1 + (f32x4){bf_lo(p2.x), bf_hi(p2.x), bf_lo(p2.y), bf_hi(p2.y)} * w2) * inv;
                                    u32x2 w; w.x = pk2(o[0], o[1]); w.y = pk2(o[2], o[3]); *(u32x2*)((char*)Yb + pg8::atile_off(row, 1536 + (c4 >> 1) * 8, DM / 64) + (c4 & 1) * 8) = w; } } }
                    } PH_END
                    PH_BEGIN { unsigned char* wl = ws + WS_W + (size_t)l * WLAYER; pg8::MergeOrder S{(const char*)(ws + WS_Y), (const char*)(wl + WO_BR), nwg, wg}; pg8::EpiMerge E{(const bf16_t*)(ws + WS_G), (bf16_t*)(ws + WS_MG)};
                               for (int rep = 0; rep < NREP(5); ++rep) pg8::gemm_hm3(lds, DM, DM, DM, S, E, wv); } PH_END
                    PH_BEGIN { unsigned char* wl = ws + WS_W + (size_t)l * WLAYER; pg8::PlainOrder S; S.init(ws + WS_MG, wl + WO_OUT, GT, DM, DM, DM, nwg, wg);
                               pg8::EpiResid E{(const float*)nullptr, (const float*)nullptr, (float*)(ws + WS_XF), (float*)nullptr, (const float*)(ws + WS_MOD) + (size_t)l * 6 * NMODC, 5 * DM, 1.0f, g * GT,
                                               (bf16_t*)(ws + WS_H), (const float*)(ws + WS_AT) + (size_t)(l * 3 + 2) * 6 * DM, (float*)(ws + WS_SS) + (size_t)(l * 3 + 2) * NTOK};
                               pg8::gemm_phase(lds, DM, DM, DM, S, E, wv); } PH_END
                }
            }
        }
    }
    PH_BEGIN { const int t_ = opaque_tid(wv); final_phase(a, wg, nwg, __builtin_amdgcn_readfirstlane(t_ >> 6), t_ & 63); } PH_END
#undef PH_BEGIN
#undef PH_END
}

extern "C" void kernel_launch(void* const* d_in, const int* in_sizes, int n_in, void* d_out, int out_size, void* d_ws, size_t ws_size, hipStream_t stream) {
    static int grid = 0;
    if (grid == 0) {
        if (n_in != 24 || in_sizes[0] != 32768 * DM || out_size != NTOK * DM || ws_size < WS_END) { fprintf(stderr, "kernel_launch: unexpected shapes (n_in %d, out %d, ws %zu, need %zu)\n", n_in, out_size, ws_size, (size_t)WS_END); grid = -1; return; }
        int dev = 0, cus = 0, per_cu = 0;
        if (hipGetDevice(&dev) != hipSuccess || hipDeviceGetAttribute(&cus, hipDeviceAttributeMultiprocessorCount, dev) != hipSuccess) { grid = -1; return; }
        if (hipFuncSetAttribute((const void*)fwd, hipFuncAttributeMaxDynamicSharedMemorySize, LDS_BYTES) != hipSuccess) { fprintf(stderr, "kernel_launch: hipFuncSetAttribute failed\n"); grid = -1; return; }
        if (hipOccupancyMaxActiveBlocksPerMultiprocessor(&per_cu, (const void*)fwd, 512, LDS_BYTES) != hipSuccess || per_cu < 1) { fprintf(stderr, "kernel_launch: occupancy query says %d\n", per_cu); }
        (void)hipGetLastError();
        grid = cus > 256 ? 256 : cus;
    }
    if (grid < 0) return;
    if (hipMemsetAsync((char*)d_ws + WS_CTL, 0, CTL_ZERO_BYTES, stream) != hipSuccess) return;
    Args a{};
    for (int i = 0; i < 24; ++i) a.in[i] = (const float*)d_in[i];
    a.out = (float*)d_out; a.ws = (unsigned char*)d_ws; a.pad = 0;
#if MK_ONE_LAUNCH
    a.ph_lo = 0; a.ph_hi = NPH; a.li = 0;
    hipLaunchKernelGGL(fwd, dim3(grid), dim3(512), LDS_BYTES, stream, a);
#else
    for (int li = 0; li < NPH; ++li) { a.ph_lo = li; a.ph_hi = li + 1; a.li = 0; hipLaunchKernelGGL(fwd, dim3(grid), dim3(512), LDS_BYTES, stream, a); }
#endif
}
```

```cpp
#include <hip/hip_runtime.h>
#include <cstdio>
#include <cstdint>

#ifndef MK_ONE_LAUNCH
#define MK_ONE_LAUNCH 1
#endif
#ifndef DBG_SKIP
#define DBG_SKIP 0
#endif
#ifndef DBG_REP
#define DBG_REP 0
#endif
#ifndef DBG_PROBE
#define DBG_PROBE -1
#endif
#ifndef WGM_FFI
#define WGM_FFI 4
#endif
#ifndef WGM_INP
#define WGM_INP 4
#endif
#ifndef WGM_FFO
#define WGM_FFO 4
#endif
#ifndef DBG_WPROBE
#define DBG_WPROBE 0
#endif
#define NREP(k) (1 + ((DBG_REP >> (k)) & 1))

#define LAS __attribute__((address_space(3)))
typedef unsigned short bf16_t;
typedef short bf16x8 __attribute__((ext_vector_type(8)));
typedef short s16x4 __attribute__((ext_vector_type(4)));
typedef float f32x4 __attribute__((ext_vector_type(4)));
typedef float f32x2 __attribute__((ext_vector_type(2)));
typedef float f32x16 __attribute__((ext_vector_type(16)));
typedef unsigned u32x4 __attribute__((ext_vector_type(4)));
typedef unsigned u32x2 __attribute__((ext_vector_type(2)));

constexpr int DM = 2048, NTOK = 65536, DFF = 5504, GT = 16384, ZP = 8192, NINV = 16384, NMODC = 18432;
constexpr int ZR = 64;
__host__ __device__ __forceinline__ size_t zoff(int row, int col) { return ((size_t)(col >> 6) * GT + row) * ZR + (col & 63); }
constexpr float EPS = 1e-6f;
constexpr float LOG2E = 1.4426950408889634f;
constexpr float C2 = 0.125f * 1.4426950408889634f;

constexpr size_t MiB = 1u << 20;
constexpr size_t WS_CTL = 0, CTL_ZERO_BYTES = 1 * MiB;
constexpr size_t WS_MOD = 1 * MiB;
constexpr size_t WS_ROPE = 2 * MiB;
constexpr size_t WS_DFT = 3 * MiB;
constexpr size_t WS_LAM = 3 * MiB + 256 * 1024;
constexpr size_t WS_W = 4 * MiB;
constexpr size_t WO_FF1I = 0, WO_FF1O = 45088768, WO_IN = 67633152, WO_BR = 134742016, WO_OUT = 143130624, WO_FF2I = 151519232, WO_FF2O = 196608000, WLAYER = 219152384;
constexpr size_t WS_H = 426 * MiB;
constexpr size_t WS_BIG = 682 * MiB;
constexpr size_t WS_Z = WS_BIG, WS_G = WS_BIG + 272 * MiB, WS_Y = WS_BIG + 528 * MiB, WS_MG = WS_BIG + 592 * MiB, WS_FFTB = WS_BIG + 656 * MiB,
                 WS_DILO = WS_BIG + 688 * MiB, WS_DILL = WS_BIG + 784 * MiB, WS_DOS = WS_BIG + 786 * MiB,
                 WS_SS = WS_BIG + 802 * MiB  ,
                 WS_AT = WS_SS + 2 * MiB  , WS_BW = WS_AT + 1 * MiB  , WS_XF = WS_BW + 2 * MiB  , WS_END = WS_XF + 512 * MiB;
constexpr int BWL = 38400;
static_assert(WS_W + 2 * WLAYER <= WS_H, "weights region");
constexpr int CW_BAR = 4096;

constexpr int LDS_BYTES = 148480;
constexpr int LDSCTL_OFF = 147456;
constexpr int MISC_OFF = LDSCTL_OFF + 320;

__device__ __forceinline__ float bf_lo(unsigned w) { return __uint_as_float(w << 16); }
__device__ __forceinline__ float bf_hi(unsigned w) { return __uint_as_float(w & 0xffff0000u); }
typedef __bf16 bf16x2_t __attribute__((ext_vector_type(2)));
__device__ __forceinline__ unsigned pk2(float lo, float hi) { const f32x2 v = {lo, hi}; const bf16x2_t b = __builtin_convertvector(v, bf16x2_t); return __builtin_bit_cast(unsigned, b); }
__device__ __forceinline__ float swap_max(float x) { auto rr = __builtin_amdgcn_permlane32_swap(__float_as_uint(x), __float_as_uint(x), false, false); return fmaxf(__uint_as_float(rr[0]), __uint_as_float(rr[1])); }
__device__ __forceinline__ float swap_sum(float x) { auto rr = __builtin_amdgcn_permlane32_swap(__float_as_uint(x), __float_as_uint(x), false, false); return __uint_as_float(rr[0]) + __uint_as_float(rr[1]); }
__device__ __forceinline__ int lane_now() { int l; asm volatile("v_mbcnt_lo_u32_b32 %0, -1, 0\n\tv_mbcnt_hi_u32_b32 %0, -1, %0" : "=v"(l)); return l; }
__device__ __forceinline__ int opaque_tid(int wv) { return (wv << 6) | lane_now(); }
__device__ __forceinline__ float wave_sum(float v) {
    v += __uint_as_float((unsigned)__builtin_amdgcn_ds_swizzle((int)__float_as_uint(v), (1 << 10) | 0x1f));
    v += __uint_as_float((unsigned)__builtin_amdgcn_ds_swizzle((int)__float_as_uint(v), (2 << 10) | 0x1f));
    v += __uint_as_float((unsigned)__builtin_amdgcn_ds_swizzle((int)__float_as_uint(v), (4 << 10) | 0x1f));
    v += __uint_as_float((unsigned)__builtin_amdgcn_ds_swizzle((int)__float_as_uint(v), (8 << 10) | 0x1f));
    v += __uint_as_float((unsigned)__builtin_amdgcn_ds_swizzle((int)__float_as_uint(v), (16 << 10) | 0x1f));
    return swap_sum(v);
}
__device__ __forceinline__ int opaque_lane() { return lane_now(); }
__device__ __forceinline__ int brow_of(int row) { return row < 32768 ? (row >> 14) : 2 + ((row - 32768) >> 13); }
__device__ __forceinline__ int crow(int r, int hi) { return (r & 3) + 8 * (r >> 2) + 4 * hi; }

namespace pg8 {
constexpr float ROPE_C0[8] = {1.5915494309e-01f, 3.0863763405e-02f, 5.9851857127e-03f, 1.1606636412e-03f, 2.2507907904e-04f, 4.3647952793e-05f, 8.4643308082e-06f, 1.6414262628e-06f};
constexpr float ROPE_C1[8] = {3.7183271576e-01f, 9.5056171580e-01f, 7.6610377123e-01f, 1.4856494608e-01f, 2.8810122117e-02f, 5.5869379575e-03f, 1.0834343435e-03f, 2.1010256164e-04f};
constexpr int BM = 256, BK = 64, HALF = 128, HTB = HALF * BK * 2, STAGE_BYTES = 8 * HTB, NXCD = 8, WGM = 4;
__host__ __device__ __forceinline__ int lds_byte(int r, int c) { const int st = (r >> 4) * 2 + (c >> 5), rr = r & 15, cc = c & 31, ob = rr * 64 + cc * 2; return st * 1024 + (ob ^ (((ob >> 9) & 1) << 5)); }
__host__ __device__ __forceinline__ void stage_rc(int b, int& R, int& C) { const int st = b / 1024, sb = b % 1024, swz = sb ^ (((sb >> 9) & 1) << 5); R = (st >> 1) * 16 + swz / 64; C = (st & 1) * 32 + (swz % 64) / 2; }
__host__ __device__ __forceinline__ int perm32(int rho) { const int n = rho >> 4, i = rho & 15; return 8 * (i >> 2) + 4 * n + (i & 3); }
__host__ __device__ __forceinline__ size_t atile_off(int r, int k, int nkt) { return ((size_t)((r >> 8) * nkt + (k >> 6)) * 2 + ((r >> 7) & 1)) * 16384 + lds_byte(r & 127, k & 63); }
__host__ __device__ __forceinline__ size_t wtile_off(int v, int k, int nkt) {
    const int rb = v & 127, s = rb & 31, rho = 16 * ((s >> 2) & 1) + 4 * (s >> 3) + (s & 3), R = (rb & ~31) + rho;
    return ((size_t)((v >> 8) * nkt + (k >> 6)) * 2 + ((v >> 7) & 1)) * 16384 + lds_byte(R, k & 63);
}

struct Unit { int pm, pn, pz; const char* a; const char* b; };

__device__ __forceinline__ bool tile_of(int nM, int nN, int G, int c, int i, int& pm, int& pn, int wgm = WGM) {
    const int nwg = nM * nN; const long L = (long)i * G + c; if (L >= nwg) return false;
    int wgid = (int)L; { const int q = nwg / NXCD, r = nwg % NXCD, xcd = wgid % NXCD, off = wgid / NXCD; wgid = (xcd < r ? xcd * (q + 1) : r * (q + 1) + (xcd - r) * q) + off; }
    const int nig = wgm * nN, gid = wgid / nig, fm = gid * wgm, gsz = (nM - fm) < wgm ? (nM - fm) : wgm;
    pm = fm + ((wgid % nig) % gsz); pn = (wgid % nig) / gsz; return true;
}
struct PlainOrder {
    const char* A; const char* Bt; int nM, nN, G, c, wgm; size_t tA, tB; bool atile;
    __device__ __forceinline__ void init(const void* A_, const void* Bt_, int M, int N, int lda, int ldb, int G_, int c_, int wgm_ = WGM) { A = (const char*)A_; Bt = (const char*)Bt_; nM = M / BM; nN = N / BM; G = G_; c = c_; wgm = wgm_; tA = (size_t)BM * lda * 2; tB = (size_t)BM * ldb * 2; atile = true; }
    __device__ __forceinline__ bool next(int i, Unit& u) const { int pm, pn; if (!tile_of(nM, nN, G, c, i, pm, pn, wgm)) return false; u.pm = pm; u.pn = pn; u.pz = 0; u.a = A + (size_t)pm * tA; u.b = Bt + (size_t)pn * tB; return true; }
};
struct MergeOrder {
    const char* A; const char* Bt; int G, c; static constexpr bool atile = false;
    __device__ __forceinline__ bool next(int i, Unit& u) const { int pm, pn; if (!tile_of(64, 8, G, c, i >> 1, pm, pn)) return false; u.pm = pm; u.pn = pn; u.pz = i & 1;
        u.a = A + (size_t)pm * (32 * 32768) + (size_t)(i & 1) * 16384; u.b = Bt + (size_t)pn * (256 * 2048 * 2); return true; }
};

template <class Epi, class Sched, bool HM = false>
__device__ __forceinline__ void gemm_phase(LAS unsigned char* lds, const int K, const int lda, const int ldb, const Sched& S, const Epi& E, const int wv) {
    const int tid = opaque_tid(wv), wid = __builtin_amdgcn_readfirstlane(tid >> 6), lane = tid & 63, wr = wid >> 2, wc = wid & 3, fr = lane & 15, fq = lane >> 4;
    const int nt = K / BK;
    unsigned voffA[2], voffB[2];
#pragma unroll
    for (int i = 0; i < 2; ++i) { int R, C; stage_rc(tid * 16 + i * 8192, R, C); const int Rb = Epi::PERM ? ((R & ~31) + perm32(R & 31)) : R;
        voffA[i] = S.atile ? (unsigned)(tid * 16 + i * 8192) : (unsigned)(R * lda + C) * 2u; voffB[i] = (unsigned)(tid * 16 + i * 8192); (void)Rb; }
    const size_t kstep = S.atile ? (size_t)(2 * HTB) : (size_t)(BK * 2), kstepB = (size_t)(2 * HTB);
    const size_t hstepA = HM ? (size_t)0 : (S.atile ? (size_t)HTB : (size_t)HALF * lda * 2), hstepB = (size_t)HTB;
    const unsigned ldsw = (unsigned)wid * 1024u;
    const int aoff = lds_byte(wr * 64 + fr, fq * 8), boff = lds_byte(wc * 32 + fr, fq * 8);
#define PG8_SA(b, h) (((b) * 2 + (h)) * HTB)
#define PG8_SB(b, h) ((4 + (b) * 2 + (h)) * HTB)
#define PG8_STAGE(bufoff, gbase, voff) do { _Pragma("unroll") for (int _i = 0; _i < 2; ++_i) \
        __builtin_amdgcn_global_load_lds((const unsigned*)((const char*)(gbase) + (voff)[_i]), (LAS unsigned*)(lds + (bufoff) + ldsw + _i * 8192), 16, 0, 0); } while (0)
#define PG8_LDA(dst, b, h) do { _Pragma("unroll") for (int m = 0; m < 4; ++m) _Pragma("unroll") for (int k = 0; k < 2; ++k) dst[m][k] = *(const LAS bf16x8*)(lds + PG8_SA(b, h) + aoff + m * 2048 + k * 1024); } while (0)
#define PG8_LDB(dst, b, h) do { _Pragma("unroll") for (int n = 0; n < 2; ++n) _Pragma("unroll") for (int k = 0; k < 2; ++k) dst[n][k] = *(const LAS bf16x8*)(lds + PG8_SB(b, h) + boff + n * 2048 + k * 1024); } while (0)
#define PG8_MMA(ai, bj, At, Bt) do { __builtin_amdgcn_s_setprio(1); _Pragma("unroll") for (int m = 0; m < 4; ++m) _Pragma("unroll") for (int n = 0; n < 2; ++n) _Pragma("unroll") for (int k = 0; k < 2; ++k) \
        acc[ai][bj][m][n] = __builtin_amdgcn_mfma_f32_16x16x32_bf16(Bt[n][k], At[m][k], acc[ai][bj][m][n], 0, 0, 0); __builtin_amdgcn_s_setprio(0); } while (0)
#define PG8_WAIT_V(n) asm volatile("s_waitcnt vmcnt(" #n ")" ::: "memory")
#define PG8_WAIT_L(n) asm volatile("s_waitcnt lgkmcnt(" #n ")" ::: "memory")
#define PG8_BAR __builtin_amdgcn_s_barrier()
#define PG8_SCHED __builtin_amdgcn_sched_barrier(0)
    Unit cur, nxt; int ui = 0;
    if (!S.next(0, cur)) return;
    f32x4 acc[2][2][4][2];
#pragma unroll
    for (int a = 0; a < 2; ++a)
#pragma unroll
        for (int b = 0; b < 2; ++b)
#pragma unroll
            for (int m = 0; m < 4; ++m)
#pragma unroll
                for (int n = 0; n < 2; ++n) acc[a][b][m][n] = (f32x4){0.f, 0.f, 0.f, 0.f};
    bf16x8 At[4][2], B0[2][2], B1[2][2];
    const char* cA = cur.a; const char* cB = cur.b;
    PG8_STAGE(PG8_SB(0, 0), cB, voffB); PG8_STAGE(PG8_SB(0, 1), cB + hstepB, voffB); PG8_STAGE(PG8_SA(0, 0), cA, voffA); PG8_STAGE(PG8_SA(0, 1), cA + hstepA, voffA);
    if (wr == 1) PG8_BAR;
    PG8_WAIT_V(2); PG8_BAR;
    PG8_STAGE(PG8_SB(1, 0), cB + kstepB, voffB); PG8_STAGE(PG8_SA(1, 0), cA + kstep, voffA); PG8_STAGE(PG8_SB(1, 1), cB + hstepB + kstepB, voffB);
    PG8_WAIT_V(6); PG8_BAR;
    for (;;) {
        const bool has_next = S.next(ui + 1, nxt);
        const char* nA = has_next ? nxt.a : cA; const char* nB = has_next ? nxt.b : cB;
        for (int t = 0; t < nt; t += 2) {
            const bool last = (t == nt - 2);
            const char* a1 = cA + (size_t)(t + 1) * kstep;
            const char* a2 = last ? nA : cA + (size_t)(t + 2) * kstep; const char* b2 = last ? nB : cB + (size_t)(t + 2) * kstepB;
            const char* a3 = a2 + kstep; const char* b3 = b2 + kstepB;
            PG8_LDB(B0, 0, 0); PG8_LDB(B1, 0, 1); PG8_SCHED; PG8_LDA(At, 0, 0); PG8_STAGE(PG8_SA(1, 1), a1 + hstepA, voffA);
            PG8_WAIT_V(8); PG8_WAIT_L(0); PG8_BAR; PG8_MMA(0, 0, At, B0); PG8_MMA(0, 1, At, B1); PG8_BAR; PG8_SCHED;
            if constexpr (!HM) PG8_LDA(At, 0, 1); PG8_STAGE(PG8_SB(0, 0), b2, voffB); PG8_STAGE(PG8_SB(0, 1), b2 + hstepB, voffB); PG8_STAGE(PG8_SA(0, 0), a2, voffA);
            PG8_WAIT_V(8); PG8_WAIT_L(0); PG8_BAR; if constexpr (!HM) { PG8_MMA(1, 0, At, B0); PG8_MMA(1, 1, At, B1); } PG8_BAR; PG8_SCHED;
            PG8_LDB(B0, 1, 0); PG8_LDB(B1, 1, 1); PG8_SCHED; PG8_LDA(At, 1, 0); PG8_STAGE(PG8_SA(0, 1), a2 + hstepA, voffA);
            PG8_WAIT_V(8); PG8_WAIT_L(0); PG8_BAR; PG8_MMA(0, 0, At, B0); PG8_MMA(0, 1, At, B1); PG8_BAR; PG8_SCHED;
            if constexpr (!HM) PG8_LDA(At, 1, 1); PG8_STAGE(PG8_SB(1, 0), b3, voffB); PG8_STAGE(PG8_SB(1, 1), b3 + hstepB, voffB); PG8_STAGE(PG8_SA(1, 0), a3, voffA);
            PG8_WAIT_V(8); PG8_WAIT_L(0); PG8_BAR; if constexpr (!HM) { PG8_MMA(1, 0, At, B0); PG8_MMA(1, 1, At, B1); } PG8_BAR; PG8_SCHED;
            if constexpr (HM) { if (((t + 2) & 7) == 0) E.fold(acc, cur, t >> 3, wr, wc, fr, fq); }
        }
        if (wr == 0) PG8_BAR;
        E(acc, cur, wr, wc, fr, fq);
        if (!has_next) break;
#pragma unroll
        for (int a = 0; a < 2; ++a)
#pragma unroll
            for (int b = 0; b < 2; ++b)
#pragma unroll
                for (int m = 0; m < 4; ++m)
#pragma unroll
                    for (int n = 0; n < 2; ++n) acc[a][b][m][n] = (f32x4){0.f, 0.f, 0.f, 0.f};
        cur = nxt; cA = nA; cB = nB; ++ui;
        if (wr == 1) PG8_BAR;
    }
    PG8_WAIT_V(0);
    PG8_BAR;
#undef PG8_SA
#undef PG8_SB
#undef PG8_STAGE
#undef PG8_LDA
#undef PG8_LDB
#undef PG8_MMA
#undef PG8_WAIT_V
#undef PG8_WAIT_L
#undef PG8_BAR
#undef PG8_SCHED
}

template <class Epi, class Sched>
__device__ __forceinline__ void gemm_hm3(LAS unsigned char* lds, const int K, const int lda, const int ldb, const Sched& S, const Epi& E, const int wv) {
    const int tid = opaque_tid(wv), wid = __builtin_amdgcn_readfirstlane(tid >> 6), lane = tid & 63, wr = wid >> 2, wc = wid & 3, fr = lane & 15, fq = lane >> 4;
    const int nt = K / BK;
    unsigned voffA[2], voffB[2];
#pragma unroll
    for (int i = 0; i < 2; ++i) { int R, C; stage_rc(tid * 16 + i * 8192, R, C); const int Rb = Epi::PERM ? ((R & ~31) + perm32(R & 31)) : R;
        voffA[i] = (unsigned)(tid * 16 + i * 8192); voffB[i] = voffA[i]; (void)R; (void)C; (void)Rb; }
    const size_t kstep = (size_t)(2 * HTB), kstepB = (size_t)(2 * HTB), hstepB = (size_t)HTB;
    const unsigned ldsw = (unsigned)wid * 1024u;
    const int aoff = lds_byte(wr * 64 + fr, fq * 8), boff = lds_byte(wc * 32 + fr, fq * 8);
    constexpr int SLOT = 3 * HTB;
#define H3_STAGE(off, gbase, voff) do { _Pragma("unroll") for (int _i = 0; _i < 2; ++_i) \
        __builtin_amdgcn_global_load_lds((const unsigned*)((const char*)(gbase) + (voff)[_i]), (LAS unsigned*)(lds + (off) + ldsw + _i * 8192), 16, 0, 0); } while (0)
#define H3_STAGE3(sl, ga, gb) do { H3_STAGE((sl), (gb), voffB); H3_STAGE((sl) + HTB, (gb) + hstepB, voffB); H3_STAGE((sl) + 2 * HTB, (ga), voffA); } while (0)
#define H3_LDA(dst, sl) do { _Pragma("unroll") for (int m = 0; m < 4; ++m) _Pragma("unroll") for (int k = 0; k < 2; ++k) dst[m][k] = *(const LAS bf16x8*)(lds + (sl) + 2 * HTB + aoff + m * 2048 + k * 1024); } while (0)
#define H3_LDB(dst, sl, h) do { _Pragma("unroll") for (int n = 0; n < 2; ++n) _Pragma("unroll") for (int k = 0; k < 2; ++k) dst[n][k] = *(const LAS bf16x8*)(lds + (sl) + (h) * HTB + boff + n * 2048 + k * 1024); } while (0)
#define H3_MMA(bj, At, Bt) do { __builtin_amdgcn_s_setprio(1); _Pragma("unroll") for (int m = 0; m < 4; ++m) _Pragma("unroll") for (int n = 0; n < 2; ++n) _Pragma("unroll") for (int k = 0; k < 2; ++k) \
        acc[0][bj][m][n] = __builtin_amdgcn_mfma_f32_16x16x32_bf16(Bt[n][k], At[m][k], acc[0][bj][m][n], 0, 0, 0); __builtin_amdgcn_s_setprio(0); } while (0)
#define H3_BAR __builtin_amdgcn_s_barrier()
    Unit cur, nxt; int ui = 0;
    if (!S.next(0, cur)) return;
    f32x4 acc[2][2][4][2];
#pragma unroll
    for (int a = 0; a < 2; ++a)
#pragma unroll
        for (int b = 0; b < 2; ++b)
#pragma unroll
            for (int m = 0; m < 4; ++m)
#pragma unroll
                for (int n = 0; n < 2; ++n) acc[a][b][m][n] = (f32x4){0.f, 0.f, 0.f, 0.f};
    bf16x8 At[4][2], B0[2][2], B1[2][2]; u32x2 gw[4][2];
    const char* cA = cur.a; const char* cB = cur.b;
    int sl = 0, sl2 = 2 * SLOT;
    H3_STAGE3(0, cA, cB); H3_STAGE3(SLOT, cA + kstep, cB + kstepB);
    asm volatile("s_waitcnt vmcnt(6)" ::: "memory"); H3_BAR;
    if (wr == 1) H3_BAR;
    for (;;) {
        const bool has_next = S.next(ui + 1, nxt);
        const char* nA = has_next ? nxt.a : cA; const char* nB = has_next ? nxt.b : cB;
        for (int t = 0; t < nt; ++t) {
            const bool own = (t + 2 < nt);
            const char* a2 = (own ? cA : nA) + (size_t)(own ? t + 2 : t + 2 - nt) * kstep; const char* b2 = (own ? cB : nB) + (size_t)(own ? t + 2 : t + 2 - nt) * kstepB;
            H3_LDB(B0, sl, 0); H3_LDB(B1, sl, 1); __builtin_amdgcn_sched_barrier(0); H3_LDA(At, sl); H3_STAGE3(sl2, a2, b2);
            const int ph_ = t & 7;
            if (ph_ == 6) { E.fold_load(gw, cur, t >> 3, wr, wc, fr, fq); __builtin_amdgcn_sched_barrier(0); }
            if (ph_ >= 6) asm volatile("s_waitcnt vmcnt(14)" ::: "memory"); else asm volatile("s_waitcnt vmcnt(6)" ::: "memory");
            asm volatile("s_waitcnt lgkmcnt(0)" ::: "memory"); H3_BAR; H3_MMA(0, At, B0); H3_MMA(1, At, B1); H3_BAR; __builtin_amdgcn_sched_barrier(0);
            sl = (sl == 2 * SLOT) ? 0 : sl + SLOT; sl2 = (sl2 == 2 * SLOT) ? 0 : sl2 + SLOT;
            if (ph_ == 7) E.fold_apply(acc, gw, t >> 3);
        }
        if (wr == 0) H3_BAR;
        E(acc, cur, wr, wc, fr, fq);
        if (!has_next) break;
#pragma unroll
        for (int a = 0; a < 2; ++a)
#pragma unroll
            for (int b = 0; b < 2; ++b)
#pragma unroll
                for (int m = 0; m < 4; ++m)
#pragma unroll
                    for (int n = 0; n < 2; ++n) acc[a][b][m][n] = (f32x4){0.f, 0.f, 0.f, 0.f};
        cur = nxt; cA = nA; cB = nB; ++ui;
        if (wr == 1) H3_BAR;
    }
    asm volatile("s_waitcnt vmcnt(0)" ::: "memory");
    H3_BAR;
#undef H3_STAGE
#undef H3_STAGE3
#undef H3_LDA
#undef H3_LDB
#undef H3_MMA
#undef H3_BAR
}

__device__ __forceinline__ float silu_f(float a) { return a * __builtin_amdgcn_rcpf(1.0f + __builtin_amdgcn_exp2f(-a * LOG2E)); }
__device__ __forceinline__ float sigm_f(float a) { return __builtin_amdgcn_rcpf(1.0f + __builtin_amdgcn_exp2f(-a * LOG2E)); }
__device__ __forceinline__ unsigned gq8(float g) { return (unsigned)(g * 255.0f + 0.5f); }
__device__ __forceinline__ unsigned gq8x4(float a, float b, float c, float d) { return gq8(a) | (gq8(b) << 8) | (gq8(c) << 16) | (gq8(d) << 24); }

struct EpiSwiGLU {
    static constexpr bool PERM = true;
    bf16_t* O; const float* ss; const float* bwl;
    __device__ __forceinline__ void operator()(const f32x4 (&acc)[2][2][4][2], const Unit& u, int wr, int wc, int fr, int fq) const {
        const int row0 = u.pm * BM + wr * 64 + fr, col0 = u.pn * 128 + wc * 32 + 8 * fq;
        const float* bw = bwl + (size_t)brow_of(u.pm * BM) * BWL + u.pn * BM + wc * 32 + 8 * fq;
        const f32x4 ba0 = *(const f32x4*)bw, ba1 = *(const f32x4*)(bw + 4), bb0 = *(const f32x4*)(bw + HALF), bb1 = *(const f32x4*)(bw + HALF + 4);
        float rsv[2][4];
#pragma unroll
        for (int ai = 0; ai < 2; ++ai)
#pragma unroll
            for (int m = 0; m < 4; ++m) rsv[ai][m] = ss[row0 + ai * HALF + m * 16];
#pragma unroll
        for (int ai = 0; ai < 2; ++ai)
#pragma unroll
            for (int m = 0; m < 4; ++m) rsv[ai][m] = __builtin_amdgcn_rsqf(rsv[ai][m] * (1.0f / DM) + EPS);
#pragma unroll
        for (int ai = 0; ai < 2; ++ai)
#pragma unroll
            for (int m = 0; m < 4; ++m) { const int row = row0 + ai * HALF + m * 16; const float rs = rsv[ai][m];
                const f32x4 a0 = acc[ai][0][m][0] * rs + ba0, a1 = acc[ai][0][m][1] * rs + ba1, b0 = acc[ai][1][m][0] * rs + bb0, b1 = acc[ai][1][m][1] * rs + bb1;
                u32x4 w;
                w.x = pk2(silu_f(a0[0]) * b0[0], silu_f(a0[1]) * b0[1]); w.y = pk2(silu_f(a0[2]) * b0[2], silu_f(a0[3]) * b0[3]);
                w.z = pk2(silu_f(a1[0]) * b1[0], silu_f(a1[1]) * b1[1]); w.w = pk2(silu_f(a1[2]) * b1[2], silu_f(a1[3]) * b1[3]);
                __builtin_nontemporal_store(w, (u32x4*)((char*)O + atile_off(row, col0, DFF / 64)));
            }
    }
};
struct EpiResid {
    static constexpr bool PERM = true;
    const float* base_p; const float* base_s;
    float* xf; float* out;
    const float* mod_l; int gofs; float coef; int rowbase;
    bf16_t* xa; const float* atab; float* ssn;
    __device__ __forceinline__ void operator()(const f32x4 (&acc)[2][2][4][2], const Unit& u, int wr, int wc, int fr, int fq) const {
        const int rabs0 = rowbase + u.pm * BM; const int br = brow_of(rabs0);
        const float* base = rabs0 < 32768 ? base_p : base_s;
        const float* g = mod_l + (size_t)br * NMODC + gofs;
        const int row0 = rabs0 + wr * 64 + fr, col0 = u.pn * BM + wc * 32 + 8 * fq;
        float* xt = xf + ((size_t)((rabs0 >> 8) * 8 + u.pn) << 16) + ((wr * 4 + wc) * 64 + fq * 16 + fr) * 4;
        f32x4 gv[2][2], av[2][2];
#pragma unroll
        for (int bj = 0; bj < 2; ++bj)
#pragma unroll
            for (int n = 0; n < 2; ++n) { gv[bj][n] = *(const f32x4*)(g + col0 + bj * HALF + n * 4) * coef; av[bj][n] = xa ? *(const f32x4*)(atab + (size_t)br * DM + col0 + bj * HALF + n * 4) : (f32x4){0.f, 0.f, 0.f, 0.f}; }
#pragma unroll
        for (int aq = 0; aq < 4; ++aq) { const int ai = aq >> 1, mb = (aq & 1) * 2;
            f32x4 bs[2][2][2];
#pragma unroll
            for (int mi = 0; mi < 2; ++mi) { const size_t off = (size_t)(row0 + ai * HALF + (mb + mi) * 16) * DM + col0; const int pc = ((ai * 4 + mb + mi) * 2) * 2;
#pragma unroll
                for (int bj = 0; bj < 2; ++bj)
#pragma unroll
                    for (int n = 0; n < 2; ++n) bs[mi][bj][n] = base_p ? __builtin_nontemporal_load((const f32x4*)(base + off + bj * HALF + n * 4)) : *(const f32x4*)(xt + (pc + bj * 2 + n) * 2048); }
#pragma unroll
            for (int mi = 0; mi < 2; ++mi) { const int m = mb + mi; const size_t off = (size_t)(row0 + ai * HALF + m * 16) * DM + col0; const int pc = ((ai * 4 + m) * 2) * 2; float sq = 0.f;
#pragma unroll
                for (int bj = 0; bj < 2; ++bj) { const f32x4 x0 = bs[mi][bj][0] + gv[bj][0] * acc[ai][bj][m][0], x1 = bs[mi][bj][1] + gv[bj][1] * acc[ai][bj][m][1];
                    if (out) { __builtin_nontemporal_store(x0, (f32x4*)(out + off + bj * HALF)); __builtin_nontemporal_store(x1, (f32x4*)(out + off + bj * HALF + 4)); }
                    else { __builtin_nontemporal_store(x0, (f32x4*)(xt + (pc + bj * 2) * 2048)); __builtin_nontemporal_store(x1, (f32x4*)(xt + (pc + bj * 2 + 1) * 2048)); }
                    if (xa) { const f32x4 y0 = x0 * av[bj][0], y1 = x1 * av[bj][1]; u32x4 w; w.x = pk2(y0[0], y0[1]); w.y = pk2(y0[2], y0[3]); w.z = pk2(y1[0], y1[1]); w.w = pk2(y1[2], y1[3]);
                              __builtin_nontemporal_store(w, (u32x4*)((char*)xa + atile_off(row0 + ai * HALF + m * 16, col0 + bj * HALF, DM / 64)));
                              sq += ((x0[0] * x0[0] + x0[1] * x0[1]) + (x0[2] * x0[2] + x0[3] * x0[3])) + ((x1[0] * x1[0] + x1[1] * x1[1]) + (x1[2] * x1[2] + x1[3] * x1[3])); } }
                if (xa) {
                    sq += __uint_as_float((unsigned)__builtin_amdgcn_ds_swizzle((int)__float_as_uint(sq), (16 << 10) | 0x1f)); sq = swap_sum(sq);
                    if (fq == 0) atomicAdd(ssn + row0 + ai * HALF + m * 16, sq); } }
        }
    }
};
struct EpiInProj {
    static constexpr bool PERM = true;
    bf16_t* Z; bf16_t* G; const float* bgate; int tmask; const float* ss; const float* bw; int rowbase;
    __device__ __forceinline__ void operator()(const f32x4 (&acc)[2][2][4][2], const Unit& u, int wr, int wc, int fr, int fq) const {
        const int row0 = u.pm * BM + wr * 64 + fr;
        const float* bwp = bw + (size_t)brow_of(rowbase + u.pm * BM) * BWL + u.pn * BM + wc * 32 + 8 * fq;
        const f32x4 bq00 = *(const f32x4*)bwp, bq01 = *(const f32x4*)(bwp + 4), bq10 = *(const f32x4*)(bwp + HALF), bq11 = *(const f32x4*)(bwp + HALF + 4);
        float rsv[2][4];
#pragma unroll
        for (int ai = 0; ai < 2; ++ai)
#pragma unroll
            for (int m = 0; m < 4; ++m) rsv[ai][m] = ss[rowbase + row0 + ai * HALF + m * 16];
#pragma unroll
        for (int ai = 0; ai < 2; ++ai)
#pragma unroll
            for (int m = 0; m < 4; ++m) rsv[ai][m] = __builtin_amdgcn_rsqf(rsv[ai][m] * (1.0f / DM) + EPS);
        if (u.pn < 32) {
            const int col0 = u.pn * BM + wc * 32 + 8 * fq;
            const bool ropet = (u.pn >= 8 && u.pn < 12) || (u.pn >= 14 && u.pn < 26);
            const bool rot = ropet && ((wc & 1) == 0) && (fq < 2);
            float rc0[4] = {0.f, 0.f, 0.f, 0.f}, rc1[4] = {0.f, 0.f, 0.f, 0.f};
            if (rot) {
#pragma unroll
                for (int e = 0; e < 4; ++e) { rc0[e] = fq ? ROPE_C0[4 + e] : ROPE_C0[e]; rc1[e] = fq ? ROPE_C1[4 + e] : ROPE_C1[e]; } }
#pragma unroll
            for (int ai = 0; ai < 2; ++ai)
#pragma unroll
                for (int m = 0; m < 4; ++m) { const int row = row0 + ai * HALF + m * 16; const float rs = rsv[ai][m];
                    float cc[4] = {1.f, 1.f, 1.f, 1.f}, sn[4] = {0.f, 0.f, 0.f, 0.f};
                    if (rot) { const int pos = row & tmask; const float ph = (float)(pos >> 7), pl = (float)(pos & 127);
#pragma unroll
                        for (int e = 0; e < 4; ++e) { const float c0 = rc0[e], c1 = rc1[e];
                            float rev = ph * c1 + pl * c0; rev = rev - __builtin_floorf(rev); cc[e] = __builtin_amdgcn_cosf(rev); sn[e] = __builtin_amdgcn_sinf(rev); } }
#pragma unroll
                    for (int bj = 0; bj < 2; ++bj) { f32x4 v0 = acc[ai][bj][m][0] * rs + (bj ? bq10 : bq00), v1 = acc[ai][bj][m][1] * rs + (bj ? bq11 : bq01);
                        if (u.pn == 2 || u.pn == 3 || u.pn == 8 || u.pn == 9 || (u.pn >= 14 && u.pn < 20)) { v0 *= C2; v1 *= C2; }
                        if (rot) {
#pragma unroll
                            for (int e = 0; e < 4; ++e) { const float x1 = v0[e], x2 = v1[e]; v0[e] = x1 * cc[e] - x2 * sn[e]; v1[e] = x2 * cc[e] + x1 * sn[e]; } }
                        u32x4 w; w.x = pk2(v0[0], v0[1]); w.y = pk2(v0[2], v0[3]); w.z = pk2(v1[0], v1[1]); w.w = pk2(v1[2], v1[3]);
                        __builtin_nontemporal_store(w, (u32x4*)(Z + zoff(row, col0 + bj * HALF))); } }
        } else {
            const int col0 = (u.pn - 32) * BM + wc * 32 + 8 * fq;
            f32x4 bv[2][2];
#pragma unroll
            for (int bj = 0; bj < 2; ++bj)
#pragma unroll
                for (int n = 0; n < 2; ++n) bv[bj][n] = *(const f32x4*)(bgate + col0 + bj * HALF + 4 * n);
#pragma unroll
            for (int ai = 0; ai < 2; ++ai)
#pragma unroll
                for (int m = 0; m < 4; ++m) { const int row = row0 + ai * HALF + m * 16; const float rs = rsv[ai][m];
#pragma unroll
                    for (int bj = 0; bj < 2; ++bj) { const f32x4 v0 = acc[ai][bj][m][0] * rs + (bv[bj][0] + (bj ? bq10 : bq00)), v1 = acc[ai][bj][m][1] * rs + (bv[bj][1] + (bj ? bq11 : bq01));
                        u32x2 w; w.x = gq8x4(sigm_f(v0[0]), sigm_f(v0[1]), sigm_f(v0[2]), sigm_f(v0[3])); w.y = gq8x4(sigm_f(v1[0]), sigm_f(v1[1]), sigm_f(v1[2]), sigm_f(v1[3]));
                        __builtin_nontemporal_store(w, (u32x2*)((unsigned char*)G + ((size_t)(u.pm * 32 + (u.pn - 32)) << 16) + ai * 32768 + (m * 2 + bj) * 4096 + (wr * 4 + wc) * 512 + (fq * 16 + fr) * 8)); } }
        }
    }
};
struct EpiMerge {
    static constexpr bool PERM = true;
    const bf16_t* G; bf16_t* Mg;
    __device__ __forceinline__ void fold_load(u32x2 (&gw)[4][2], const Unit& u, int n, int wr, int wc, int fr, int fq) const {
        const int row0 = u.pm * BM + u.pz * HALF + wr * 64 + fr, col0 = u.pn * BM + wc * 32 + 8 * fq;
#pragma unroll
        for (int m = 0; m < 4; ++m)
#pragma unroll
            for (int bj = 0; bj < 2; ++bj) gw[m][bj] = __builtin_nontemporal_load((const u32x2*)((const unsigned char*)G + ((size_t)(u.pm * 32 + n * 8 + u.pn) << 16) + u.pz * 32768 + (m * 2 + bj) * 4096 + (wr * 4 + wc) * 512 + (fq * 16 + fr) * 8));
    }
    __device__ __forceinline__ void fold_apply(f32x4 (&acc)[2][2][4][2], const u32x2 (&gw)[4][2], int n) const {
#pragma unroll
        for (int m = 0; m < 4; ++m)
#pragma unroll
            for (int bj = 0; bj < 2; ++bj) { const u32x2 g = gw[m][bj]; f32x4& v0 = acc[0][bj][m][0]; f32x4& v1 = acc[0][bj][m][1];
                const f32x4 g0 = (f32x4){(float)(g.x & 255u), (float)((g.x >> 8) & 255u), (float)((g.x >> 16) & 255u), (float)(g.x >> 24)} * (1.0f / 255.0f);
                const f32x4 g1 = (f32x4){(float)(g.y & 255u), (float)((g.y >> 8) & 255u), (float)((g.y >> 16) & 255u), (float)(g.y >> 24)} * (1.0f / 255.0f);
                if (n == 0) { acc[1][bj][m][0] = g0 * v0; acc[1][bj][m][1] = g1 * v1; }
                else { acc[1][bj][m][0] += g0 * v0; acc[1][bj][m][1] += g1 * v1; }
                v0 = (f32x4){0.f, 0.f, 0.f, 0.f}; v1 = (f32x4){0.f, 0.f, 0.f, 0.f}; }
    }
    __device__ __forceinline__ void fold(f32x4 (&acc)[2][2][4][2], const Unit& u, int n, int wr, int wc, int fr, int fq) const { u32x2 gw[4][2]; fold_load(gw, u, n, wr, wc, fr, fq); fold_apply(acc, gw, n); }
    __device__ __forceinline__ void operator()(const f32x4 (&acc)[2][2][4][2], const Unit& u, int wr, int wc, int fr, int fq) const {
        const int row0 = u.pm * BM + u.pz * HALF + wr * 64 + fr, col0 = u.pn * BM + wc * 32 + 8 * fq;
#pragma unroll
        for (int m = 0; m < 4; ++m)
#pragma unroll
            for (int bj = 0; bj < 2; ++bj) { const f32x4 v0 = acc[1][bj][m][0], v1 = acc[1][bj][m][1];
                u32x4 w; w.x = pk2(v0[0], v0[1]); w.y = pk2(v0[2], v0[3]); w.z = pk2(v1[0], v1[1]); w.w = pk2(v1[2], v1[3]);
                __builtin_nontemporal_store(w, (u32x4*)((char*)Mg + atile_off(row0 + m * 16, col0 + bj * HALF, DM / 64))); }
    }
};
}

#define XB_TMO      128
#define XB_XCNT(j)  (256  + 64 * (j))
#define XB_XSUB(j)  (1280 + 64 * (j))
#define XB_XGEN(j)  (2304 + 64 * (j))
#define XB_TOP      3328
#define XB_TOPGEN   3392
#define XCD_BAR_WORDS 3456
#define XB_SPIN_CAP (1u << 24)
__device__ __forceinline__ unsigned xb_ld(unsigned* p)              { return __hip_atomic_load(p, __ATOMIC_RELAXED, __HIP_MEMORY_SCOPE_AGENT); }
__device__ __forceinline__ unsigned xb_add(unsigned* p, unsigned v) { return __hip_atomic_fetch_add(p, v, __ATOMIC_RELAXED, __HIP_MEMORY_SCOPE_AGENT); }
__device__ __forceinline__ unsigned xb_xcc_id() { return (unsigned)__builtin_amdgcn_s_getreg((3 << 11) | 20) & 0xFu; }
#define XB_SPIN(cond, bar) do { unsigned _sp = 0; while (cond) { __builtin_amdgcn_s_sleep(1); \
    if ((++_sp & 255u) == 0u) { if (xb_ld(&(bar)[XB_TMO])) break; if (_sp > XB_SPIN_CAP) { atomicAdd(&(bar)[XB_TMO], 1u); break; } } } } while (0)
struct XcdBarrier { unsigned* bar; unsigned x; volatile LAS unsigned* st; int wv; };
__device__ __forceinline__ XcdBarrier xcd_barrier_post(unsigned* bar, volatile LAS unsigned* st, int wv) {
    XcdBarrier b; b.bar = bar; b.x = xb_xcc_id(); b.st = st; b.wv = wv;
    if (opaque_tid(wv) == 0) (void)xb_add(&bar[XB_XCNT(b.x)], 1u);
    return b;
}
__device__ __forceinline__ void xcd_barrier_complete(unsigned* bar, unsigned x, unsigned& nloc, unsigned& nx) {
    const unsigned G = gridDim.x * gridDim.y * gridDim.z;
    unsigned sum, cnt, mine, sp = 0u;
    for (;;) {
        sum = 0u; cnt = 0u; mine = 0u;
#pragma unroll
        for (unsigned j = 0; j < 16; ++j) { const unsigned c = xb_ld(&bar[XB_XCNT(j)]); sum += c; cnt += (c > 0u) ? 1u : 0u; mine = (j == x) ? c : mine; }
        if (sum == G) break;
        __builtin_amdgcn_s_sleep(1);
        if ((++sp & 255u) == 0u) { if (xb_ld(&bar[XB_TMO])) break; if (sp > XB_SPIN_CAP) { atomicAdd(&bar[XB_TMO], 1u); break; } }
    }
    nloc = mine > 0u ? mine : 1u; nx = cnt > 0u ? cnt : 1u;
}
__device__ __forceinline__ void xcd_barrier(const XcdBarrier& b) {
    asm volatile("s_waitcnt vmcnt(0)" ::: "memory");
    __syncthreads();
    if (opaque_tid(b.wv) == 0) {
        unsigned* bar = b.bar;
        __builtin_amdgcn_s_waitcnt(0);
        unsigned nloc = b.st[0], nx = b.st[1];
        if (nloc == 0u) { xcd_barrier_complete(bar, b.x, nloc, nx); b.st[0] = nloc; b.st[1] = nx; }
        const unsigned old = xb_add(&bar[XB_XSUB(b.x)], 1u);
        const unsigned gen = old / nloc;
        if (old + 1u == (gen + 1u) * nloc) {
            __builtin_amdgcn_fence(__ATOMIC_RELEASE, "agent");
            asm volatile("s_waitcnt vmcnt(0)" ::: "memory");
            const unsigned og = xb_add(&bar[XB_TOP], 1u);
            const unsigned tg = og / nx;
            if (og + 1u == (tg + 1u) * nx) xb_add(&bar[XB_TOPGEN], 1u);
            else XB_SPIN(xb_ld(&bar[XB_TOPGEN]) == tg, bar);
            __builtin_amdgcn_fence(__ATOMIC_ACQUIRE, "agent");
            xb_add(&bar[XB_XGEN(b.x)], 1u);
            asm volatile("s_waitcnt vmcnt(0)" ::: "memory");
        } else {
            XB_SPIN(xb_ld(&bar[XB_XGEN(b.x)]) == gen, bar);
            __builtin_amdgcn_fence(__ATOMIC_ACQUIRE, "agent");
            asm volatile("s_waitcnt vmcnt(0)" ::: "memory");
        }
    }
    __syncthreads();
}

struct Args { const float* in[24]; float* out; unsigned char* ws; int ph_lo, ph_hi, li, pad; };
typedef const __attribute__((address_space(4))) Args KArgs;
__device__ __forceinline__ KArgs* kargs() { KArgs* p = (KArgs*)__builtin_amdgcn_kernarg_segment_ptr(); asm volatile("" : "+s"(p)); return p; }
enum { I_XP = 0, I_XS, I_CP, I_CS, I_WADA, I_BADA, I_GFF1, I_WFF1I, I_WFF1O, I_GMIX, I_WIN, I_BGATE, I_RELB, I_LQ1, I_LK1, I_LQ2, I_LK2, I_DLNG, I_WBR, I_WOUT, I_GFF2, I_WFF2I, I_WFF2O, I_GFIN };

__device__ __forceinline__ int srcmap(int kind, int v) {
    if (kind == 1) return ((v >> 7) & 1) * DFF + (v >> 8) * 128 + (v & 127);
    if (kind == 2) { const int o = v; const bool rp = (o >= 2048 && o < 3072) || (o >= 3584 && o < 6656);
        if (rp && (o & 63) < 16) { const int d = o & 15; const int pd = (d & 3) | ((d & 4) << 1) | ((d & 8) >> 1); return (o & ~15) + pd; }
        return o; }
    return v;
}
__device__ __forceinline__ void conv_tile(const float* src, int ldsrc, bf16_t* dst, int K, int v0, int k0, int kind, LAS float* tile, int tid) {
    __syncthreads();
#pragma unroll
    for (int i = 0; i < 8; ++i) { const int idx = tid + 512 * i, kk = idx >> 6, vv = idx & 63;
        tile[vv * 65 + kk] = src[(size_t)(k0 + kk) * ldsrc + srcmap(kind, v0 + vv)]; }
    __syncthreads();
    const int vv = tid >> 3, kc = tid & 7; const LAS float* s = tile + vv * 65 + kc * 8;
    u32x4 o; o.x = pk2(s[0], s[1]); o.y = pk2(s[2], s[3]); o.z = pk2(s[4], s[5]); o.w = pk2(s[6], s[7]);
    *(u32x4*)((char*)dst + pg8::wtile_off(v0 + vv, k0 + kc * 8, K >> 6)) = o;
}
__device__ __forceinline__ void fold_tile(const float* win_l, bf16_t* dst, int v0, int k0, LAS float* S  , LAS float* tc, LAS float* tsn, int tid) {
    __syncthreads();
    if (tid < 128) { const float x = (float)tid * (1.0f / 128.0f); tc[tid] = __builtin_amdgcn_cosf(x) * 0.08838834764831843f; tsn[tid] = __builtin_amdgcn_sinf(x) * 0.08838834764831843f; }
    const int g = v0 >> 8, isq = (v0 >> 7) & 1, cp0 = v0 & 127;
#pragma unroll
    for (int i = 0; i < 16; ++i) { const int idx = tid + 512 * i, kk = idx >> 7, c = idx & 127;
        S[kk * 129 + c] = win_l[(size_t)(k0 + kk) * 16384 + g * 128 + c]; }
    __syncthreads();
    const int vv = tid >> 3, kc = tid & 7, cp = cp0 + vv; const LAS float* tr = isq ? tsn : tc;
    float o[8] = {0.f, 0.f, 0.f, 0.f, 0.f, 0.f, 0.f, 0.f};
    for (int c = 0; c < 128; ++c) { const float w = tr[(c * cp) & 127];
#pragma unroll
        for (int j = 0; j < 8; ++j) o[j] += S[(kc * 8 + j) * 129 + c] * w; }
    u32x4 ov; ov.x = pk2(o[0], o[1]); ov.y = pk2(o[2], o[3]); ov.z = pk2(o[4], o[5]); ov.w = pk2(o[6], o[7]);
    *(u32x4*)(dst + (size_t)(v0 + vv) * DM + k0 + kc * 8) = ov;
}
__device__ __forceinline__ bf16_t fftm_bf1(float x) { return (bf16_t)(pk2(x, 0.f) & 0xffffu); }
__constant__ double ROPE_INV[8] = {1.0, 0.19392274474868576, 0.03760603093086393, 0.007292664737217109, 0.001414213562373095, 0.0002742481756762073, 5.318295896944988e-05, 1.031338537721246e-05};

__device__ __forceinline__ void ada_task(KArgs& a, int l, int jb, float* mod, LAS float* sc  , LAS float* red  , int tid) {
    __syncthreads();
#pragma unroll 1
    for (int i0 = 0; i0 < 6 * DM; i0 += 8 * 512) {
        float cv[8];
#pragma unroll
        for (int j = 0; j < 8; ++j) { const int i = i0 + j * 512 + tid, br = i >> 11, k = i & 2047; cv[j] = br < 2 ? a.in[I_CP][br * DM + k] : a.in[I_CS][(br - 2) * DM + k]; }
#pragma unroll
        for (int j = 0; j < 8; ++j) sc[i0 + j * 512 + tid] = cv[j] * pg8::sigm_f(cv[j]); }
    __syncthreads();
    const int jq = tid & 7, kp = tid >> 3, j0 = jb * 32;
    const float* w = a.in[I_WADA] + ((size_t)l * DM + kp * 32) * NMODC + j0 + 4 * jq;
    f32x4 acc[6];
#pragma unroll
    for (int br = 0; br < 6; ++br) acc[br] = (f32x4){0.f, 0.f, 0.f, 0.f};
    for (int k = 0; k < 32; ++k) { const f32x4 wv = *(const f32x4*)(w + (size_t)k * NMODC);
#pragma unroll
        for (int br = 0; br < 6; ++br) acc[br] += wv * sc[br * DM + kp * 32 + k]; }
#pragma unroll
    for (int br = 0; br < 6; ++br) *(LAS f32x4*)(red + (kp * 6 + br) * 32 + 4 * jq) = acc[br];
    __syncthreads();
    if (tid < 192) { const int br = tid >> 5, j = tid & 31; float s = a.in[I_BADA][(size_t)l * NMODC + j0 + j];
        for (int k = 0; k < 64; ++k) s += red[(k * 6 + br) * 32 + j];
        mod[((size_t)l * 6 + br) * NMODC + j0 + j] = s; }
}

constexpr int NT_ADA = 2 * 576, NT_FOLD = 0, NT_FFI = 5504, NT_FFO = 2752, NT_IN = 8192, NT_BR = 1024, NT_OUT = 1024;
constexpr int NT_LAYER = 2 * NT_FFI + 2 * NT_FFO + NT_IN + NT_BR + NT_OUT;
constexpr int NT_ROPE = 256, NT_DFT = 40, NT_ZSS = 192, NT_LAM = 1;
constexpr int NT_PRO = NT_ADA + NT_FOLD + 2 * NT_LAYER + NT_ROPE + NT_DFT + NT_ZSS + NT_LAM;

__device__ __forceinline__ void prologue_phase(KArgs& a, LAS unsigned char* lds, int wg, int nwg, int tid) {
    unsigned char* ws = a.ws;
    float* mod = (float*)(ws + WS_MOD);
    LAS float* L = (LAS float*)lds;
    for (int t = wg; t < NT_PRO; t += nwg) {
        int r = t;
        if (r < NT_ADA) { ada_task(a, r / 576, r % 576, mod, L, L + 6 * DM, tid); continue; } r -= NT_ADA;
        if (r < NT_FOLD) { const int l = r >> 9, q = r & 511; fold_tile(a.in[I_WIN] + (size_t)l * DM * 16384, (bf16_t*)(ws + WS_W + l * WLAYER + WO_IN), (q >> 5) * 64, (q & 31) * 64, L, L + 64 * 129, L + 64 * 129 + 128, tid); continue; } r -= NT_FOLD;
        if (r < 2 * NT_LAYER) { const int l = r / NT_LAYER; int q = r % NT_LAYER; unsigned char* wl = ws + WS_W + l * WLAYER;
            if (q < NT_FFI) { conv_tile(a.in[I_WFF1I] + (size_t)l * DM * 11008, 11008, (bf16_t*)(wl + WO_FF1I), DM, (q >> 5) * 64, (q & 31) * 64, 1, L, tid); continue; } q -= NT_FFI;
            if (q < NT_FFI) { conv_tile(a.in[I_WFF2I] + (size_t)l * DM * 11008, 11008, (bf16_t*)(wl + WO_FF2I), DM, (q >> 5) * 64, (q & 31) * 64, 1, L, tid); continue; } q -= NT_FFI;
            if (q < NT_FFO) { conv_tile(a.in[I_WFF1O] + (size_t)l * DFF * DM, DM, (bf16_t*)(wl + WO_FF1O), DFF, (q / 86) * 64, (q % 86) * 64, 0, L, tid); continue; } q -= NT_FFO;
            if (q < NT_FFO) { conv_tile(a.in[I_WFF2O] + (size_t)l * DFF * DM, DM, (bf16_t*)(wl + WO_FF2O), DFF, (q / 86) * 64, (q % 86) * 64, 0, L, tid); continue; } q -= NT_FFO;
            if (q < NT_IN) { conv_tile(a.in[I_WIN] + (size_t)l * DM * 16384, 16384, (bf16_t*)(wl + WO_IN), DM, (q >> 5) * 64, (q & 31) * 64, 2, L, tid); continue; } q -= NT_IN;
            if (q < NT_BR) { const int n = q >> 8, tt = q & 255; conv_tile(a.in[I_WBR] + (size_t)l * 4 * 512 * DM, DM, (bf16_t*)(wl + WO_BR), DM, (tt >> 3) * 64, n * 512 + (tt & 7) * 64, 0, L, tid); continue; } q -= NT_BR;
            conv_tile(a.in[I_WOUT] + (size_t)l * DM * DM, DM, (bf16_t*)(wl + WO_OUT), DM, (q >> 5) * 64, (q & 31) * 64, 0, L, tid); continue; }
        r -= 2 * NT_LAYER;
        if (r < NT_ROPE) { const int idx = r * 512 + tid, pos = idx >> 3, i = idx & 7; double rev = (double)pos * ROPE_INV[i] * 0.15915494309189535; rev -= floor(rev); const float fr = (float)rev;
            float* rp = (float*)(ws + WS_ROPE) + (size_t)idx * 2; rp[0] = __builtin_amdgcn_cosf(fr); rp[1] = __builtin_amdgcn_sinf(fr); continue; } r -= NT_ROPE;
        if (r < NT_DFT) {
            const bool big = r < 32; const int N = big ? 128 : 64, m = (big ? r : r - 32) * 512 + tid, k = m / N, t = m % N;
            const float x = (float)((k * t) & (N - 1)) / (float)N; const float c = __builtin_amdgcn_cosf(x), sn = __builtin_amdgcn_sinf(x);
            bf16_t* dp = (bf16_t*)(ws + WS_DFT + (big ? 0 : 98304)); dp[m] = fftm_bf1(c); dp[N * N + m] = fftm_bf1(sn); dp[2 * N * N + m] = fftm_bf1(-sn); continue; }
        r -= NT_DFT;
        if (r < NT_ZSS) { ((f32x4*)(ws + WS_SS))[r * 512 + tid] = (f32x4){0.f, 0.f, 0.f, 0.f}; continue; }
        if (tid < 2) { const int l = tid; float s1 = 0.f, s2 = 0.f;
            for (int k = 0; k < 64; ++k) { s1 += a.in[I_LQ1][l * 64 + k] * a.in[I_LK1][l * 64 + k]; s2 += a.in[I_LQ2][l * 64 + k] * a.in[I_LK2][l * 64 + k]; }
            const float li = l == 0 ? 0.2f : 0.35550906759096934f;
            ((float*)(ws + WS_LAM))[l] = __expf(s1) - __expf(s2) + li; }
    }
}

constexpr int NT_AT = 144, NT_BWT = 1200, NT_PRO2 = NT_AT + NT_BWT;
__device__ __forceinline__ void prologue2_phase(KArgs& a, LAS unsigned char* lds, int wg, int nwg, int tid) {
    unsigned char* ws = a.ws; const float* mod = (const float*)(ws + WS_MOD);
    LAS float* sh = (LAS float*)lds;
    const int lane = tid & 63, wid = tid >> 6;
    for (int t = wg; t < NT_PRO2; t += nwg) {
        if (t < NT_AT) { const int idx = t * 512 + tid, inst = idx / 12288, rem = idx % 12288, br = rem >> 11, col = rem & 2047, l = inst / 3, sl = inst % 3;
            const float g = a.in[sl == 0 ? I_GFF1 : (sl == 1 ? I_GMIX : I_GFF2)][l * DM + col];
            ((float*)(ws + WS_AT))[idx] = g * (1.0f + mod[((size_t)l * 6 + br) * NMODC + (3 * sl + 1) * DM + col]); continue; }
        const int R0 = (t - NT_AT) * 64, l = R0 / BWL, rr = R0 % BWL, sl = rr < 11008 ? 0 : (rr < 27392 ? 1 : 2), v0 = rr - (sl == 0 ? 0 : (sl == 1 ? 11008 : 27392));
        __syncthreads();
#pragma unroll 1
        for (int i0 = 0; i0 < 6 * DM; i0 += 8 * 512) {
            float mv[8];
#pragma unroll
            for (int j = 0; j < 8; ++j) { const int i = i0 + j * 512 + tid, br = i >> 11, k = i & 2047; mv[j] = mod[((size_t)l * 6 + br) * NMODC + 3 * sl * DM + k]; }
#pragma unroll
            for (int j = 0; j < 8; ++j) { const int i = i0 + j * 512 + tid, br = i >> 11, k = i & 2047; sh[(br * 8 + (k >> 8)) * 260 + (k & 255)] = mv[j]; } }
        __syncthreads();
        const bf16_t* W = (const bf16_t*)(ws + WS_W + (size_t)l * WLAYER + (sl == 0 ? WO_FF1I : (sl == 1 ? WO_IN : WO_FF2I)));
        const int v = v0 + wid * 8 + (lane >> 3), kq = lane & 7;
        float acc[6] = {0.f, 0.f, 0.f, 0.f, 0.f, 0.f};
        for (int i = 0; i < 32; ++i) { const u32x4 wv = *(const u32x4*)((const char*)W + pg8::wtile_off(v, kq * 256 + i * 8, DM / 64));
            const float w8[8] = {bf_lo(wv.x), bf_hi(wv.x), bf_lo(wv.y), bf_hi(wv.y), bf_lo(wv.z), bf_hi(wv.z), bf_lo(wv.w), bf_hi(wv.w)};
#pragma unroll
            for (int br = 0; br < 6; ++br) { const LAS float* sp = sh + (br * 8 + kq) * 260 + i * 8; const f32x4 s0 = *(const LAS f32x4*)sp, s1 = *(const LAS f32x4*)(sp + 4);
                acc[br] += (w8[0] * s0[0] + w8[1] * s0[1]) + (w8[2] * s0[2] + w8[3] * s0[3]) + (w8[4] * s1[0] + w8[5] * s1[1]) + (w8[6] * s1[2] + w8[7] * s1[3]); } }
#pragma unroll
        for (int br = 0; br < 6; ++br) { float x = acc[br];
            x += __uint_as_float((unsigned)__builtin_amdgcn_ds_swizzle((int)__float_as_uint(x), (1 << 10) | 0x1f));
            x += __uint_as_float((unsigned)__builtin_amdgcn_ds_swizzle((int)__float_as_uint(x), (2 << 10) | 0x1f));
            x += __uint_as_float((unsigned)__builtin_amdgcn_ds_swizzle((int)__float_as_uint(x), (4 << 10) | 0x1f));
            if (kq == 0) ((float*)(ws + WS_BW))[((size_t)l * 6 + br) * BWL + rr + wid * 8 + (lane >> 3)] = x; }
    }
}
__device__ __forceinline__ void norm_first_phase(KArgs& a, int wg, int nwg, int wave, int lane) {
    bf16_t* XA = (bf16_t*)(a.ws + WS_H); float* ss0 = (float*)(a.ws + WS_SS); const float* at = (const float*)(a.ws + WS_AT);
    const int stride = nwg * 8; int row = wg * 8 + wave; if (row >= NTOK) return;
    f32x4 v[8], vn[8], av[8]; int brc = -1;
    { const float* x = row < 32768 ? a.in[I_XP] + (size_t)row * DM : a.in[I_XS] + (size_t)(row - 32768) * DM;
#pragma unroll
      for (int i = 0; i < 8; ++i) v[i] = *(const f32x4*)(x + (i * 64 + lane) * 4); }
    for (; row < NTOK; row += stride) {
        const int rn = row + stride; const int br = brow_of(row);
        if (rn < NTOK) { const float* xn = rn < 32768 ? a.in[I_XP] + (size_t)rn * DM : a.in[I_XS] + (size_t)(rn - 32768) * DM;
#pragma unroll
            for (int i = 0; i < 8; ++i) vn[i] = *(const f32x4*)(xn + (i * 64 + lane) * 4); }
        if (br != brc) { brc = br;
#pragma unroll
            for (int i = 0; i < 8; ++i) av[i] = *(const f32x4*)(at + (size_t)br * DM + (i * 64 + lane) * 4); }
        float ss = 0.f;
#pragma unroll
        for (int i = 0; i < 8; ++i) ss += (v[i][0] * v[i][0] + v[i][1] * v[i][1]) + (v[i][2] * v[i][2] + v[i][3] * v[i][3]);
        ss = wave_sum(ss); if (lane == 0) ss0[row] = ss;
#pragma unroll
        for (int i = 0; i < 8; ++i) { const int col = (i * 64 + lane) * 4; const f32x4 o = v[i] * av[i]; u32x2 w; w.x = pk2(o[0], o[1]); w.y = pk2(o[2], o[3]);
            *(u32x2*)(XA + (size_t)row * DM + col) = w; }
#pragma unroll
        for (int i = 0; i < 8; ++i) v[i] = vn[i];
    }
}
__device__ __forceinline__ void final_phase(KArgs& a, int wg, int nwg, int wave, int lane) {
    const float* gw = a.in[I_GFIN];
    const int stride = nwg * 8; int row = wg * 8 + wave; if (row >= NTOK) return;
    f32x4 v[8], vn[8], gv[8];
#pragma unroll
    for (int i = 0; i < 8; ++i) { gv[i] = *(const f32x4*)(gw + (i * 64 + lane) * 4); v[i] = *(const f32x4*)(a.out + (size_t)row * DM + (i * 64 + lane) * 4); }
    for (; row < NTOK; row += stride) {
        const int rn = row + stride; float* x = a.out + (size_t)row * DM;
        if (rn < NTOK) {
#pragma unroll
            for (int i = 0; i < 8; ++i) vn[i] = *(const f32x4*)(a.out + (size_t)rn * DM + (i * 64 + lane) * 4); }
        float ss = 0.f;
#pragma unroll
        for (int i = 0; i < 8; ++i) ss += (v[i][0] * v[i][0] + v[i][1] * v[i][1]) + (v[i][2] * v[i][2] + v[i][3] * v[i][3]);
        ss = wave_sum(ss); const float rstd = __builtin_amdgcn_rsqf(ss * (1.0f / DM) + EPS);
#pragma unroll
        for (int i = 0; i < 8; ++i) { const int col = (i * 64 + lane) * 4; *(f32x4*)(x + col) = v[i] * rstd * gv[i]; }
#pragma unroll
        for (int i = 0; i < 8; ++i) v[i] = vn[i];
    }
}

namespace dattn {
constexpr int KP = 144, VP = 320, KT = 64 * KP, VT = 64 * VP;
constexpr int KS0 = 0, KS1 = KT, VS0 = 2 * KT, VS1 = 2 * KT + VT;
#define DBAR() asm volatile("s_waitcnt lgkmcnt(0)\n\ts_barrier" ::: "memory")
__device__ __forceinline__ bf16x8 trA(LAS unsigned char* p) {
    const s16x4 lo = __builtin_amdgcn_ds_read_tr16_b64_v4i16((LAS s16x4*)p), hi = __builtin_amdgcn_ds_read_tr16_b64_v4i16((LAS s16x4*)(p + 8 * VP));
    return (bf16x8){lo[0], lo[1], lo[2], lo[3], hi[0], hi[1], hi[2], hi[3]};
}
__device__ __forceinline__ void qk(f32x16& p0, f32x16& p1, LAS unsigned char* ks, const bf16x8 (&qf)[4], int r32, int hi) {
    p0 = (f32x16){0.f, 0.f, 0.f, 0.f, 0.f, 0.f, 0.f, 0.f, 0.f, 0.f, 0.f, 0.f, 0.f, 0.f, 0.f, 0.f}; p1 = p0;
#pragma unroll
    for (int s = 0; s < 4; ++s) { const bf16x8 k0f = *(const LAS bf16x8*)(ks + r32 * KP + (16 * s + 8 * hi) * 2), k1f = *(const LAS bf16x8*)(ks + (32 + r32) * KP + (16 * s + 8 * hi) * 2);
        p0 = __builtin_amdgcn_mfma_f32_32x32x16_bf16(k0f, qf[s], p0, 0, 0, 0); p1 = __builtin_amdgcn_mfma_f32_32x32x16_bf16(k1f, qf[s], p1, 0, 0, 0); }
}
__device__ __forceinline__ float softmax(f32x16& p0, f32x16& p1, float& m, float& l, bf16x8 (&pb)[4]) {
    float mx = fmaxf(p0[0], p1[0]);
#pragma unroll
    for (int r = 1; r < 16; ++r) mx = fmaxf(mx, fmaxf(p0[r], p1[r]));
    mx = swap_max(mx);
    const float mn = fmaxf(m, mx * C2), alpha = __builtin_amdgcn_exp2f(m - mn); m = mn;
    float ps = 0.f;
#pragma unroll
    for (int r = 0; r < 16; ++r) { p0[r] = __builtin_amdgcn_exp2f(fmaf(p0[r], C2, -mn)); p1[r] = __builtin_amdgcn_exp2f(fmaf(p1[r], C2, -mn)); ps += p0[r] + p1[r]; }
    ps = swap_sum(ps); l = l * alpha + ps;
#pragma unroll
    for (int ks = 0; ks < 4; ++ks) { u32x4 w;
        if (ks < 2) { w.x = pk2(p0[8 * (ks & 1) + 0], p0[8 * (ks & 1) + 1]); w.y = pk2(p0[8 * (ks & 1) + 2], p0[8 * (ks & 1) + 3]); w.z = pk2(p0[8 * (ks & 1) + 4], p0[8 * (ks & 1) + 5]); w.w = pk2(p0[8 * (ks & 1) + 6], p0[8 * (ks & 1) + 7]); }
        else        { w.x = pk2(p1[8 * (ks & 1) + 0], p1[8 * (ks & 1) + 1]); w.y = pk2(p1[8 * (ks & 1) + 2], p1[8 * (ks & 1) + 3]); w.z = pk2(p1[8 * (ks & 1) + 4], p1[8 * (ks & 1) + 5]); w.w = pk2(p1[8 * (ks & 1) + 6], p1[8 * (ks & 1) + 7]); }
        pb[ks] = __builtin_bit_cast(bf16x8, w); }
    return alpha;
}
__device__ __forceinline__ void pv(f32x16 (&o)[4], LAS unsigned char* vs, int vbase, const bf16x8 (&pb)[4]) {
#pragma unroll
    for (int ks = 0; ks < 4; ++ks)
#pragma unroll
        for (int db = 0; db < 4; ++db) { const bf16x8 va = trA(vs + vbase + ks * 16 * VP + db * 64); o[db] = __builtin_amdgcn_mfma_f32_32x32x16_bf16(va, pb[ks], o[db], 0, 0, 0); }
}
template <int MODE>
__device__ __forceinline__ void unit(const bf16_t* Zs, int T, int h, int qb, const float* lamp, int layer, const float* lng, bf16_t* Ys, u32x4* oscr, LAS unsigned char* lds, const int wv) {
    const int tid = opaque_tid(wv), lane = tid & 63, wid = __builtin_amdgcn_readfirstlane(tid >> 6), r32 = lane & 31, hi = lane >> 5;
    const int qrow = qb * 256 + wid * 32 + r32, NT = T >> 6;
    const int ksr = tid >> 3, ksc = tid & 7, vr0 = tid >> 4, vc0 = tid & 15;
    const int vbase = (4 * hi + ((lane >> 2) & 3)) * VP + (16 * ((lane >> 4) & 1) + 4 * (lane & 3)) * 2;
    const int kw = ksr * KP + ksc * 16, vw = vr0 * VP + vc0 * 16;
#pragma unroll
    for (int c = 0; c < 2; ++c) {
        const bf16_t* Qp = Zs + zoff(qrow, 2048 + h * 128 + c * 64) + hi * 8;
        bf16x8 qf[4];
#pragma unroll
        for (int s = 0; s < 4; ++s) qf[s] = *(const bf16x8*)(Qp + 16 * s);
        LAS unsigned char* const qlds = lds + 59392 + wid * 4096 + lane * 16;
        const bf16_t* Kg = Zs + zoff(ksr, 2560 + h * 128 + c * 64) + ksc * 8;
        const bf16_t* Vg = Zs + zoff(vr0, 3072 + h * 128 + vc0 * 8);
        f32x16 o[4];
#pragma unroll
        for (int d = 0; d < 4; ++d) o[d] = (f32x16){0.f, 0.f, 0.f, 0.f, 0.f, 0.f, 0.f, 0.f, 0.f, 0.f, 0.f, 0.f, 0.f, 0.f, 0.f, 0.f};
        float m = -1e30f, l = 0.f;
        __syncthreads();
#pragma unroll
        for (int s = 0; s < 4; ++s) *(LAS bf16x8*)(qlds + s * 1024) = qf[s];
        { const bf16x8 k0 = *(const bf16x8*)Kg, k1 = *(const bf16x8*)(Kg + (size_t)64 * ZR), v0 = *(const bf16x8*)Vg, v1 = *(const bf16x8*)(Vg + (size_t)32 * ZR);
          *(LAS bf16x8*)(lds + KS0 + kw) = k0; *(LAS bf16x8*)(lds + KS1 + kw) = k1; *(LAS bf16x8*)(lds + VS0 + vw) = v0; *(LAS bf16x8*)(lds + VS0 + vw + 32 * VP) = v1; }
        __syncthreads();
        constexpr float THR = 8.0f;
        f32x16 pA0, pA1, pB0, pB1, negm; u32x4 pbA[4], pbB[4]; float mref = 0.f;
        negm = (f32x16){0.f, 0.f, 0.f, 0.f, 0.f, 0.f, 0.f, 0.f, 0.f, 0.f, 0.f, 0.f, 0.f, 0.f, 0.f, 0.f};
        qk(pA0, pA1, lds + KS0, qf, r32, hi);
        __syncthreads();
#define KFRAG(SL, G) (*(const LAS bf16x8*)((SL) + ((((G) & 1) ? 32 : 0) + r32) * KP + (16 * ((G) >> 1) + 8 * hi) * 2))
#define MX3(a, b, c) __builtin_fmaxf(__builtin_fmaxf((a), (b)), (c))
#define DSTEP(C0, C1, N0, N1, PBR, PBW, J) do { const int j_ = (J); const int jk_ = (j_ + 2 < NT) ? j_ + 2 : NT - 1; \
            LAS unsigned char* ksl_ = lds + (((j_ + 1) & 1) ? KS1 : KS0); LAS unsigned char* vsl_ = lds + (((j_ - 1) & 1) ? VS1 : VS0) + vbase; \
            bf16x8 kf_[8], va_[16], qs_[4]; float ps_ = 0.f; \
            const bf16x8 kreg_ = *(const bf16x8*)(Kg + (size_t)jk_ * 64 * ZR);        \
            const bf16x8 v0_ = *(const bf16x8*)(Vg + (size_t)j_ * 64 * ZR), v1_ = *(const bf16x8*)(Vg + (size_t)j_ * 64 * ZR + (size_t)32 * ZR); \
            kf_[0] = KFRAG(ksl_, 0); kf_[1] = KFRAG(ksl_, 1); qs_[0] = *(const LAS bf16x8*)(qlds); \
            __builtin_amdgcn_sched_barrier(0); \
            _Pragma("unroll") for (int g_ = 0; g_ < 8; ++g_) { \
                if (g_ + 2 < 8) kf_[g_ + 2] = KFRAG(ksl_, g_ + 2); \
                if (!(g_ & 1) && g_ + 2 < 8) qs_[(g_ >> 1) + 1] = *(const LAS bf16x8*)(qlds + ((g_ >> 1) + 1) * 1024); \
                if (g_ >= 6) va_[g_ - 6] = trA(vsl_ + (g_ - 6) * 64); \
                if (g_ == 0) N0 = __builtin_amdgcn_mfma_f32_32x32x16_bf16(kf_[0], qs_[0], negm, 0, 0, 0); else if (g_ == 1) N1 = __builtin_amdgcn_mfma_f32_32x32x16_bf16(kf_[1], qs_[0], negm, 0, 0, 0); \
                else if (g_ & 1) N1 = __builtin_amdgcn_mfma_f32_32x32x16_bf16(kf_[g_], qs_[g_ >> 1], N1, 0, 0, 0); else N0 = __builtin_amdgcn_mfma_f32_32x32x16_bf16(kf_[g_], qs_[g_ >> 1], N0, 0, 0, 0); \
                { const float e0_ = __builtin_amdgcn_exp2f(C0[2 * g_]), e1_ = __builtin_amdgcn_exp2f(C0[2 * g_ + 1]); ps_ += e0_; ps_ += e1_; PBW[g_ >> 2][g_ & 3] = pk2(e0_, e1_); } \
                __builtin_amdgcn_sched_barrier(0); } \
            float tn_ = -1e30f, ep_ = 0.f; \
            __builtin_amdgcn_sched_barrier(0); \
            _Pragma("unroll") for (int i_ = 0; i_ < 16; ++i_) { \
                if (i_ + 2 < 16) va_[i_ + 2] = trA(vsl_ + ((i_ + 2) >> 2) * 16 * VP + ((i_ + 2) & 3) * 64); \
                o[i_ & 3] = __builtin_amdgcn_mfma_f32_32x32x16_bf16(va_[i_], __builtin_bit_cast(bf16x8, PBR[i_ >> 2]), o[i_ & 3], 0, 0, 0); \
                { const float e_ = __builtin_amdgcn_exp2f(C1[i_]); ps_ += e_; if (i_ & 1) PBW[2 + (i_ >> 3)][(i_ >> 1) & 3] = pk2(ep_, e_); else ep_ = e_; } \
                tn_ = MX3(tn_, N0[i_], N1[i_]); asm volatile("" : "+v"(tn_)); \
                __builtin_amdgcn_sched_barrier(0); } \
            asm volatile("" : "+v"(PBW[0]), "+v"(PBW[1]), "+v"(PBW[2]), "+v"(PBW[3])); \
            ps_ = swap_sum(ps_); l += ps_; \
            if (__any(fcarry < 1.0f)) { _Pragma("unroll") for (int d = 0; d < 4; ++d) o[d] *= fcarry; } \
            fcarry = 1.0f; \
            { const float mx_ = swap_max(tn_); \
              if ((j_ + 1 < NT) && __any(mx_ > THR)) { const float d_ = fmaxf(mx_, 0.f); fcarry = __builtin_amdgcn_exp2f(-d_); mref += d_; l *= fcarry; \
                  _Pragma("unroll") for (int r = 0; r < 16; ++r) { N0[r] -= d_; N1[r] -= d_; negm[r] = -mref; } } } \
            *(LAS bf16x8*)(lds + ((j_ & 1) ? KS1 : KS0) + kw) = kreg_; \
            *(LAS bf16x8*)(lds + ((j_ & 1) ? VS1 : VS0) + vw) = v0_; *(LAS bf16x8*)(lds + ((j_ & 1) ? VS1 : VS0) + vw + 32 * VP) = v1_; \
            DBAR(); } while (0)
        float fcarry = 1.0f;
        {
            const bf16x8 kreg_ = *(const bf16x8*)(Kg + (size_t)(2 < NT ? 2 : NT - 1) * 64 * ZR);
            float mx = fmaxf(pA0[0], pA1[0]);
#pragma unroll
            for (int r = 1; r < 16; ++r) mx = fmaxf(mx, fmaxf(pA0[r], pA1[r]));
            mx = swap_max(mx); mref = mx;
#pragma unroll
            for (int r = 0; r < 16; ++r) negm[r] = -mref;
            float ps = 0.f;
#pragma unroll
            for (int r = 0; r < 16; ++r) { pA0[r] = __builtin_amdgcn_exp2f(pA0[r] - mx); pA1[r] = __builtin_amdgcn_exp2f(pA1[r] - mx); ps += pA0[r] + pA1[r]; }
            l = swap_sum(ps);
#pragma unroll
            for (int ks = 0; ks < 4; ++ks) { u32x4 w;
                if (ks < 2) { w.x = pk2(pA0[8 * (ks & 1) + 0], pA0[8 * (ks & 1) + 1]); w.y = pk2(pA0[8 * (ks & 1) + 2], pA0[8 * (ks & 1) + 3]); w.z = pk2(pA0[8 * (ks & 1) + 4], pA0[8 * (ks & 1) + 5]); w.w = pk2(pA0[8 * (ks & 1) + 6], pA0[8 * (ks & 1) + 7]); }
                else        { w.x = pk2(pA1[8 * (ks & 1) + 0], pA1[8 * (ks & 1) + 1]); w.y = pk2(pA1[8 * (ks & 1) + 2], pA1[8 * (ks & 1) + 3]); w.z = pk2(pA1[8 * (ks & 1) + 4], pA1[8 * (ks & 1) + 5]); w.w = pk2(pA1[8 * (ks & 1) + 6], pA1[8 * (ks & 1) + 7]); }
                pbA[ks] = w; }
            { LAS unsigned char* ksl_ = lds + KS1;
#pragma unroll
              for (int g = 0; g < 8; ++g) { const bf16x8 kf = KFRAG(ksl_, g);
                if (g == 0) pB0 = __builtin_amdgcn_mfma_f32_32x32x16_bf16(kf, qf[0], negm, 0, 0, 0); else if (g == 1) pB1 = __builtin_amdgcn_mfma_f32_32x32x16_bf16(kf, qf[0], negm, 0, 0, 0);
                else if (g & 1) pB1 = __builtin_amdgcn_mfma_f32_32x32x16_bf16(kf, qf[g >> 1], pB1, 0, 0, 0); else pB0 = __builtin_amdgcn_mfma_f32_32x32x16_bf16(kf, qf[g >> 1], pB0, 0, 0, 0); } }
            { float t1 = fmaxf(pB0[0], pB1[0]);
#pragma unroll
              for (int r = 1; r < 16; ++r) t1 = fmaxf(t1, fmaxf(pB0[r], pB1[r]));
              t1 = swap_max(t1);
              if ((1 < NT) && __any(t1 > THR)) { const float d_ = fmaxf(t1, 0.f); fcarry = __builtin_amdgcn_exp2f(-d_); mref += d_; l *= fcarry;
#pragma unroll
                  for (int r = 0; r < 16; ++r) { pB0[r] -= d_; pB1[r] -= d_; negm[r] = -mref; } } }
            *(LAS bf16x8*)(lds + KS0 + kw) = kreg_;
            DBAR(); }
        for (int j = 1; j + 1 < NT; j += 2) { DSTEP(pB0, pB1, pA0, pA1, pbA, pbB, j); DSTEP(pA0, pA1, pB0, pB1, pbB, pbA, j + 1); }
        DSTEP(pB0, pB1, pA0, pA1, pbA, pbB, NT - 1);
#undef DSTEP
#undef KFRAG
#undef MX3
        { bf16x8 pbl[4];
#pragma unroll
          for (int q = 0; q < 4; ++q) pbl[q] = __builtin_bit_cast(bf16x8, pbB[q]);
          pv(o, lds + (((NT - 1) & 1) ? VS1 : VS0), vbase, pbl); }
        const float inv = __builtin_amdgcn_rcpf(l);
        const int tidE = opaque_tid(wv), hiE = (tidE >> 5) & 1, qrowE = qb * 256 + (tidE >> 6) * 32 + (tidE & 31);
        if (c == 0) {
#pragma unroll
            for (int d = 0; d < 4; ++d)
#pragma unroll
                for (int i = 0; i < 2; ++i) { u32x4 w; w.x = pk2(o[d][8 * i] * inv, o[d][8 * i + 1] * inv); w.y = pk2(o[d][8 * i + 2] * inv, o[d][8 * i + 3] * inv); w.z = pk2(o[d][8 * i + 4] * inv, o[d][8 * i + 5] * inv); w.w = pk2(o[d][8 * i + 6] * inv, o[d][8 * i + 7] * inv);
                    oscr[(size_t)tidE * 8 + d * 2 + i] = w; }
        } else {
            float ss = 0.f; int ly = layer; asm volatile("" : "+s"(ly));
            const float lamv = lamp[ly], postv = ly == 0 ? 0.8f : 0.64449093240903066f;
#pragma unroll
            for (int d = 0; d < 4; ++d) {
#pragma unroll
                for (int i = 0; i < 2; ++i) { const u32x4 w = __builtin_nontemporal_load(oscr + (size_t)tidE * 8 + d * 2 + i); const float il = inv * lamv;
                    o[d][8 * i + 0] = bf_lo(w.x) - o[d][8 * i + 0] * il; o[d][8 * i + 1] = bf_hi(w.x) - o[d][8 * i + 1] * il; o[d][8 * i + 2] = bf_lo(w.y) - o[d][8 * i + 2] * il; o[d][8 * i + 3] = bf_hi(w.y) - o[d][8 * i + 3] * il;
                    o[d][8 * i + 4] = bf_lo(w.z) - o[d][8 * i + 4] * il; o[d][8 * i + 5] = bf_hi(w.z) - o[d][8 * i + 5] * il; o[d][8 * i + 6] = bf_lo(w.w) - o[d][8 * i + 6] * il; o[d][8 * i + 7] = bf_hi(w.w) - o[d][8 * i + 7] * il; }
#pragma unroll
                for (int r = 0; r < 16; ++r) ss += o[d][r] * o[d][r]; }
            ss = swap_sum(ss);
            const float rn = __builtin_amdgcn_rsqf(ss * (1.0f / 128.0f) + EPS) * postv;
            bf16_t* yp = Ys + (size_t)qrowE * DM + 1024 + h * 128;
            f32x4 gl[16];
#pragma unroll
            for (int i = 0; i < 16; ++i) gl[i] = *(const f32x4*)(lng + (i >> 2) * 32 + 8 * (i & 3) + 4 * hiE);
            __builtin_amdgcn_sched_barrier(0);
#pragma unroll
            for (int d = 0; d < 4; ++d)
#pragma unroll
                for (int a4 = 0; a4 < 4; ++a4) { const int d0 = d * 32 + 8 * a4 + 4 * hiE; const f32x4 g = gl[d * 4 + a4];
                    u32x2 w; w.x = pk2(o[d][4 * a4] * rn * g[0], o[d][4 * a4 + 1] * rn * g[1]); w.y = pk2(o[d][4 * a4 + 2] * rn * g[2], o[d][4 * a4 + 3] * rn * g[3]);
                    *(u32x2*)((char*)Ys + pg8::atile_off(qrowE, 1024 + h * 128 + d * 32 + 8 * a4, DM / 64) + 8 * hiE) = w; (void)yp; (void)d0; }
        }
    }
}
#undef DBAR
}

namespace wattn {
constexpr int VP = 192, VBUF = 32 * VP, KP = 144, KBUF = 32 * KP, WBUF = VBUF + KBUF;
constexpr float THR = 8.0f;
struct KV { bf16x8 kr[4], vr[4]; };
struct Geom { int kind, a0, a1, B, TS, KS, nt, QB, qsh, qcol, kcol, vcol; };
__device__ __forceinline__ unsigned kv_off0(const Geom& G, int lane) { return (unsigned)(zoff(G.B + (lane >> 3) * G.KS, G.kcol) + 8 * (lane & 7)) * 2u; }
__device__ __forceinline__ void load_kv(KV& t, const char* Zc, unsigned off, unsigned rsb, int dv) {
#pragma unroll
    for (int i = 0; i < 4; ++i) { const char* pk = Zc + (off + (unsigned)i * rsb); t.kr[i] = *(const bf16x8*)pk; t.vr[i] = *(const bf16x8*)(pk + dv); }
}
__device__ __forceinline__ void load_q(bf16x8 (&qf)[4], const char* Zc, const Geom& G, int lane) {
    const int r32 = lane & 31, hi = lane >> 5; const int qtok = G.QB + (G.qsh < 0 ? (r32 >> 4) * 64 + (r32 & 15) : (r32 << G.qsh));
    const char* Qp = Zc + (unsigned)(zoff(qtok, G.qcol) + 8 * hi) * 2u;
#pragma unroll
    for (int s = 0; s < 4; ++s) qf[s] = *(const bf16x8*)(Qp + 32 * s);
}
__device__ __forceinline__ void put_k(const KV& t, LAS unsigned char* kb, int lane) {
#pragma unroll
    for (int i = 0; i < 4; ++i) *(LAS bf16x8*)(kb + ((lane >> 3) + 8 * i) * KP + (lane & 7) * 16) = t.kr[i];
}
__device__ __forceinline__ f32x16 qk4(LAS unsigned char* kb, const bf16x8 (&qf)[4], int lane) {
    LAS unsigned char* p = kb + (lane & 31) * KP + (lane >> 5) * 16;
    bf16x8 kf[4];
#pragma unroll
    for (int st = 0; st < 4; ++st) kf[st] = *(const LAS bf16x8*)(p + st * 32);
    __builtin_amdgcn_sched_barrier(0);
    f32x16 s = __builtin_amdgcn_mfma_f32_32x32x16_bf16(kf[0], qf[0], (f32x16){0.f, 0.f, 0.f, 0.f, 0.f, 0.f, 0.f, 0.f, 0.f, 0.f, 0.f, 0.f, 0.f, 0.f, 0.f, 0.f}, 0, 0, 0);
#pragma unroll
    for (int st = 1; st < 4; ++st) s = __builtin_amdgcn_mfma_f32_32x32x16_bf16(kf[st], qf[st], s, 0, 0, 0);
    return s;
}
__device__ __forceinline__ void put_v(const KV& t, LAS unsigned char* vb, int lane) {
#pragma unroll
    for (int i = 0; i < 4; ++i) *(LAS bf16x8*)(vb + ((lane >> 3) + 8 * i) * VP + (lane & 7) * 16) = t.vr[i];
}
__device__ __forceinline__ void pv2(f32x16& o0, f32x16& o1, LAS unsigned char* vb, const u32x4 (&pb)[2], int lane) {
    const int hi = lane >> 5; LAS unsigned char* p0 = vb + (4 * hi + ((lane >> 2) & 3)) * VP + (16 * ((lane >> 4) & 1) + 4 * (lane & 3)) * 2;
    bf16x8 va[4];
#pragma unroll
    for (int i = 0; i < 4; ++i) { LAS unsigned char* p = p0 + (i >> 1) * 16 * VP + (i & 1) * 64;
        const s16x4 lo = __builtin_amdgcn_ds_read_tr16_b64_v4i16((LAS s16x4*)p), hh = __builtin_amdgcn_ds_read_tr16_b64_v4i16((LAS s16x4*)(p + 8 * VP));
        va[i] = (bf16x8){lo[0], lo[1], lo[2], lo[3], hh[0], hh[1], hh[2], hh[3]}; }
    __builtin_amdgcn_sched_barrier(0);
#pragma unroll
    for (int ks = 0; ks < 2; ++ks) { o0 = __builtin_amdgcn_mfma_f32_32x32x16_bf16(va[2 * ks], __builtin_bit_cast(bf16x8, pb[ks]), o0, 0, 0, 0); o1 = __builtin_amdgcn_mfma_f32_32x32x16_bf16(va[2 * ks + 1], __builtin_bit_cast(bf16x8, pb[ks]), o1, 0, 0, 0); }
}
template <class FixS>
__device__ __forceinline__ void run(f32x16& o0, f32x16& o1, float& l, float& mref, bf16x8 (&qf)[4], KV& kvA, KV& kvB, const char* Zc, const Geom& G, const Geom& N, const bool hasN, const FixS& fixs, LAS unsigned char* wbuf, int lane) {
    const f32x16 zero = (f32x16){0.f, 0.f, 0.f, 0.f, 0.f, 0.f, 0.f, 0.f, 0.f, 0.f, 0.f, 0.f, 0.f, 0.f, 0.f, 0.f};
    LAS unsigned char* const vbuf = wbuf; LAS unsigned char* const kbuf = wbuf + VBUF;
    const int nt = G.nt; const unsigned tsb = (unsigned)G.TS * (ZR * 2), rsb = (unsigned)G.KS * (8 * ZR * 2); const int dv = ((G.vcol - G.kcol) >> 6) * (GT * ZR * 2);
    unsigned off2 = kv_off0(G, lane) + 2u * tsb;
    o0 = zero; o1 = zero; l = 0.f;
    f32x16 sA, sB; u32x4 pbA[2], pbB[2]; float fcarry = 1.0f;
    asm volatile("" ::: "memory"); put_k(kvA, kbuf, lane); asm volatile("" ::: "memory");
    sA = qk4(kbuf, qf, lane); fixs(0, sA);
    { float mx = sA[0];
#pragma unroll
      for (int r = 1; r < 16; ++r) mx = fmaxf(mx, sA[r]);
      mx = swap_max(mx); mx = (mx > -1e30f) ? mx : 0.f; mref = mx;
#pragma unroll
      for (int r = 0; r < 16; ++r) sA[r] -= mx; }
#define WSTEP(SC, SN, PBR, PBW, KC, KN, TT, KCI) do { const int t_ = (TT); const bool nx_ = (t_ + 1 < nt); \
        asm volatile("" ::: "memory"); \
        if (nx_) { put_k(KN, kbuf, lane); asm volatile("" ::: "memory"); SN = qk4(kbuf, qf, lane); } \
        if (t_ >= 1) pv2(o0, o1, vbuf, PBR, lane); \
        asm volatile("" ::: "memory"); put_v(KC, vbuf, lane); asm volatile("" ::: "memory"); \
        if (t_ + 2 < nt) { load_kv(KC, Zc, off2, rsb, dv); off2 += tsb; } \
        else if (hasN) load_kv(KC, Zc, kv_off0(N, lane) + (KCI) * ((unsigned)N.TS * (ZR * 2)), (unsigned)N.KS * (8 * ZR * 2), ((N.vcol - N.kcol) >> 6) * (GT * ZR * 2));     \
        if (!nx_ && hasN) load_q(qf, Zc, N, lane); \
        float ps_ = 0.f; \
        _Pragma("unroll") for (int r = 0; r < 16; r += 2) { const float e0_ = __builtin_amdgcn_exp2f(SC[r]), e1_ = __builtin_amdgcn_exp2f(SC[r + 1]); ps_ += e0_; ps_ += e1_; PBW[r >> 3][(r >> 1) & 3] = pk2(e0_, e1_); } \
        ps_ = swap_sum(ps_); l += ps_; \
        if (__any(fcarry < 1.0f)) { o0 *= fcarry; o1 *= fcarry; } \
        fcarry = 1.0f; \
        if (nx_) { _Pragma("unroll") for (int r = 0; r < 16; ++r) SN[r] -= mref; \
            fixs(t_ + 1, SN); float tn_ = SN[0]; \
            _Pragma("unroll") for (int r = 1; r < 16; ++r) tn_ = fmaxf(tn_, SN[r]); \
            tn_ = swap_max(tn_); \
            if (__any(tn_ > THR)) { const float d_ = fmaxf(tn_, 0.f); fcarry = __builtin_amdgcn_exp2f(-d_); mref += d_; l *= fcarry; \
                _Pragma("unroll") for (int r = 0; r < 16; ++r) SN[r] -= d_; } } \
    } while (0)
    int t = 0;
    for (; t + 1 < nt; t += 2) { WSTEP(sA, sB, pbB, pbA, kvA, kvB, t, 0); WSTEP(sB, sA, pbA, pbB, kvB, kvA, t + 1, 1); }
    if (t < nt) { WSTEP(sA, sB, pbB, pbA, kvA, kvB, t, 0); asm volatile("" ::: "memory"); pv2(o0, o1, vbuf, pbA, lane); }
    else { asm volatile("" ::: "memory"); pv2(o0, o1, vbuf, pbB, lane); }
#undef WSTEP
    asm volatile("" ::: "memory");
}

__device__ __forceinline__ Geom nat_geom(int T, int qb, int h) {
    const int tok0 = qb * 32, seqrow0 = tok0 & ~(T - 1), bl = (tok0 & (T - 1)) >> 5, r = 2 * (bl >> 2), c0 = 16 * (bl & 3), rows = T >> 6;
    const int rsu = min(max(r - 4, 0), rows - 8), nt = min(max(r - 3, 0), rows - 8) + 8 - rsu, cst = min(min(max(c0 - 8, 0), 48), 32);
    return Geom{0, qb, 0, seqrow0 + rsu * 64 + cst, 64, 1, nt, seqrow0 + r * 64 + c0, -1, 512 + h * 64, 1024 + h * 64, 1536 + h * 64};
}
__device__ __forceinline__ Geom dil_geom(int T, int g, int qblk, int h) {
    const int ds = 2 * g, d = 1 << ds, nqs = T >> 5;
    const int seqrow0 = (qblk << 5) & ~(T - 1), qs = qblk & (nqs - 1), rho = qs & (d - 1), u0 = (qs >> ds) * 32, U = T >> ds;
    const int jlo = u0 >= 64 ? 0 : (u0 >= 32 ? 1 : 2), jhi = (u0 + 96 <= U) ? 4 : ((u0 + 64 <= U) ? 3 : 2);
    const int base = seqrow0 + rho, ub = u0 - 64 + 32 * jlo;
    return Geom{1, g, qblk, base + (ub << ds), 32 << ds, d, jhi - jlo + 1, base + (u0 << ds), ds, 3584 + g * 512 + h * 64, 5120 + g * 512 + h * 64, 6656 + g * 512 + h * 64};
}
__device__ __forceinline__ void task(const bf16_t* Z, bf16_t* Y, float* DO, float* DL, const LAS float* tabl, int T, int h, bf16x8 (&qf)[4], KV& kvA, KV& kvB, const Geom& G, const Geom& N, bool hasN, LAS unsigned char* vbuf) {
    const int lane = opaque_lane(), r32 = lane & 31, hi = lane >> 5;
    const bool nat = G.kind == 0;
    const int tok0 = G.a0 * 32, nsr0 = tok0 & ~(T - 1), bl = (tok0 & (T - 1)) >> 5, r = 2 * (bl >> 2), c0 = 16 * (bl & 3), rows = T >> 6;
    const int qr = r + (r32 >> 4), qc = c0 + (r32 & 15);
    const int rsu = min(max(r - 4, 0), rows - 8), cst = min(min(max(c0 - 8, 0), 48), 32);
    const int dlo = min(max(qr - 4, 0), rows - 8) - rsu, clo = min(max(qc - 8, 0), 48) - cst - 4 * hi;
    const LAS float* rbl = tabl + h * 465 + (rsu - qr + 7) * 31 + 15 - qc + cst + 4 * hi;
    const int g = G.a0, qblk = G.a1, ds = 2 * g, d = 1 << ds, nqs = T >> 5;
    const int dsr0 = (qblk << 5) & ~(T - 1), qs = qblk & (nqs - 1), rho = qs & (d - 1), u0 = (qs >> ds) * 32;
    const int jlo = u0 >= 64 ? 0 : (u0 >= 32 ? 1 : 2);
    const int qtok = nat ? nsr0 + qr * 64 + qc : dsr0 + rho + ((u0 + r32) << ds);
    const int keyl = r32 - 4 * hi;
    f32x16 o0, o1; float l, mref;
    run(o0, o1, l, mref, qf, kvA, kvB, (const char*)Z, G, N, hasN,
        [&](int t, f32x16& s) {
            if (nat) { const int cl = ((unsigned)(t - dlo) < 8u) ? clo : (1 << 20); const LAS float* bp = rbl + t * 31;
                float bv[16];
#pragma unroll
                for (int rr = 0; rr < 16; ++rr) bv[rr] = bp[(rr & 3) + 8 * (rr >> 2)];
#pragma unroll
                for (int rr = 0; rr < 16; ++rr) s[rr] = ((unsigned)((rr & 3) + 8 * (rr >> 2) - cl) < 16u) ? s[rr] + bv[rr] : -INFINITY; }
            else { const int jt = jlo + t;
                if (jt == 0) {
#pragma unroll
                    for (int rr = 0; rr < 16; ++rr) s[rr] = ((rr & 3) + 8 * (rr >> 2) >= keyl) ? s[rr] : -INFINITY; }
                else if (jt == 4) {
#pragma unroll
                    for (int rr = 0; rr < 16; ++rr) s[rr] = ((rr & 3) + 8 * (rr >> 2) <= keyl) ? s[rr] : -INFINITY; } } },
        vbuf, lane);
    const float inv = __builtin_amdgcn_rcpf(l);
    if (nat) {
        bf16_t* yp = Y + (size_t)qtok * DM + 512 + h * 64;
#pragma unroll
        for (int a4 = 0; a4 < 4; ++a4) { const int d0 = 8 * a4 + 4 * hi;
            u32x2 w; w.x = pk2(o0[4 * a4] * inv, o0[4 * a4 + 1] * inv); w.y = pk2(o0[4 * a4 + 2] * inv, o0[4 * a4 + 3] * inv); *(u32x2*)((char*)Y + pg8::atile_off(qtok, 512 + h * 64 + 8 * a4, DM / 64) + 8 * hi) = w;
            u32x2 w1; w1.x = pk2(o1[4 * a4] * inv, o1[4 * a4 + 1] * inv); w1.y = pk2(o1[4 * a4 + 2] * inv, o1[4 * a4 + 3] * inv); *(u32x2*)((char*)Y + pg8::atile_off(qtok, 512 + h * 64 + 32 + 8 * a4, DM / 64) + 8 * hi) = w1; (void)yp; (void)d0; }
    } else {
        bf16_t* op = (bf16_t*)DO + ((size_t)g * GT + qtok) * 512 + h * 64;
#pragma unroll
        for (int a4 = 0; a4 < 4; ++a4) { const int d0 = 8 * a4 + 4 * hi;
            u32x2 w; w.x = pk2(o0[4 * a4] * inv, o0[4 * a4 + 1] * inv); w.y = pk2(o0[4 * a4 + 2] * inv, o0[4 * a4 + 3] * inv); *(u32x2*)(op + d0) = w;
            u32x2 w1; w1.x = pk2(o1[4 * a4] * inv, o1[4 * a4 + 1] * inv); w1.y = pk2(o1[4 * a4 + 2] * inv, o1[4 * a4 + 3] * inv); *(u32x2*)(op + 32 + d0) = w1; }
        if (hi == 0) DL[((size_t)g * GT + qtok) * 8 + h] = mref + __log2f(l);
    }
}
__device__ __forceinline__ Geom stream_geom(int T, int h, int kk, int wx, int nwg) {
    const int i = wx + (kk >> 1) * nwg, k = kk & 1;
    return nat_geom(T, 2 * i + k, h);
}
__device__ __forceinline__ void stream(const bf16_t* Z, bf16_t* Y, float* DO, float* DL, const LAS float* tabl, int T, int h, int wx, int nwg, LAS unsigned char* vbuf) {
    const int total = 2 * ((256 - wx + nwg - 1) / nwg);
    if (total <= 0) return;
    Geom G = stream_geom(T, h, 0, wx, nwg), N = G; bf16x8 qf[4]; KV kvA, kvB;
    { const int lane = opaque_lane(); const unsigned o0 = kv_off0(G, lane), tsb = (unsigned)G.TS * (ZR * 2), rsb = (unsigned)G.KS * (8 * ZR * 2); const int dv = ((G.vcol - G.kcol) >> 6) * (GT * ZR * 2);
      load_q(qf, (const char*)Z, G, lane); load_kv(kvA, (const char*)Z, o0, rsb, dv); load_kv(kvB, (const char*)Z, o0 + tsb, rsb, dv); }
    for (int kk = 0; kk < total; ++kk) {
        const bool hasN = kk + 1 < total; if (hasN) N = stream_geom(T, h, kk + 1, wx, nwg);
        task(Z, Y, DO, DL, tabl, T, h, qf, kvA, kvB, G, N, hasN, vbuf);
        G = N;
    }
}

constexpr int SKT = 32 * KP, SVT = 32 * VP, SVOFF = 12 * SKT;
struct DTask { int g, h, ds, tok0, u0b, U; };
__device__ __forceinline__ DTask dtask_of(int T, int j) {
    const int g = j >> 9, rem = j & 511, h = rem & 7, jj = rem >> 3, ds = 2 * g, d = 1 << ds, per = T >> 8;
    const int seq = jj / per, q = jj % per, rho = q & (d - 1), ubg = q >> ds;
    return DTask{g, h, ds, seq * T + rho, ubg * 256, T >> ds};
}
__device__ __forceinline__ void dshared_prefetch(u32x4 (&pre)[12], bf16x8 (&qn)[4], const char* Zc, const DTask& D, int tid, int wave, int lane) {
    const int kv = tid >> 8, row = (tid >> 3) & 31, chunk = tid & 7;
    const int col = (kv ? 6656 : 5120) + D.g * 512 + D.h * 64 + chunk * 8;
#pragma unroll
    for (int j = 0; j < 12; ++j) { const int u = D.u0b - 64 + 32 * j;
        if (u >= 0 && u + 32 <= D.U) pre[j] = *(const u32x4*)(Zc + (unsigned)zoff(D.tok0 + ((u + row) << D.ds), col) * 2u); }
    const int r32 = lane & 31, hi = lane >> 5; const int tq = D.tok0 + ((D.u0b + 32 * wave + r32) << D.ds);
    const char* Qp = Zc + (unsigned)(zoff(tq, 3584 + D.g * 512 + D.h * 64) + 8 * hi) * 2u;
#pragma unroll
    for (int s = 0; s < 4; ++s) qn[s] = *(const bf16x8*)(Qp + 32 * s);
}
__device__ __forceinline__ void dshared_task(const bf16_t* Z, float* DO, float* DL, int T, const DTask& D, const DTask& Nx, bool hasN, u32x4 (&pre)[12], bf16x8 (&qn)[4], LAS unsigned char* lds, int tid, int wave) {
    const int lane = tid & 63, r32 = lane & 31, hi = lane >> 5;
    asm volatile("s_waitcnt lgkmcnt(0)\n\ts_barrier" ::: "memory");
    { const int kv = tid >> 8, row = (tid >> 3) & 31, chunk = tid & 7; LAS unsigned char* wp = lds + (kv ? SVOFF + row * VP : row * KP) + chunk * 16;
#pragma unroll
      for (int j = 0; j < 12; ++j) { const int u = D.u0b - 64 + 32 * j; if (u >= 0 && u + 32 <= D.U) *(LAS u32x4*)(wp + j * (kv ? SVT : SKT)) = pre[j]; } }
    bf16x8 qf[4];
#pragma unroll
    for (int s = 0; s < 4; ++s) qf[s] = qn[s];
    asm volatile("s_waitcnt lgkmcnt(0)\n\ts_barrier" ::: "memory");
    if (hasN) dshared_prefetch(pre, qn, (const char*)Z, Nx, tid, wave, lane);
    const int u0 = D.u0b + 32 * wave, jlo = u0 >= 64 ? 0 : (u0 >= 32 ? 1 : 2), jhi = (u0 + 96 <= D.U) ? 4 : ((u0 + 64 <= D.U) ? 3 : 2), nt = jhi - jlo + 1;
    const int keyl = r32 - 4 * hi;
    LAS unsigned char* kb0 = lds + (wave + jlo) * SKT; LAS unsigned char* vb0 = lds + SVOFF + (wave + jlo) * SVT;
    const f32x16 zero = (f32x16){0.f, 0.f, 0.f, 0.f, 0.f, 0.f, 0.f, 0.f, 0.f, 0.f, 0.f, 0.f, 0.f, 0.f, 0.f, 0.f};
    f32x16 o0 = zero, o1 = zero, sA, sB; u32x4 pbA[2], pbB[2]; float l = 0.f, mref, fcarry = 1.0f;
#define DFIX(TT, S) do { const int jt_ = jlo + (TT); \
        if (jt_ == 0) { _Pragma("unroll") for (int rr = 0; rr < 16; ++rr) S[rr] = ((rr & 3) + 8 * (rr >> 2) >= keyl) ? S[rr] : -INFINITY; } \
        else if (jt_ == 4) { _Pragma("unroll") for (int rr = 0; rr < 16; ++rr) S[rr] = ((rr & 3) + 8 * (rr >> 2) <= keyl) ? S[rr] : -INFINITY; } } while (0)
    sA = qk4(kb0, qf, lane); DFIX(0, sA);
    { float mx = sA[0];
#pragma unroll
      for (int r = 1; r < 16; ++r) mx = fmaxf(mx, sA[r]);
      mx = swap_max(mx); mx = (mx > -1e30f) ? mx : 0.f; mref = mx;
#pragma unroll
      for (int r = 0; r < 16; ++r) sA[r] -= mx; }
#define DSTEP2(SC, SN, PBR, PBW, TT) do { const int t_ = (TT); const bool nx_ = (t_ + 1 < nt); \
        if (nx_) SN = qk4(kb0 + (t_ + 1) * SKT, qf, lane); \
        if (t_ >= 1) pv2(o0, o1, vb0 + (t_ - 1) * SVT, PBR, lane); \
        float ps_ = 0.f; \
        _Pragma("unroll") for (int r = 0; r < 16; r += 2) { const float e0_ = __builtin_amdgcn_exp2f(SC[r]), e1_ = __builtin_amdgcn_exp2f(SC[r + 1]); ps_ += e0_; ps_ += e1_; PBW[r >> 3][(r >> 1) & 3] = pk2(e0_, e1_); } \
        ps_ = swap_sum(ps_); l += ps_; \
        if (__any(fcarry < 1.0f)) { o0 *= fcarry; o1 *= fcarry; } \
        fcarry = 1.0f; \
        if (nx_) { _Pragma("unroll") for (int r = 0; r < 16; ++r) SN[r] -= mref; \
            DFIX(t_ + 1, SN); float tn_ = SN[0]; \
            _Pragma("unroll") for (int r = 1; r < 16; ++r) tn_ = fmaxf(tn_, SN[r]); \
            tn_ = swap_max(tn_); \
            if (__any(tn_ > THR)) { const float d_ = fmaxf(tn_, 0.f); fcarry = __builtin_amdgcn_exp2f(-d_); mref += d_; l *= fcarry; \
                _Pragma("unroll") for (int r = 0; r < 16; ++r) SN[r] -= d_; } } \
    } while (0)
    int t = 0;
    for (; t + 1 < nt; t += 2) { DSTEP2(sA, sB, pbB, pbA, t); DSTEP2(sB, sA, pbA, pbB, t + 1); }
    if (t < nt) { DSTEP2(sA, sB, pbB, pbA, t); pv2(o0, o1, vb0 + (nt - 1) * SVT, pbA, lane); }
    else pv2(o0, o1, vb0 + (nt - 1) * SVT, pbB, lane);
#undef DSTEP2
#undef DFIX
    const float inv = __builtin_amdgcn_rcpf(l);
    const int tq = D.tok0 + ((u0 + r32) << D.ds);
    bf16_t* op = (bf16_t*)DO + ((size_t)D.g * GT + tq) * 512 + D.h * 64;
#pragma unroll
    for (int a4 = 0; a4 < 4; ++a4) { const int d0 = 8 * a4 + 4 * hi;
        u32x2 w; w.x = pk2(o0[4 * a4] * inv, o0[4 * a4 + 1] * inv); w.y = pk2(o0[4 * a4 + 2] * inv, o0[4 * a4 + 3] * inv); *(u32x2*)(op + d0) = w;
        u32x2 w1; w1.x = pk2(o1[4 * a4] * inv, o1[4 * a4 + 1] * inv); w1.y = pk2(o1[4 * a4 + 2] * inv, o1[4 * a4 + 3] * inv); *(u32x2*)(op + 32 + d0) = w1; }
    if (hi == 0) DL[((size_t)D.g * GT + tq) * 8 + D.h] = mref + __log2f(l);
}
__device__ __forceinline__ void dshared(const bf16_t* Z, float* DO, float* DL, int T, int wx, int nwg, LAS unsigned char* lds, int tid, int wave) {
    if (wx >= 1536) return;
    const int lane = tid & 63;
    DTask D = dtask_of(T, wx), Nx = D; u32x4 pre[12]; bf16x8 qn[4];
    dshared_prefetch(pre, qn, (const char*)Z, D, tid, wave, lane);
    for (int j = wx; j < 1536; j += nwg) {
        const bool hasN = j + nwg < 1536; if (hasN) Nx = dtask_of(T, j + nwg);
        dshared_task(Z, DO, DL, T, D, Nx, hasN, pre, qn, lds, tid, wave);
        D = Nx;
    }
}
}

namespace fftm {
constexpr int PP = 320, PLANE = 128 * PP;
__device__ __forceinline__ bf16x8 trB(LAS unsigned char* p) {
    const s16x4 lo = __builtin_amdgcn_ds_read_tr16_b64_v4i16((LAS s16x4*)p), hh = __builtin_amdgcn_ds_read_tr16_b64_v4i16((LAS s16x4*)(p + 4 * PP));
    return (bf16x8){lo[0], lo[1], lo[2], lo[3], hh[0], hh[1], hh[2], hh[3]};
}
__device__ __forceinline__ bf16_t bf1(float x) { return (bf16_t)(pk2(x, 0.f) & 0xffffu); }
constexpr int UP = 272, PLOFF = 36864;
template <int N1>
__device__ __forceinline__ void pass1(const bf16_t* Zs, bf16_t* Bs, int t2, int g4, int dftstep, const bf16_t* W, const bf16_t* W128, LAS unsigned char* lds, int tid) {
    __syncthreads();
    { bf16x8 uv[N1 / 32];
#pragma unroll
      for (int i = 0; i < N1 / 32; ++i) { const int idx = tid + 512 * i, t1 = idx >> 4, c = idx & 15; uv[i] = *(const bf16x8*)(Zs + zoff(t1 * 128 + t2, g4 * 128 + c * 8)); }
#pragma unroll
      for (int i = 0; i < N1 / 32; ++i) { const int idx = tid + 512 * i, t1 = idx >> 4, c = idx & 15; *(LAS bf16x8*)(lds + t1 * UP + c * 16) = uv[i]; } }
    __syncthreads();
    constexpr int KB = N1 / 32, TPW = N1 / 64;
    const int lane = tid & 63, wid = __builtin_amdgcn_readfirstlane(tid >> 6), r32 = lane & 31, hi = lane >> 5;
    LAS unsigned char* const pl = lds + PLOFF;
    {
        const int tb = wid & 3, ca0 = (wid >> 2) * 2;
        if (tb < KB) {
            f32x16 aP[2], aQ[2];
#pragma unroll
            for (int t = 0; t < 2; ++t) { aP[t] = (f32x16){0.f, 0.f, 0.f, 0.f, 0.f, 0.f, 0.f, 0.f, 0.f, 0.f, 0.f, 0.f, 0.f, 0.f, 0.f, 0.f}; aQ[t] = aP[t]; }
            const LAS unsigned char* up = lds + (tb * 32 + r32) * UP + 16 * hi;
#pragma unroll
            for (int kh = 0; kh < 2; ++kh) {
                bf16x8 wP[4][2], wQ[4][2];
#pragma unroll
                for (int k4 = 0; k4 < 4; ++k4)
#pragma unroll
                    for (int t = 0; t < 2; ++t) { const bf16_t* wr_ = W128 + ((ca0 + t) * 32 + r32) * 128 + 16 * (kh * 4 + k4) + 8 * hi;
                        wP[k4][t] = *(const bf16x8*)wr_; wQ[k4][t] = *(const bf16x8*)(wr_ + 16384); }
                __builtin_amdgcn_sched_barrier(0);
#pragma unroll
                for (int k4 = 0; k4 < 4; ++k4) { const bf16x8 au = *(const LAS bf16x8*)(up + (kh * 4 + k4) * 32);
#pragma unroll
                    for (int t = 0; t < 2; ++t) { aP[t] = __builtin_amdgcn_mfma_f32_32x32x16_bf16(au, wP[k4][t], aP[t], 0, 0, 0); aQ[t] = __builtin_amdgcn_mfma_f32_32x32x16_bf16(au, wQ[k4][t], aQ[t], 0, 0, 0); } }
                __builtin_amdgcn_sched_barrier(0); }
#pragma unroll
            for (int t = 0; t < 2; ++t)
#pragma unroll
                for (int r = 0; r < 16; ++r) { LAS bf16_t* o = (LAS bf16_t*)(pl + (tb * 32 + crow(r, hi)) * PP) + (ca0 + t) * 32 + r32; o[0] = bf1(aP[t][r]); *(LAS bf16_t*)((LAS unsigned char*)o + PLANE) = bf1(aQ[t][r]); }
        }
    }
    __syncthreads();
    const int kblk = wid % KB, cb0 = (wid / KB) * TPW;
    const bf16_t* wc = W + (kblk * 32 + r32) * N1 + 8 * hi; const bf16_t* wsn = wc + N1 * N1; const bf16_t* wn = wsn + N1 * N1;
    const int vb = (8 * hi + ((lane >> 2) & 3)) * PP + (16 * ((lane >> 4) & 1) + 4 * (lane & 3)) * 2;
    f32x16 re[TPW], im[TPW];
#pragma unroll
    for (int t = 0; t < TPW; ++t) { re[t] = (f32x16){0.f, 0.f, 0.f, 0.f, 0.f, 0.f, 0.f, 0.f, 0.f, 0.f, 0.f, 0.f, 0.f, 0.f, 0.f, 0.f}; im[t] = re[t]; }
#pragma unroll
    for (int kh = 0; kh < N1 / 64; ++kh) {
        bf16x8 ac[4], as[4], an[4];
#pragma unroll
        for (int k4 = 0; k4 < 4; ++k4) { const int ks = kh * 4 + k4; ac[k4] = *(const bf16x8*)(wc + 16 * ks); as[k4] = *(const bf16x8*)(wsn + 16 * ks); an[k4] = *(const bf16x8*)(wn + 16 * ks); }
        __builtin_amdgcn_sched_barrier(0);
#pragma unroll
        for (int k4 = 0; k4 < 4; ++k4) { const int ks = kh * 4 + k4;
#pragma unroll
            for (int t = 0; t < TPW; ++t) { LAS unsigned char* bp = pl + vb + ks * 16 * PP + (cb0 + t) * 64;
                const bf16x8 bP = trB(bp), bQ = trB(bp + PLANE);
                re[t] = __builtin_amdgcn_mfma_f32_32x32x16_bf16(ac[k4], bP, re[t], 0, 0, 0); re[t] = __builtin_amdgcn_mfma_f32_32x32x16_bf16(an[k4], bQ, re[t], 0, 0, 0);
                im[t] = __builtin_amdgcn_mfma_f32_32x32x16_bf16(as[k4], bP, im[t], 0, 0, 0); im[t] = __builtin_amdgcn_mfma_f32_32x32x16_bf16(ac[k4], bQ, im[t], 0, 0, 0); } }
        __builtin_amdgcn_sched_barrier(0);
    }
#pragma unroll
    for (int t = 0; t < TPW; ++t) { const int ch = (cb0 + t) * 32 + r32;
#pragma unroll
        for (int r = 0; r < 16; ++r) { const int k1 = kblk * 32 + crow(r, hi); const float x = (float)((k1 * t2 * dftstep) & 16383) * (1.0f / 16384.0f);
            const float c = __builtin_amdgcn_cosf(x), sn = __builtin_amdgcn_sinf(x);
            bf16_t* o = Bs + ((((size_t)k1 * 128 + t2) * 4 + g4) * 256 + ch);
            o[0] = bf1(re[t][r] * c - im[t][r] * sn); o[128] = bf1(re[t][r] * sn + im[t][r] * c); } }
}
template <int N1>
__device__ __forceinline__ void pass2(const bf16_t* Bs, bf16_t* Ys, int k1, int g4, float rsT, const bf16_t* W128, LAS unsigned char* lds, int tid) {
    __syncthreads();
    { bf16x8 rv[4], iv[4];
#pragma unroll
      for (int i = 0; i < 4; ++i) { const int idx = tid + 512 * i, t2 = idx >> 4, c = idx & 15; const bf16_t* p = Bs + ((((size_t)k1 * 128 + t2) * 4 + g4) * 256 + c * 8); rv[i] = *(const bf16x8*)p; iv[i] = *(const bf16x8*)(p + 128); }
#pragma unroll
      for (int i = 0; i < 4; ++i) { const int idx = tid + 512 * i, t2 = idx >> 4, c = idx & 15; *(LAS bf16x8*)(lds + t2 * PP + c * 16) = rv[i]; *(LAS bf16x8*)(lds + PLANE + t2 * PP + c * 16) = iv[i]; } }
    __syncthreads();
    const int lane = tid & 63, wid = __builtin_amdgcn_readfirstlane(tid >> 6), r32 = lane & 31, hi = lane >> 5;
    const int kblk = wid & 3, cb0 = (wid >> 2) * 2;
    const bf16_t* wc = W128 + (kblk * 32 + r32) * 128 + 8 * hi; const bf16_t* wn = wc + 2 * 128 * 128;
    const int vb = (8 * hi + ((lane >> 2) & 3)) * PP + (16 * ((lane >> 4) & 1) + 4 * (lane & 3)) * 2;
    f32x16 acc[2];
    acc[0] = (f32x16){0.f, 0.f, 0.f, 0.f, 0.f, 0.f, 0.f, 0.f, 0.f, 0.f, 0.f, 0.f, 0.f, 0.f, 0.f, 0.f}; acc[1] = acc[0];
    bf16x8 ac[8], an[8];
#pragma unroll
    for (int ks = 0; ks < 8; ++ks) { ac[ks] = *(const bf16x8*)(wc + 16 * ks); an[ks] = *(const bf16x8*)(wn + 16 * ks); }
    __builtin_amdgcn_sched_barrier(0);
#pragma unroll
    for (int ks = 0; ks < 8; ++ks) {
#pragma unroll
        for (int t = 0; t < 2; ++t) { LAS unsigned char* bp = lds + vb + ks * 16 * PP + (cb0 + t) * 64;
            const bf16x8 bR = trB(bp), bI = trB(bp + PLANE);
            acc[t] = __builtin_amdgcn_mfma_f32_32x32x16_bf16(ac[ks], bR, acc[t], 0, 0, 0); acc[t] = __builtin_amdgcn_mfma_f32_32x32x16_bf16(an[ks], bI, acc[t], 0, 0, 0); }
    }
#pragma unroll
    for (int t = 0; t < 2; ++t) { const int ch = (cb0 + t) * 32 + r32;
#pragma unroll
        for (int r = 0; r < 16; ++r) { const int k2 = kblk * 32 + crow(r, hi); *(bf16_t*)((char*)Ys + pg8::atile_off(k1 + N1 * k2, (g4 * 128 + ch) & ~7, DM / 64) + (ch & 7) * 2) = bf1(acc[t][r] * rsT); } }
}
}

constexpr int NPH = 52;
__global__ void __launch_bounds__(512, 2) fwd(Args a_unused) {
    extern __shared__ __attribute__((aligned(16))) unsigned char lds_raw[];
    LAS unsigned char* lds = (LAS unsigned char*)lds_raw;
    const int wg = blockIdx.x, nwg = gridDim.x;
    int wv = __builtin_amdgcn_readfirstlane((int)threadIdx.x >> 6); asm volatile("" : "+s"(wv));
    { const int tid0 = opaque_tid(wv); for (int u = tid0; u < (LDS_BYTES - LDSCTL_OFF) / 4; u += 512) ((LAS unsigned*)(lds + LDSCTL_OFF))[u] = 0u; }
    __syncthreads();
    int lo, hi; XcdBarrier bar;
    { KArgs* ka = kargs(); lo = ka->ph_lo; hi = ka->ph_hi; unsigned* barw = (unsigned*)(ka->ws + WS_CTL) + CW_BAR + ka->li * XCD_BAR_WORDS;
      bar.bar = barw; bar.x = 0; bar.st = (volatile LAS unsigned*)(lds + MISC_OFF + 32); bar.wv = wv;
      if (hi - lo > 1) bar = xcd_barrier_post(barw, (volatile LAS unsigned*)(lds + MISC_OFF + 32), wv); }
    int pi = 0;
#define PH_BEGIN if (pi >= lo && pi < hi) { KArgs& a = *kargs(); unsigned char* const ws = a.ws; (void)ws;
#define PH_END   if (pi + 1 < hi) xcd_barrier(bar); } ++pi;

    PH_BEGIN prologue_phase(a, lds, wg, nwg, opaque_tid(wv)); PH_END
    PH_BEGIN prologue2_phase(a, lds, wg, nwg, opaque_tid(wv)); PH_END
    PH_BEGIN { const int t_ = opaque_tid(wv); for (int rep = 0; rep < NREP(6); ++rep) norm_first_phase(a, wg, nwg, __builtin_amdgcn_readfirstlane(t_ >> 6), t_ & 63); } PH_END

    for (int l = 0; l < 2; ++l) {
        for (int s = 0; s < 3; ++s) {
            const bool first = (l == 0 && s == 0);
            if ((DBG_SKIP & 1) && s == 1) { pi += 20; continue; }
            if (s != 1) {
                PH_BEGIN { unsigned char* wl = ws + WS_W + (size_t)l * WLAYER; pg8::PlainOrder S; S.init(ws + WS_H, wl + (s == 0 ? WO_FF1I : WO_FF2I), NTOK, 2 * DFF, DM, DM, nwg, wg, WGM_FFI); S.atile = !first;        pg8::EpiSwiGLU E{(bf16_t*)(ws + WS_BIG), (const float*)(ws + WS_SS) + (size_t)(l * 3 + s) * NTOK, (const float*)(ws + WS_BW) + (size_t)l * 6 * BWL + (s == 0 ? 0 : 27392)};
                           for (int rep = 0; rep < NREP(0); ++rep) pg8::gemm_phase(lds, DM, DM, DM, S, E, wv); } PH_END
                PH_BEGIN { unsigned char* wl = ws + WS_W + (size_t)l * WLAYER; pg8::PlainOrder S; S.init(ws + WS_BIG, wl + (s == 0 ? WO_FF1O : WO_FF2O), NTOK, DM, DFF, DFF, nwg, wg, WGM_FFO);
                           const bool lastsub = (l == 1 && s == 2);
                           pg8::EpiResid E{first ? a.in[I_XP] : (const float*)nullptr, first ? a.in[I_XS] - (size_t)32768 * DM : (const float*)nullptr, (float*)(ws + WS_XF), lastsub ? a.out : (float*)nullptr,
                                           (const float*)(ws + WS_MOD) + (size_t)l * 6 * NMODC, (3 * s + 2) * DM, 0.5f, 0,
                                           lastsub ? (bf16_t*)nullptr : (bf16_t*)(ws + WS_H), (const float*)(ws + WS_AT) + (size_t)(l * 3 + s + 1) * 6 * DM, (float*)(ws + WS_SS) + (size_t)(l * 3 + s + 1) * NTOK};
                           pg8::gemm_phase(lds, DFF, DFF, DFF, S, E, wv); } PH_END
            } else {
                for (int g = 0; g < 4; ++g) {
                    const int T = g < 2 ? 16384 : 8192;
                    PH_BEGIN if (!(DBG_SKIP & 128)) { unsigned char* wl = ws + WS_W + (size_t)l * WLAYER; pg8::PlainOrder S; S.init((bf16_t*)(ws + WS_H) + (size_t)g * GT * DM, wl + WO_IN, GT, NINV, DM, DM, nwg, wg, WGM_INP);
                               pg8::EpiInProj E{(bf16_t*)(ws + WS_Z), (bf16_t*)(ws + WS_G), a.in[I_BGATE] + (size_t)l * 4 * DM, T - 1, (const float*)(ws + WS_SS) + (size_t)(l * 3 + 1) * NTOK, (const float*)(ws + WS_BW) + (size_t)l * 6 * BWL + 11008, g * GT};
                               for (int rep = 0; rep < NREP(1); ++rep) pg8::gemm_phase(lds, DM, DM, DM, S, E, wv); } PH_END
                    PH_BEGIN {
                        bf16_t* Zb = (bf16_t*)(ws + WS_Z); bf16_t* Yb = (bf16_t*)(ws + WS_Y);
                        { const float* lamp = (const float*)(ws + WS_LAM); const float* lng = a.in[I_DLNG] + l * 128;
                          if (!(DBG_SKIP & 2)) for (int rep = 0; rep < NREP(2); ++rep) for (int u = wg; u < 256; u += nwg) { const int x = u & 7, h = x >> 1; int seq, qb;
                            if (T == 16384) { seq = 0; qb = (u >> 3) * 2 + (x & 1); } else { seq = x & 1; qb = u >> 3; }
                            dattn::unit<0>(Zb + (size_t)seq * T * ZR, T, h, qb, lamp, l, lng, Yb + (size_t)seq * T * DM, (u32x4*)(ws + WS_DOS) + (size_t)u * 4096, lds, wv);
#if DBG_PROBE >= 0
                            dattn::unit<DBG_PROBE>(Zb + (size_t)seq * T * ZR, T, h, qb, lamp, l, lng, (bf16_t*)(ws + WS_MG) + (size_t)seq * T * DM, (u32x4*)(ws + WS_DOS) + (size_t)u * 4096, lds, wv);
#endif
                            } }
                        __syncthreads();
                        { const int tid = opaque_tid(wv), lane = tid & 63, wave = __builtin_amdgcn_readfirstlane(tid >> 6);
                          LAS unsigned char* vbuf = lds + wave * wattn::WBUF; const float* relb = a.in[I_RELB] + (size_t)l * 8 * 465;
                          LAS float* tabl = (LAS float*)(lds + 8 * wattn::WBUF);
                          { float tv[8];
#pragma unroll
                            for (int i = 0; i < 8; ++i) { const int e = tid + 512 * i; tv[i] = e < 8 * 465 ? relb[e] : 0.f; }
#pragma unroll
                            for (int i = 0; i < 8; ++i) { const int e = tid + 512 * i; if (e < 8 * 465) tabl[e] = tv[i] * LOG2E; } }
                          __syncthreads();
                          float* DO = (float*)(ws + WS_DILO); float* DL = (float*)(ws + WS_DILL);
                          for (int rep = 0; rep < NREP(3); ++rep) {
                          const int wx = (nwg == 256) ? ((wg & 7) * 32 + (wg >> 3)) : wg;
                          wattn::stream(Zb, Yb, DO, DL, tabl, T, wave, wx, nwg, vbuf);
                          __syncthreads();
                          wattn::dshared(Zb, DO, DL, T, wx, nwg, lds, opaque_tid(wv), wave); }
                          }
                        __syncthreads();
                        { const int tid = opaque_tid(wv); const bf16_t* dft = (const bf16_t*)(ws + WS_DFT); bf16_t* FB = (bf16_t*)(ws + WS_FFTB);
                          for (int rep = 0; rep < NREP(4); ++rep)
                          if (DBG_SKIP & 16) {} else if (T == 16384) { for (int u = wg; u < 512; u += nwg) fftm::pass1<128>(Zb, FB, u >> 2, u & 3, 1, dft, dft, lds, tid); }
                          else { for (int u = wg; u < 1024; u += nwg) { const int seq = u >> 9; fftm::pass1<64>(Zb + (size_t)seq * 8192 * ZR, FB + (size_t)seq * 64 * 128 * 1024, (u >> 2) & 127, u & 3, 2, dft + 49152, dft, lds, tid); } } }
                    } PH_END
                    PH_BEGIN {
                        const int tid = opaque_tid(wv); bf16_t* Yb = (bf16_t*)(ws + WS_Y); const bf16_t* FB = (const bf16_t*)(ws + WS_FFTB); const bf16_t* dft = (const bf16_t*)(ws + WS_DFT); const float* DO = (const float*)(ws + WS_DILO); const float* DL = (const float*)(ws + WS_DILL);
                        for (int rep = 0; rep < NREP(4); ++rep)
                        if (DBG_SKIP & 16) {} else if (T == 16384) { for (int u = wg; u < 512; u += nwg) fftm::pass2<128>(FB, Yb, u >> 2, u & 3, 0.0078125f * 0.08838834764831843f, dft, lds, tid); }
                        else { for (int u = wg; u < 512; u += nwg) { const int seq = u >> 8; fftm::pass2<64>(FB + (size_t)seq * 64 * 128 * 1024, Yb + (size_t)seq * 8192 * DM, (u >> 2) & 63, u & 3, 0.011048543456039806f * 0.08838834764831843f, dft, lds, tid); } }
                        if (DBG_SKIP & 30) { for (int item = wg * 512 + tid; item < GT * 512; item += nwg * 512) { const int row = item >> 9, c4 = item & 511, part = c4 >> 7;
                            const bool z = (part == 0 && (DBG_SKIP & 16)) || (part == 1 && (DBG_SKIP & 4)) || (part == 2 && (DBG_SKIP & 2)) || (part == 3 && (DBG_SKIP & 8));
                            if (z) *(u32x2*)(Yb + (size_t)row * DM + c4 * 4) = ((DBG_SKIP & 64) && part == 1) ? ((DBG_SKIP & 128) ? *(const u32x2*)((const bf16_t*)(ws + WS_H) + ((size_t)g * GT + row) * DM + (c4 - 128) * 4) : *(const u32x2*)((const bf16_t*)(ws + WS_Z) + (size_t)row * ZP + 512 + (c4 - 128) * 4)) : (u32x2){0u, 0u}; } }
                        if (!(DBG_SKIP & 8)) {
                            const bf16_t* DOb = (const bf16_t*)DO; const int istr = nwg * 512;
#pragma unroll 1
                            for (int item0 = wg * 512 + tid; item0 < GT * 128; item0 += 4 * istr) {
                                float Lv[4][3]; u32x2 pv[4][3];
#pragma unroll
                                for (int q = 0; q < 4; ++q) { const int item = item0 + q * istr; const bool ok = item < GT * 128; const int row = ok ? item >> 7 : 0, c4 = item & 127, h = c4 >> 4;
#pragma unroll
                                    for (int gq = 0; gq < 3; ++gq) { Lv[q][gq] = DL[((size_t)gq * GT + row) * 8 + h]; pv[q][gq] = *(const u32x2*)(DOb + ((size_t)gq * GT + row) * 512 + c4 * 4); } }
#pragma unroll
                                for (int q = 0; q < 4; ++q) { const int item = item0 + q * istr; if (item >= GT * 128) break; const int row = item >> 7, c4 = item & 127;
                                    const float L0 = Lv[q][0], L1 = Lv[q][1], L2 = Lv[q][2];
                                    const float mx = fmaxf(L0, fmaxf(L1, L2)); const float w0 = __builtin_amdgcn_exp2f(L0 - mx), w1 = __builtin_amdgcn_exp2f(L1 - mx), w2 = __builtin_amdgcn_exp2f(L2 - mx);
                                    const float inv = __builtin_amdgcn_rcpf(w0 + w1 + w2);
                                    const u32x2 p0 = pv[q][0], p1 = pv[q][1], p2 = pv[q][2];
                                    const f32x4 o = ((f32x4){bf_lo(p0.x), bf_hi(p0.x), bf_lo(p0.y), bf_hi(p0.y)} * w0 + (f32x4){bf_lo(p1.x), bf_hi(p1.x), bf_lo(p1.y), bf_hi(p1.y)} * w1 + (f32x4){bf_lo(p2.x), bf_hi(p2.x), bf_lo(p2.y), bf_hi(p2.y)} * w2) * inv;
                                    u32x2 w; w.x = pk2(o[0], o[1]); w.y = pk2(o[2], o[3]); *(u32x2*)((char*)Yb + pg8::atile_off(row, 1536 + (c4 >> 1) * 8, DM / 64) + (c4 & 1) * 8) = w; } } }
                    } PH_END
                    PH_BEGIN { unsigned char* wl = ws + WS_W + (size_t)l * WLAYER; pg8::MergeOrder S{(const char*)(ws + WS_Y), (const char*)(wl + WO_BR), nwg, wg}; pg8::EpiMerge E{(const bf16_t*)(ws + WS_G), (bf16_t*)(ws + WS_MG)};
                               for (int rep = 0; rep < NREP(5); ++rep) pg8::gemm_hm3(lds, DM, DM, DM, S, E, wv); } PH_END
                    PH_BEGIN { unsigned char* wl = ws + WS_W + (size_t)l * WLAYER; pg8::PlainOrder S; S.init(ws + WS_MG, wl + WO_OUT, GT, DM, DM, DM, nwg, wg);
                               pg8::EpiResid E{(const float*)nullptr, (const float*)nullptr, (float*)(ws + WS_XF), (float*)nullptr, (const float*)(ws + WS_MOD) + (size_t)l * 6 * NMODC, 5 * DM, 1.0f, g * GT,
                                               (bf16_t*)(ws + WS_H), (const float*)(ws + WS_AT) + (size_t)(l * 3 + 2) * 6 * DM, (float*)(ws + WS_SS) + (size_t)(l * 3 + 2) * NTOK};
                               pg8::gemm_phase(lds, DM, DM, DM, S, E, wv); } PH_END
                }
            }
        }
    }
    PH_BEGIN { const int t_ = opaque_tid(wv); final_phase(a, wg, nwg, __builtin_amdgcn_readfirstlane(t_ >> 6), t_ & 63); } PH_END
#undef PH_BEGIN
#undef PH_END
}

extern "C" void kernel_launch(void* const* d_in, const int* in_sizes, int n_in, void* d_out, int out_size, void* d_ws, size_t ws_size, hipStream_t stream) {
    static int grid = 0;
    if (grid == 0) {
        if (n_in != 24 || in_sizes[0] != 32768 * DM || out_size != NTOK * DM || ws_size < WS_END) { fprintf(stderr, "kernel_launch: unexpected shapes (n_in %d, out %d, ws %zu, need %zu)\n", n_in, out_size, ws_size, (size_t)WS_END); grid = -1; return; }
        int dev = 0, cus = 0, per_cu = 0;
        if (hipGetDevice(&dev) != hipSuccess || hipDeviceGetAttribute(&cus, hipDeviceAttributeMultiprocessorCount, dev) != hipSuccess) { grid = -1; return; }
        if (hipFuncSetAttribute((const void*)fwd, hipFuncAttributeMaxDynamicSharedMemorySize, LDS_BYTES) != hipSuccess) { fprintf(stderr, "kernel_launch: hipFuncSetAttribute failed\n"); grid = -1; return; }
        if (hipOccupancyMaxActiveBlocksPerMultiprocessor(&per_cu, (const void*)fwd, 512, LDS_BYTES) != hipSuccess || per_cu < 1) { fprintf(stderr, "kernel_launch: occupancy query says %d\n", per_cu); }
        (void)hipGetLastError();
        grid = cus > 256 ? 256 : cus;
    }
    if (grid < 0) return;
    if (hipMemsetAsync((char*)d_ws + WS_CTL, 0, CTL_ZERO_BYTES, stream) != hipSuccess) return;
    Args a{};
    for (int i = 0; i < 24; ++i) a.in[i] = (const float*)d_in[i];
    a.out = (float*)d_out; a.ws = (unsigned char*)d_ws; a.pad = 0;
#if MK_ONE_LAUNCH
    a.ph_lo = 0; a.ph_hi = NPH; a.li = 0;
    hipLaunchKernelGGL(fwd, dim3(grid), dim3(512), LDS_BYTES, stream, a);
#else
    for (int li = 0; li < NPH; ++li) { a.ph_lo = li; a.ph_hi = li + 1; a.li = 0; hipLaunchKernelGGL(fwd, dim3(grid), dim3(512), LDS_BYTES, stream, a); }
#endif
}
```

```cpp
#include <hip/hip_runtime.h>
#include <cstdio>
#include <cstdint>

#ifndef MK_ONE_LAUNCH
#define MK_ONE_LAUNCH 1
#endif
#ifndef DBG_SKIP
#define DBG_SKIP 0
#endif
#ifndef DBG_REP
#define DBG_REP 0
#endif
#ifndef DBG_PROBE
#define DBG_PROBE -1
#endif
#ifndef WGM_FFI
#define WGM_FFI 4
#endif
#ifndef WGM_INP
#define WGM_INP 8
#endif
#ifndef WGM_FFO
#define WGM_FFO 4
#endif
#ifndef DBG_WPROBE
#define DBG_WPROBE 0
#endif
#define NREP(k) (1 + ((DBG_REP >> (k)) & 1))

#define LAS __attribute__((address_space(3)))
typedef unsigned short bf16_t;
typedef short bf16x8 __attribute__((ext_vector_type(8)));
typedef short s16x4 __attribute__((ext_vector_type(4)));
typedef float f32x4 __attribute__((ext_vector_type(4)));
typedef float f32x2 __attribute__((ext_vector_type(2)));
typedef float f32x16 __attribute__((ext_vector_type(16)));
typedef unsigned u32x4 __attribute__((ext_vector_type(4)));
typedef unsigned u32x2 __attribute__((ext_vector_type(2)));

constexpr int DM = 2048, NTOK = 65536, DFF = 5504, GT = 16384, ZP = 8192, NINV = 16384, NMODC = 18432;
constexpr int ZR = 64;
__host__ __device__ __forceinline__ size_t zoff(int row, int col) { return ((size_t)(col >> 6) * GT + row) * ZR + (col & 63); }
constexpr float EPS = 1e-6f;
constexpr float LOG2E = 1.4426950408889634f;
constexpr float C2 = 0.125f * 1.4426950408889634f;

constexpr size_t MiB = 1u << 20;
constexpr size_t WS_CTL = 0, CTL_ZERO_BYTES = 1 * MiB;
constexpr size_t WS_MOD = 1 * MiB;
constexpr size_t WS_ROPE = 2 * MiB;
constexpr size_t WS_DFT = 3 * MiB;
constexpr size_t WS_LAM = 3 * MiB + 256 * 1024;
constexpr size_t WS_W = 4 * MiB;
constexpr size_t WO_FF1I = 0, WO_FF1O = 45088768, WO_IN = 67633152, WO_BR = 134742016, WO_OUT = 143130624, WO_FF2I = 151519232, WO_FF2O = 196608000, WLAYER = 219152384;
constexpr size_t WS_H = 426 * MiB;
constexpr size_t WS_BIG = 682 * MiB;
constexpr size_t WS_Z = WS_BIG, WS_G = WS_BIG + 272 * MiB, WS_Y = WS_BIG + 528 * MiB, WS_MG = WS_BIG + 592 * MiB, WS_FFTB = WS_BIG + 656 * MiB,
                 WS_DILO = WS_BIG + 688 * MiB, WS_DILL = WS_BIG + 784 * MiB, WS_DOS = WS_BIG + 786 * MiB,
                 WS_SS = WS_BIG + 802 * MiB  ,
                 WS_AT = WS_SS + 2 * MiB  , WS_BW = WS_AT + 1 * MiB  , WS_XF = WS_BW + 2 * MiB  , WS_END = WS_XF + 512 * MiB;
constexpr int BWL = 38400;
static_assert(WS_W + 2 * WLAYER <= WS_H, "weights region");
constexpr int CW_BAR = 4096;

constexpr int LDS_BYTES = 148480;
constexpr int LDSCTL_OFF = 147456;
constexpr int MISC_OFF = LDSCTL_OFF + 320;

__device__ __forceinline__ float bf_lo(unsigned w) { return __uint_as_float(w << 16); }
__device__ __forceinline__ float bf_hi(unsigned w) { return __uint_as_float(w & 0xffff0000u); }
typedef __bf16 bf16x2_t __attribute__((ext_vector_type(2)));
__device__ __forceinline__ unsigned pk2(float lo, float hi) { const f32x2 v = {lo, hi}; const bf16x2_t b = __builtin_convertvector(v, bf16x2_t); return __builtin_bit_cast(unsigned, b); }
__device__ __forceinline__ float swap_max(float x) { auto rr = __builtin_amdgcn_permlane32_swap(__float_as_uint(x), __float_as_uint(x), false, false); return fmaxf(__uint_as_float(rr[0]), __uint_as_float(rr[1])); }
__device__ __forceinline__ float swap_sum(float x) { auto rr = __builtin_amdgcn_permlane32_swap(__float_as_uint(x), __float_as_uint(x), false, false); return __uint_as_float(rr[0]) + __uint_as_float(rr[1]); }
__device__ __forceinline__ int lane_now() { int l; asm volatile("v_mbcnt_lo_u32_b32 %0, -1, 0\n\tv_mbcnt_hi_u32_b32 %0, -1, %0" : "=v"(l)); return l; }
__device__ __forceinline__ int opaque_tid(int wv) { return (wv << 6) | lane_now(); }
__device__ __forceinline__ float wave_sum(float v) {
    v += __uint_as_float((unsigned)__builtin_amdgcn_ds_swizzle((int)__float_as_uint(v), (1 << 10) | 0x1f));
    v += __uint_as_float((unsigned)__builtin_amdgcn_ds_swizzle((int)__float_as_uint(v), (2 << 10) | 0x1f));
    v += __uint_as_float((unsigned)__builtin_amdgcn_ds_swizzle((int)__float_as_uint(v), (4 << 10) | 0x1f));
    v += __uint_as_float((unsigned)__builtin_amdgcn_ds_swizzle((int)__float_as_uint(v), (8 << 10) | 0x1f));
    v += __uint_as_float((unsigned)__builtin_amdgcn_ds_swizzle((int)__float_as_uint(v), (16 << 10) | 0x1f));
    return swap_sum(v);
}
__device__ __forceinline__ int opaque_lane() { return lane_now(); }
__device__ __forceinline__ int brow_of(int row) { return row < 32768 ? (row >> 14) : 2 + ((row - 32768) >> 13); }
__device__ __forceinline__ int crow(int r, int hi) { return (r & 3) + 8 * (r >> 2) + 4 * hi; }

namespace pg8 {
constexpr float ROPE_C0[8] = {1.5915494309e-01f, 3.0863763405e-02f, 5.9851857127e-03f, 1.1606636412e-03f, 2.2507907904e-04f, 4.3647952793e-05f, 8.4643308082e-06f, 1.6414262628e-06f};
constexpr float ROPE_C1[8] = {3.7183271576e-01f, 9.5056171580e-01f, 7.6610377123e-01f, 1.4856494608e-01f, 2.8810122117e-02f, 5.5869379575e-03f, 1.0834343435e-03f, 2.1010256164e-04f};
constexpr int BM = 256, BK = 64, HALF = 128, HTB = HALF * BK * 2, STAGE_BYTES = 8 * HTB, NXCD = 8, WGM = 4;
__host__ __device__ __forceinline__ int lds_byte(int r, int c) { const int st = (r >> 4) * 2 + (c >> 5), rr = r & 15, cc = c & 31, ob = rr * 64 + cc * 2; return st * 1024 + (ob ^ (((ob >> 9) & 1) << 5)); }
__host__ __device__ __forceinline__ void stage_rc(int b, int& R, int& C) { const int st = b / 1024, sb = b % 1024, swz = sb ^ (((sb >> 9) & 1) << 5); R = (st >> 1) * 16 + swz / 64; C = (st & 1) * 32 + (swz % 64) / 2; }
__host__ __device__ __forceinline__ int perm32(int rho) { const int n = rho >> 4, i = rho & 15; return 8 * (i >> 2) + 4 * n + (i & 3); }
__host__ __device__ __forceinline__ size_t atile_off(int r, int k, int nkt) { return ((size_t)((r >> 8) * nkt + (k >> 6)) * 2 + ((r >> 7) & 1)) * 16384 + lds_byte(r & 127, k & 63); }
__host__ __device__ __forceinline__ size_t wtile_off(int v, int k, int nkt) {
    const int rb = v & 127, s = rb & 31, rho = 16 * ((s >> 2) & 1) + 4 * (s >> 3) + (s & 3), R = (rb & ~31) + rho;
    return ((size_t)((v >> 8) * nkt + (k >> 6)) * 2 + ((v >> 7) & 1)) * 16384 + lds_byte(R, k & 63);
}

struct Unit { int pm, pn, pz; const char* a; const char* b; };

__device__ __forceinline__ bool tile_of(int nM, int nN, int G, int c, int i, int& pm, int& pn, int wgm = WGM) {
    const int nwg = nM * nN; const long L = (long)i * G + c; if (L >= nwg) return false;
    int wgid = (int)L; { const int q = nwg / NXCD, r = nwg % NXCD, xcd = wgid % NXCD, off = wgid / NXCD; wgid = (xcd < r ? xcd * (q + 1) : r * (q + 1) + (xcd - r) * q) + off; }
    const int nig = wgm * nN, gid = wgid / nig, fm = gid * wgm, gsz = (nM - fm) < wgm ? (nM - fm) : wgm;
    pm = fm + ((wgid % nig) % gsz); pn = (wgid % nig) / gsz; return true;
}
struct PlainOrder {
    const char* A; const char* Bt; int nM, nN, G, c, wgm; size_t tA, tB; bool atile;
    __device__ __forceinline__ void init(const void* A_, const void* Bt_, int M, int N, int lda, int ldb, int G_, int c_, int wgm_ = WGM) { A = (const char*)A_; Bt = (const char*)Bt_; nM = M / BM; nN = N / BM; G = G_; c = c_; wgm = wgm_; tA = (size_t)BM * lda * 2; tB = (size_t)BM * ldb * 2; atile = true; }
    __device__ __forceinline__ bool next(int i, Unit& u) const { int pm, pn; if (!tile_of(nM, nN, G, c, i, pm, pn, wgm)) return false; u.pm = pm; u.pn = pn; u.pz = 0; u.a = A + (size_t)pm * tA; u.b = Bt + (size_t)pn * tB; return true; }
};
struct MergeOrder {
    const char* A; const char* Bt; int G, c; static constexpr bool atile = false;
    __device__ __forceinline__ bool next(int i, Unit& u) const { int pm, pn; if (!tile_of(64, 8, G, c, i >> 1, pm, pn)) return false; u.pm = pm; u.pn = pn; u.pz = i & 1;
        u.a = A + (size_t)pm * (32 * 32768) + (size_t)(i & 1) * 16384; u.b = Bt + (size_t)pn * (256 * 2048 * 2); return true; }
};

template <class Epi, class Sched, bool HM = false>
__device__ __forceinline__ void gemm_phase(LAS unsigned char* lds, const int K, const int lda, const int ldb, const Sched& S, const Epi& E, const int wv) {
    const int tid = opaque_tid(wv), wid = __builtin_amdgcn_readfirstlane(tid >> 6), lane = tid & 63, wr = wid >> 2, wc = wid & 3, fr = lane & 15, fq = lane >> 4;
    const int nt = K / BK;
    unsigned voffA[2], voffB[2];
#pragma unroll
    for (int i = 0; i < 2; ++i) { int R, C; stage_rc(tid * 16 + i * 8192, R, C); const int Rb = Epi::PERM ? ((R & ~31) + perm32(R & 31)) : R;
        voffA[i] = S.atile ? (unsigned)(tid * 16 + i * 8192) : (unsigned)(R * lda + C) * 2u; voffB[i] = (unsigned)(tid * 16 + i * 8192); (void)Rb; }
    const size_t kstep = S.atile ? (size_t)(2 * HTB) : (size_t)(BK * 2), kstepB = (size_t)(2 * HTB);
    const size_t hstepA = HM ? (size_t)0 : (S.atile ? (size_t)HTB : (size_t)HALF * lda * 2), hstepB = (size_t)HTB;
    const unsigned ldsw = (unsigned)wid * 1024u;
    const int aoff = lds_byte(wr * 64 + fr, fq * 8), boff = lds_byte(wc * 32 + fr, fq * 8);
#define PG8_SA(b, h) (((b) * 2 + (h)) * HTB)
#define PG8_SB(b, h) ((4 + (b) * 2 + (h)) * HTB)
#define PG8_STAGE(bufoff, gbase, voff) do { _Pragma("unroll") for (int _i = 0; _i < 2; ++_i) \
        __builtin_amdgcn_global_load_lds((const unsigned*)((const char*)(gbase) + (voff)[_i]), (LAS unsigned*)(lds + (bufoff) + ldsw + _i * 8192), 16, 0, 0); } while (0)
#define PG8_LDA(dst, b, h) do { _Pragma("unroll") for (int m = 0; m < 4; ++m) _Pragma("unroll") for (int k = 0; k < 2; ++k) dst[m][k] = *(const LAS bf16x8*)(lds + PG8_SA(b, h) + aoff + m * 2048 + k * 1024); } while (0)
#define PG8_LDB(dst, b, h) do { _Pragma("unroll") for (int n = 0; n < 2; ++n) _Pragma("unroll") for (int k = 0; k < 2; ++k) dst[n][k] = *(const LAS bf16x8*)(lds + PG8_SB(b, h) + boff + n * 2048 + k * 1024); } while (0)
#define PG8_MMA(ai, bj, At, Bt) do { __builtin_amdgcn_s_setprio(1); _Pragma("unroll") for (int m = 0; m < 4; ++m) _Pragma("unroll") for (int n = 0; n < 2; ++n) _Pragma("unroll") for (int k = 0; k < 2; ++k) \
        acc[ai][bj][m][n] = __builtin_amdgcn_mfma_f32_16x16x32_bf16(Bt[n][k], At[m][k], acc[ai][bj][m][n], 0, 0, 0); __builtin_amdgcn_s_setprio(0); } while (0)
#define PG8_WAIT_V(n) asm volatile("s_waitcnt vmcnt(" #n ")" ::: "memory")
#define PG8_WAIT_L(n) asm volatile("s_waitcnt lgkmcnt(" #n ")" ::: "memory")
#define PG8_BAR __builtin_amdgcn_s_barrier()
#define PG8_SCHED __builtin_amdgcn_sched_barrier(0)
    Unit cur, nxt; int ui = 0;
    if (!S.next(0, cur)) return;
    f32x4 acc[2][2][4][2];
#pragma unroll
    for (int a = 0; a < 2; ++a)
#pragma unroll
        for (int b = 0; b < 2; ++b)
#pragma unroll
            for (int m = 0; m < 4; ++m)
#pragma unroll
                for (int n = 0; n < 2; ++n) acc[a][b][m][n] = (f32x4){0.f, 0.f, 0.f, 0.f};
    bf16x8 At[4][2], B0[2][2], B1[2][2];
    const char* cA = cur.a; const char* cB = cur.b;
    PG8_STAGE(PG8_SB(0, 0), cB, voffB); PG8_STAGE(PG8_SB(0, 1), cB + hstepB, voffB); PG8_STAGE(PG8_SA(0, 0), cA, voffA); PG8_STAGE(PG8_SA(0, 1), cA + hstepA, voffA);
    if (wr == 1) PG8_BAR;
    PG8_WAIT_V(2); PG8_BAR;
    PG8_STAGE(PG8_SB(1, 0), cB + kstepB, voffB); PG8_STAGE(PG8_SA(1, 0), cA + kstep, voffA); PG8_STAGE(PG8_SB(1, 1), cB + hstepB + kstepB, voffB);
    PG8_WAIT_V(6); PG8_BAR;
    for (;;) {
        const bool has_next = S.next(ui + 1, nxt);
        const char* nA = has_next ? nxt.a : cA; const char* nB = has_next ? nxt.b : cB;
        for (int t = 0; t < nt; t += 2) {
            const bool last = (t == nt - 2);
            const char* a1 = cA + (size_t)(t + 1) * kstep;
            const char* a2 = last ? nA : cA + (size_t)(t + 2) * kstep; const char* b2 = last ? nB : cB + (size_t)(t + 2) * kstepB;
            const char* a3 = a2 + kstep; const char* b3 = b2 + kstepB;
            PG8_LDB(B0, 0, 0); PG8_LDB(B1, 0, 1); PG8_SCHED; PG8_LDA(At, 0, 0); PG8_STAGE(PG8_SA(1, 1), a1 + hstepA, voffA);
            PG8_WAIT_V(8); PG8_WAIT_L(0); PG8_BAR; PG8_MMA(0, 0, At, B0); PG8_MMA(0, 1, At, B1); PG8_BAR; PG8_SCHED;
            if constexpr (!HM) PG8_LDA(At, 0, 1); PG8_STAGE(PG8_SB(0, 0), b2, voffB); PG8_STAGE(PG8_SB(0, 1), b2 + hstepB, voffB); PG8_STAGE(PG8_SA(0, 0), a2, voffA);
            PG8_WAIT_V(8); PG8_WAIT_L(0); PG8_BAR; if constexpr (!HM) { PG8_MMA(1, 0, At, B0); PG8_MMA(1, 1, At, B1); } PG8_BAR; PG8_SCHED;
            PG8_LDB(B0, 1, 0); PG8_LDB(B1, 1, 1); PG8_SCHED; PG8_LDA(At, 1, 0); PG8_STAGE(PG8_SA(0, 1), a2 + hstepA, voffA);
            PG8_WAIT_V(8); PG8_WAIT_L(0); PG8_BAR; PG8_MMA(0, 0, At, B0); PG8_MMA(0, 1, At, B1); PG8_BAR; PG8_SCHED;
            if constexpr (!HM) PG8_LDA(At, 1, 1); PG8_STAGE(PG8_SB(1, 0), b3, voffB); PG8_STAGE(PG8_SB(1, 1), b3 + hstepB, voffB); PG8_STAGE(PG8_SA(1, 0), a3, voffA);
            PG8_WAIT_V(8); PG8_WAIT_L(0); PG8_BAR; if constexpr (!HM) { PG8_MMA(1, 0, At, B0); PG8_MMA(1, 1, At, B1); } PG8_BAR; PG8_SCHED;
            if constexpr (HM) { if (((t + 2) & 7) == 0) E.fold(acc, cur, t >> 3, wr, wc, fr, fq); }
        }
        if (wr == 0) PG8_BAR;
        E(acc, cur, wr, wc, fr, fq);
        if (!has_next) break;
#pragma unroll
        for (int a = 0; a < 2; ++a)
#pragma unroll
            for (int b = 0; b < 2; ++b)
#pragma unroll
                for (int m = 0; m < 4; ++m)
#pragma unroll
                    for (int n = 0; n < 2; ++n) acc[a][b][m][n] = (f32x4){0.f, 0.f, 0.f, 0.f};
        cur = nxt; cA = nA; cB = nB; ++ui;
        if (wr == 1) PG8_BAR;
    }
    PG8_WAIT_V(0);
    PG8_BAR;
#undef PG8_SA
#undef PG8_SB
#undef PG8_STAGE
#undef PG8_LDA
#undef PG8_LDB
#undef PG8_MMA
#undef PG8_WAIT_V
#undef PG8_WAIT_L
#undef PG8_BAR
#undef PG8_SCHED
}

template <class Epi, class Sched>
__device__ __forceinline__ void gemm_hm3(LAS unsigned char* lds, const int K, const int lda, const int ldb, const Sched& S, const Epi& E, const int wv) {
    const int tid = opaque_tid(wv), wid = __builtin_amdgcn_readfirstlane(tid >> 6), lane = tid & 63, wr = wid >> 2, wc = wid & 3, fr = lane & 15, fq = lane >> 4;
    const int nt = K / BK;
    unsigned voffA[2], voffB[2];
#pragma unroll
    for (int i = 0; i < 2; ++i) { int R, C; stage_rc(tid * 16 + i * 8192, R, C); const int Rb = Epi::PERM ? ((R & ~31) + perm32(R & 31)) : R;
        voffA[i] = (unsigned)(tid * 16 + i * 8192); voffB[i] = voffA[i]; (void)R; (void)C; (void)Rb; }
    const size_t kstep = (size_t)(2 * HTB), kstepB = (size_t)(2 * HTB), hstepB = (size_t)HTB;
    const unsigned ldsw = (unsigned)wid * 1024u;
    const int aoff = lds_byte(wr * 64 + fr, fq * 8), boff = lds_byte(wc * 32 + fr, fq * 8);
    constexpr int SLOT = 3 * HTB;
#define H3_STAGE(off, gbase, voff) do { _Pragma("unroll") for (int _i = 0; _i < 2; ++_i) \
        __builtin_amdgcn_global_load_lds((const unsigned*)((const char*)(gbase) + (voff)[_i]), (LAS unsigned*)(lds + (off) + ldsw + _i * 8192), 16, 0, 0); } while (0)
#define H3_STAGE3(sl, ga, gb) do { H3_STAGE((sl), (gb), voffB); H3_STAGE((sl) + HTB, (gb) + hstepB, voffB); H3_STAGE((sl) + 2 * HTB, (ga), voffA); } while (0)
#define H3_LDA(dst, sl) do { _Pragma("unroll") for (int m = 0; m < 4; ++m) _Pragma("unroll") for (int k = 0; k < 2; ++k) dst[m][k] = *(const LAS bf16x8*)(lds + (sl) + 2 * HTB + aoff + m * 2048 + k * 1024); } while (0)
#define H3_LDB(dst, sl, h) do { _Pragma("unroll") for (int n = 0; n < 2; ++n) _Pragma("unroll") for (int k = 0; k < 2; ++k) dst[n][k] = *(const LAS bf16x8*)(lds + (sl) + (h) * HTB + boff + n * 2048 + k * 1024); } while (0)
#define H3_MMA(bj, At, Bt) do { __builtin_amdgcn_s_setprio(1); _Pragma("unroll") for (int m = 0; m < 4; ++m) _Pragma("unroll") for (int n = 0; n < 2; ++n) _Pragma("unroll") for (int k = 0; k < 2; ++k) \
        acc[0][bj][m][n] = __builtin_amdgcn_mfma_f32_16x16x32_bf16(Bt[n][k], At[m][k], acc[0][bj][m][n], 0, 0, 0); __builtin_amdgcn_s_setprio(0); } while (0)
#define H3_BAR __builtin_amdgcn_s_barrier()
    Unit cur, nxt; int ui = 0;
    if (!S.next(0, cur)) return;
    f32x4 acc[2][2][4][2];
#pragma unroll
    for (int a = 0; a < 2; ++a)
#pragma unroll
        for (int b = 0; b < 2; ++b)
#pragma unroll
            for (int m = 0; m < 4; ++m)
#pragma unroll
                for (int n = 0; n < 2; ++n) acc[a][b][m][n] = (f32x4){0.f, 0.f, 0.f, 0.f};
    bf16x8 At[4][2], B0[2][2], B1[2][2]; u32x2 gw[4][2];
    const char* cA = cur.a; const char* cB = cur.b;
    int sl = 0, sl2 = 2 * SLOT;
    H3_STAGE3(0, cA, cB); H3_STAGE3(SLOT, cA + kstep, cB + kstepB);
    asm volatile("s_waitcnt vmcnt(6)" ::: "memory"); H3_BAR;
    if (wr == 1) H3_BAR;
    for (;;) {
        const bool has_next = S.next(ui + 1, nxt);
        const char* nA = has_next ? nxt.a : cA; const char* nB = has_next ? nxt.b : cB;
        for (int t = 0; t < nt; ++t) {
            const bool own = (t + 2 < nt);
            const char* a2 = (own ? cA : nA) + (size_t)(own ? t + 2 : t + 2 - nt) * kstep; const char* b2 = (own ? cB : nB) + (size_t)(own ? t + 2 : t + 2 - nt) * kstepB;
            H3_LDB(B0, sl, 0); H3_LDB(B1, sl, 1); __builtin_amdgcn_sched_barrier(0); H3_LDA(At, sl); H3_STAGE3(sl2, a2, b2);
            const int ph_ = t & 7;
            if (ph_ == 6) { E.fold_load(gw, cur, t >> 3, wr, wc, fr, fq); __builtin_amdgcn_sched_barrier(0); }
            if (ph_ >= 6) asm volatile("s_waitcnt vmcnt(14)" ::: "memory"); else asm volatile("s_waitcnt vmcnt(6)" ::: "memory");
            asm volatile("s_waitcnt lgkmcnt(0)" ::: "memory"); H3_BAR; H3_MMA(0, At, B0); H3_MMA(1, At, B1); H3_BAR; __builtin_amdgcn_sched_barrier(0);
            sl = (sl == 2 * SLOT) ? 0 : sl + SLOT; sl2 = (sl2 == 2 * SLOT) ? 0 : sl2 + SLOT;
            if (ph_ == 7) E.fold_apply(acc, gw, t >> 3);
        }
        if (wr == 0) H3_BAR;
        E(acc, cur, wr, wc, fr, fq);
        if (!has_next) break;
#pragma unroll
        for (int a = 0; a < 2; ++a)
#pragma unroll
            for (int b = 0; b < 2; ++b)
#pragma unroll
                for (int m = 0; m < 4; ++m)
#pragma unroll
                    for (int n = 0; n < 2; ++n) acc[a][b][m][n] = (f32x4){0.f, 0.f, 0.f, 0.f};
        cur = nxt; cA = nA; cB = nB; ++ui;
        if (wr == 1) H3_BAR;
    }
    asm volatile("s_waitcnt vmcnt(0)" ::: "memory");
    H3_BAR;
#undef H3_STAGE
#undef H3_STAGE3
#undef H3_LDA
#undef H3_LDB
#undef H3_MMA
#undef H3_BAR
}

__device__ __forceinline__ float silu_f(float a) { return a * __builtin_amdgcn_rcpf(1.0f + __builtin_amdgcn_exp2f(-a * LOG2E)); }
__device__ __forceinline__ float sigm_f(float a) { return __builtin_amdgcn_rcpf(1.0f + __builtin_amdgcn_exp2f(-a * LOG2E)); }
__device__ __forceinline__ unsigned gq8(float g) { return (unsigned)(g * 255.0f + 0.5f); }
__device__ __forceinline__ unsigned gq8x4(float a, float b, float c, float d) { return gq8(a) | (gq8(b) << 8) | (gq8(c) << 16) | (gq8(d) << 24); }

struct EpiSwiGLU {
    static constexpr bool PERM = true;
    bf16_t* O; const float* ss; const float* bwl;
    __device__ __forceinline__ void operator()(const f32x4 (&acc)[2][2][4][2], const Unit& u, int wr, int wc, int fr, int fq) const {
        const int row0 = u.pm * BM + wr * 64 + fr, col0 = u.pn * 128 + wc * 32 + 8 * fq;
        const float* bw = bwl + (size_t)brow_of(u.pm * BM) * BWL + u.pn * BM + wc * 32 + 8 * fq;
        const f32x4 ba0 = *(const f32x4*)bw, ba1 = *(const f32x4*)(bw + 4), bb0 = *(const f32x4*)(bw + HALF), bb1 = *(const f32x4*)(bw + HALF + 4);
        float rsv[2][4];
#pragma unroll
        for (int ai = 0; ai < 2; ++ai)
#pragma unroll
            for (int m = 0; m < 4; ++m) rsv[ai][m] = ss[row0 + ai * HALF + m * 16];
#pragma unroll
        for (int ai = 0; ai < 2; ++ai)
#pragma unroll
            for (int m = 0; m < 4; ++m) rsv[ai][m] = __builtin_amdgcn_rsqf(rsv[ai][m] * (1.0f / DM) + EPS);
#pragma unroll
        for (int ai = 0; ai < 2; ++ai)
#pragma unroll
            for (int m = 0; m < 4; ++m) { const int row = row0 + ai * HALF + m * 16; const float rs = rsv[ai][m];
                const f32x4 a0 = acc[ai][0][m][0] * rs + ba0, a1 = acc[ai][0][m][1] * rs + ba1, b0 = acc[ai][1][m][0] * rs + bb0, b1 = acc[ai][1][m][1] * rs + bb1;
                u32x4 w;
                w.x = pk2(silu_f(a0[0]) * b0[0], silu_f(a0[1]) * b0[1]); w.y = pk2(silu_f(a0[2]) * b0[2], silu_f(a0[3]) * b0[3]);
                w.z = pk2(silu_f(a1[0]) * b1[0], silu_f(a1[1]) * b1[1]); w.w = pk2(silu_f(a1[2]) * b1[2], silu_f(a1[3]) * b1[3]);
                __builtin_nontemporal_store(w, (u32x4*)((char*)O + atile_off(row, col0, DFF / 64)));
            }
    }
};
struct EpiResid {
    static constexpr bool PERM = true;
    const float* base_p; const float* base_s;
    float* xf; float* out;
    const float* mod_l; int gofs; float coef; int rowbase;
    bf16_t* xa; const float* atab; float* ssn;
    __device__ __forceinline__ void operator()(const f32x4 (&acc)[2][2][4][2], const Unit& u, int wr, int wc, int fr, int fq) const {
        const int rabs0 = rowbase + u.pm * BM; const int br = brow_of(rabs0);
        const float* base = rabs0 < 32768 ? base_p : base_s;
        const float* g = mod_l + (size_t)br * NMODC + gofs;
        const int row0 = rabs0 + wr * 64 + fr, col0 = u.pn * BM + wc * 32 + 8 * fq;
        float* xt = xf + ((size_t)((rabs0 >> 8) * 8 + u.pn) << 16) + ((wr * 4 + wc) * 64 + fq * 16 + fr) * 4;
        f32x4 gv[2][2], av[2][2];
#pragma unroll
        for (int bj = 0; bj < 2; ++bj)
#pragma unroll
            for (int n = 0; n < 2; ++n) { gv[bj][n] = *(const f32x4*)(g + col0 + bj * HALF + n * 4) * coef; av[bj][n] = xa ? *(const f32x4*)(atab + (size_t)br * DM + col0 + bj * HALF + n * 4) : (f32x4){0.f, 0.f, 0.f, 0.f}; }
#pragma unroll
        for (int aq = 0; aq < 4; ++aq) { const int ai = aq >> 1, mb = (aq & 1) * 2;
            f32x4 bs[2][2][2];
#pragma unroll
            for (int mi = 0; mi < 2; ++mi) { const size_t off = (size_t)(row0 + ai * HALF + (mb + mi) * 16) * DM + col0; const int pc = ((ai * 4 + mb + mi) * 2) * 2;
#pragma unroll
                for (int bj = 0; bj < 2; ++bj)
#pragma unroll
                    for (int n = 0; n < 2; ++n) bs[mi][bj][n] = base_p ? __builtin_nontemporal_load((const f32x4*)(base + off + bj * HALF + n * 4)) : *(const f32x4*)(xt + (pc + bj * 2 + n) * 2048); }
#pragma unroll
            for (int mi = 0; mi < 2; ++mi) { const int m = mb + mi; const size_t off = (size_t)(row0 + ai * HALF + m * 16) * DM + col0; const int pc = ((ai * 4 + m) * 2) * 2; float sq = 0.f;
#pragma unroll
                for (int bj = 0; bj < 2; ++bj) { const f32x4 x0 = bs[mi][bj][0] + gv[bj][0] * acc[ai][bj][m][0], x1 = bs[mi][bj][1] + gv[bj][1] * acc[ai][bj][m][1];
                    if (out) { __builtin_nontemporal_store(x0, (f32x4*)(out + off + bj * HALF)); __builtin_nontemporal_store(x1, (f32x4*)(out + off + bj * HALF + 4)); }
                    else { __builtin_nontemporal_store(x0, (f32x4*)(xt + (pc + bj * 2) * 2048)); __builtin_nontemporal_store(x1, (f32x4*)(xt + (pc + bj * 2 + 1) * 2048)); }
                    if (xa) { const f32x4 y0 = x0 * av[bj][0], y1 = x1 * av[bj][1]; u32x4 w; w.x = pk2(y0[0], y0[1]); w.y = pk2(y0[2], y0[3]); w.z = pk2(y1[0], y1[1]); w.w = pk2(y1[2], y1[3]);
                              __builtin_nontemporal_store(w, (u32x4*)((char*)xa + atile_off(row0 + ai * HALF + m * 16, col0 + bj * HALF, DM / 64)));
                              sq += ((x0[0] * x0[0] + x0[1] * x0[1]) + (x0[2] * x0[2] + x0[3] * x0[3])) + ((x1[0] * x1[0] + x1[1] * x1[1]) + (x1[2] * x1[2] + x1[3] * x1[3])); } }
                if (xa) {
                    sq += __uint_as_float((unsigned)__builtin_amdgcn_ds_swizzle((int)__float_as_uint(sq), (16 << 10) | 0x1f)); sq = swap_sum(sq);
                    if (fq == 0) atomicAdd(ssn + row0 + ai * HALF + m * 16, sq); } }
        }
    }
};
struct EpiInProj {
    static constexpr bool PERM = true;
    bf16_t* Z; bf16_t* G; const float* bgate; int tmask; const float* ss; const float* bw; int rowbase;
    __device__ __forceinline__ void operator()(const f32x4 (&acc)[2][2][4][2], const Unit& u, int wr, int wc, int fr, int fq) const {
        const int row0 = u.pm * BM + wr * 64 + fr;
        const float* bwp = bw + (size_t)brow_of(rowbase + u.pm * BM) * BWL + u.pn * BM + wc * 32 + 8 * fq;
        const f32x4 bq00 = *(const f32x4*)bwp, bq01 = *(const f32x4*)(bwp + 4), bq10 = *(const f32x4*)(bwp + HALF), bq11 = *(const f32x4*)(bwp + HALF + 4);
        float rsv[2][4];
#pragma unroll
        for (int ai = 0; ai < 2; ++ai)
#pragma unroll
            for (int m = 0; m < 4; ++m) rsv[ai][m] = ss[rowbase + row0 + ai * HALF + m * 16];
#pragma unroll
        for (int ai = 0; ai < 2; ++ai)
#pragma unroll
            for (int m = 0; m < 4; ++m) rsv[ai][m] = __builtin_amdgcn_rsqf(rsv[ai][m] * (1.0f / DM) + EPS);
        if (u.pn < 32) {
            const int col0 = u.pn * BM + wc * 32 + 8 * fq;
            const bool ropet = (u.pn >= 8 && u.pn < 12) || (u.pn >= 14 && u.pn < 26);
            const bool rot = ropet && ((wc & 1) == 0) && (fq < 2);
            float rc0[4] = {0.f, 0.f, 0.f, 0.f}, rc1[4] = {0.f, 0.f, 0.f, 0.f};
            if (rot) {
#pragma unroll
                for (int e = 0; e < 4; ++e) { rc0[e] = fq ? ROPE_C0[4 + e] : ROPE_C0[e]; rc1[e] = fq ? ROPE_C1[4 + e] : ROPE_C1[e]; } }
#pragma unroll
            for (int ai = 0; ai < 2; ++ai)
#pragma unroll
                for (int m = 0; m < 4; ++m) { const int row = row0 + ai * HALF + m * 16; const float rs = rsv[ai][m];
                    float cc[4] = {1.f, 1.f, 1.f, 1.f}, sn[4] = {0.f, 0.f, 0.f, 0.f};
                    if (rot) { const int pos = row & tmask; const float ph = (float)(pos >> 7), pl = (float)(pos & 127);
#pragma unroll
                        for (int e = 0; e < 4; ++e) { const float c0 = rc0[e], c1 = rc1[e];
                            float rev = ph * c1 + pl * c0; rev = rev - __builtin_floorf(rev); cc[e] = __builtin_amdgcn_cosf(rev); sn[e] = __builtin_amdgcn_sinf(rev); } }
#pragma unroll
                    for (int bj = 0; bj < 2; ++bj) { f32x4 v0 = acc[ai][bj][m][0] * rs + (bj ? bq10 : bq00), v1 = acc[ai][bj][m][1] * rs + (bj ? bq11 : bq01);
                        if (u.pn == 2 || u.pn == 3 || u.pn == 8 || u.pn == 9 || (u.pn >= 14 && u.pn < 20)) { v0 *= C2; v1 *= C2; }
                        if (rot) {
#pragma unroll
                            for (int e = 0; e < 4; ++e) { const float x1 = v0[e], x2 = v1[e]; v0[e] = x1 * cc[e] - x2 * sn[e]; v1[e] = x2 * cc[e] + x1 * sn[e]; } }
                        u32x4 w; w.x = pk2(v0[0], v0[1]); w.y = pk2(v0[2], v0[3]); w.z = pk2(v1[0], v1[1]); w.w = pk2(v1[2], v1[3]);
                        __builtin_nontemporal_store(w, (u32x4*)(Z + zoff(row, col0 + bj * HALF))); } }
        } else {
            const int col0 = (u.pn - 32) * BM + wc * 32 + 8 * fq;
            f32x4 bv[2][2];
#pragma unroll
            for (int bj = 0; bj < 2; ++bj)
#pragma unroll
                for (int n = 0; n < 2; ++n) bv[bj][n] = *(const f32x4*)(bgate + col0 + bj * HALF + 4 * n);
#pragma unroll
            for (int ai = 0; ai < 2; ++ai)
#pragma unroll
                for (int m = 0; m < 4; ++m) { const int row = row0 + ai * HALF + m * 16; const float rs = rsv[ai][m];
#pragma unroll
                    for (int bj = 0; bj < 2; ++bj) { const f32x4 v0 = acc[ai][bj][m][0] * rs + (bv[bj][0] + (bj ? bq10 : bq00)), v1 = acc[ai][bj][m][1] * rs + (bv[bj][1] + (bj ? bq11 : bq01));
                        u32x2 w; w.x = gq8x4(sigm_f(v0[0]), sigm_f(v0[1]), sigm_f(v0[2]), sigm_f(v0[3])); w.y = gq8x4(sigm_f(v1[0]), sigm_f(v1[1]), sigm_f(v1[2]), sigm_f(v1[3]));
                        __builtin_nontemporal_store(w, (u32x2*)((unsigned char*)G + ((size_t)(u.pm * 32 + (u.pn - 32)) << 16) + ai * 32768 + (m * 2 + bj) * 4096 + (wr * 4 + wc) * 512 + (fq * 16 + fr) * 8)); } }
        }
    }
};
struct EpiMerge {
    static constexpr bool PERM = true;
    const bf16_t* G; bf16_t* Mg;
    __device__ __forceinline__ void fold_load(u32x2 (&gw)[4][2], const Unit& u, int n, int wr, int wc, int fr, int fq) const {
        const int row0 = u.pm * BM + u.pz * HALF + wr * 64 + fr, col0 = u.pn * BM + wc * 32 + 8 * fq;
#pragma unroll
        for (int m = 0; m < 4; ++m)
#pragma unroll
            for (int bj = 0; bj < 2; ++bj) gw[m][bj] = __builtin_nontemporal_load((const u32x2*)((const unsigned char*)G + ((size_t)(u.pm * 32 + n * 8 + u.pn) << 16) + u.pz * 32768 + (m * 2 + bj) * 4096 + (wr * 4 + wc) * 512 + (fq * 16 + fr) * 8));
    }
    __device__ __forceinline__ void fold_apply(f32x4 (&acc)[2][2][4][2], const u32x2 (&gw)[4][2], int n) const {
#pragma unroll
        for (int m = 0; m < 4; ++m)
#pragma unroll
            for (int bj = 0; bj < 2; ++bj) { const u32x2 g = gw[m][bj]; f32x4& v0 = acc[0][bj][m][0]; f32x4& v1 = acc[0][bj][m][1];
                const f32x4 g0 = (f32x4){(float)(g.x & 255u), (float)((g.x >> 8) & 255u), (float)((g.x >> 16) & 255u), (float)(g.x >> 24)} * (1.0f / 255.0f);
                const f32x4 g1 = (f32x4){(float)(g.y & 255u), (float)((g.y >> 8) & 255u), (float)((g.y >> 16) & 255u), (float)(g.y >> 24)} * (1.0f / 255.0f);
                if (n == 0) { acc[1][bj][m][0] = g0 * v0; acc[1][bj][m][1] = g1 * v1; }
                else { acc[1][bj][m][0] += g0 * v0; acc[1][bj][m][1] += g1 * v1; }
                v0 = (f32x4){0.f, 0.f, 0.f, 0.f}; v1 = (f32x4){0.f, 0.f, 0.f, 0.f}; }
    }
    __device__ __forceinline__ void fold(f32x4 (&acc)[2][2][4][2], const Unit& u, int n, int wr, int wc, int fr, int fq) const { u32x2 gw[4][2]; fold_load(gw, u, n, wr, wc, fr, fq); fold_apply(acc, gw, n); }
    __device__ __forceinline__ void operator()(const f32x4 (&acc)[2][2][4][2], const Unit& u, int wr, int wc, int fr, int fq) const {
        const int row0 = u.pm * BM + u.pz * HALF + wr * 64 + fr, col0 = u.pn * BM + wc * 32 + 8 * fq;
#pragma unroll
        for (int m = 0; m < 4; ++m)
#pragma unroll
            for (int bj = 0; bj < 2; ++bj) { const f32x4 v0 = acc[1][bj][m][0], v1 = acc[1][bj][m][1];
                u32x4 w; w.x = pk2(v0[0], v0[1]); w.y = pk2(v0[2], v0[3]); w.z = pk2(v1[0], v1[1]); w.w = pk2(v1[2], v1[3]);
                __builtin_nontemporal_store(w, (u32x4*)((char*)Mg + atile_off(row0 + m * 16, col0 + bj * HALF, DM / 64))); }
    }
};
}

#define XB_TMO      128
#define XB_XCNT(j)  (256  + 64 * (j))
#define XB_XSUB(j)  (1280 + 64 * (j))
#define XB_XGEN(j)  (2304 + 64 * (j))
#define XB_TOP      3328
#define XB_TOPGEN   3392
#define XCD_BAR_WORDS 3456
#define XB_SPIN_CAP (1u << 24)
__device__ __forceinline__ unsigned xb_ld(unsigned* p)              { return __hip_atomic_load(p, __ATOMIC_RELAXED, __HIP_MEMORY_SCOPE_AGENT); }
__device__ __forceinline__ unsigned xb_add(unsigned* p, unsigned v) { return __hip_atomic_fetch_add(p, v, __ATOMIC_RELAXED, __HIP_MEMORY_SCOPE_AGENT); }
__device__ __forceinline__ unsigned xb_xcc_id() { return (unsigned)__builtin_amdgcn_s_getreg((3 << 11) | 20) & 0xFu; }
#define XB_SPIN(cond, bar) do { unsigned _sp = 0; while (cond) { __builtin_amdgcn_s_sleep(1); \
    if ((++_sp & 255u) == 0u) { if (xb_ld(&(bar)[XB_TMO])) break; if (_sp > XB_SPIN_CAP) { atomicAdd(&(bar)[XB_TMO], 1u); break; } } } } while (0)
struct XcdBarrier { unsigned* bar; unsigned x; volatile LAS unsigned* st; int wv; };
__device__ __forceinline__ XcdBarrier xcd_barrier_post(unsigned* bar, volatile LAS unsigned* st, int wv) {
    XcdBarrier b; b.bar = bar; b.x = xb_xcc_id(); b.st = st; b.wv = wv;
    if (opaque_tid(wv) == 0) (void)xb_add(&bar[XB_XCNT(b.x)], 1u);
    return b;
}
__device__ __forceinline__ void xcd_barrier_complete(unsigned* bar, unsigned x, unsigned& nloc, unsigned& nx) {
    const unsigned G = gridDim.x * gridDim.y * gridDim.z;
    unsigned sum, cnt, mine, sp = 0u;
    for (;;) {
        sum = 0u; cnt = 0u; mine = 0u;
#pragma unroll
        for (unsigned j = 0; j < 16; ++j) { const unsigned c = xb_ld(&bar[XB_XCNT(j)]); sum += c; cnt += (c > 0u) ? 1u : 0u; mine = (j == x) ? c : mine; }
        if (sum == G) break;
        __builtin_amdgcn_s_sleep(1);
        if ((++sp & 255u) == 0u) { if (xb_ld(&bar[XB_TMO])) break; if (sp > XB_SPIN_CAP) { atomicAdd(&bar[XB_TMO], 1u); break; } }
    }
    nloc = mine > 0u ? mine : 1u; nx = cnt > 0u ? cnt : 1u;
}
__device__ __forceinline__ void xcd_barrier(const XcdBarrier& b) {
    asm volatile("s_waitcnt vmcnt(0)" ::: "memory");
    __syncthreads();
    if (opaque_tid(b.wv) == 0) {
        unsigned* bar = b.bar;
        __builtin_amdgcn_s_waitcnt(0);
        unsigned nloc = b.st[0], nx = b.st[1];
        if (nloc == 0u) { xcd_barrier_complete(bar, b.x, nloc, nx); b.st[0] = nloc; b.st[1] = nx; }
        const unsigned old = xb_add(&bar[XB_XSUB(b.x)], 1u);
        const unsigned gen = old / nloc;
        if (old + 1u == (gen + 1u) * nloc) {
            __builtin_amdgcn_fence(__ATOMIC_RELEASE, "agent");
            asm volatile("s_waitcnt vmcnt(0)" ::: "memory");
            const unsigned og = xb_add(&bar[XB_TOP], 1u);
            const unsigned tg = og / nx;
            if (og + 1u == (tg + 1u) * nx) xb_add(&bar[XB_TOPGEN], 1u);
            else XB_SPIN(xb_ld(&bar[XB_TOPGEN]) == tg, bar);
            __builtin_amdgcn_fence(__ATOMIC_ACQUIRE, "agent");
            xb_add(&bar[XB_XGEN(b.x)], 1u);
            asm volatile("s_waitcnt vmcnt(0)" ::: "memory");
        } else {
            XB_SPIN(xb_ld(&bar[XB_XGEN(b.x)]) == gen, bar);
            __builtin_amdgcn_fence(__ATOMIC_ACQUIRE, "agent");
            asm volatile("s_waitcnt vmcnt(0)" ::: "memory");
        }
    }
    __syncthreads();
}

struct Args { const float* in[24]; float* out; unsigned char* ws; int ph_lo, ph_hi, li, pad; };
typedef const __attribute__((address_space(4))) Args KArgs;
__device__ __forceinline__ KArgs* kargs() { KArgs* p = (KArgs*)__builtin_amdgcn_kernarg_segment_ptr(); asm volatile("" : "+s"(p)); return p; }
enum { I_XP = 0, I_XS, I_CP, I_CS, I_WADA, I_BADA, I_GFF1, I_WFF1I, I_WFF1O, I_GMIX, I_WIN, I_BGATE, I_RELB, I_LQ1, I_LK1, I_LQ2, I_LK2, I_DLNG, I_WBR, I_WOUT, I_GFF2, I_WFF2I, I_WFF2O, I_GFIN };

__device__ __forceinline__ int srcmap(int kind, int v) {
    if (kind == 1) return ((v >> 7) & 1) * DFF + (v >> 8) * 128 + (v & 127);
    if (kind == 2) { const int o = v; const bool rp = (o >= 2048 && o < 3072) || (o >= 3584 && o < 6656);
        if (rp && (o & 63) < 16) { const int d = o & 15; const int pd = (d & 3) | ((d & 4) << 1) | ((d & 8) >> 1); return (o & ~15) + pd; }
        return o; }
    return v;
}
__device__ __forceinline__ void conv_tile(const float* src, int ldsrc, bf16_t* dst, int K, int v0, int k0, int kind, LAS float* tile, int tid) {
    __syncthreads();
#pragma unroll
    for (int i = 0; i < 8; ++i) { const int idx = tid + 512 * i, kk = idx >> 6, vv = idx & 63;
        tile[vv * 65 + kk] = src[(size_t)(k0 + kk) * ldsrc + srcmap(kind, v0 + vv)]; }
    __syncthreads();
    const int vv = tid >> 3, kc = tid & 7; const LAS float* s = tile + vv * 65 + kc * 8;
    u32x4 o; o.x = pk2(s[0], s[1]); o.y = pk2(s[2], s[3]); o.z = pk2(s[4], s[5]); o.w = pk2(s[6], s[7]);
    *(u32x4*)((char*)dst + pg8::wtile_off(v0 + vv, k0 + kc * 8, K >> 6)) = o;
}
__device__ __forceinline__ void fold_tile(const float* win_l, bf16_t* dst, int v0, int k0, LAS float* S  , LAS float* tc, LAS float* tsn, int tid) {
    __syncthreads();
    if (tid < 128) { const float x = (float)tid * (1.0f / 128.0f); tc[tid] = __builtin_amdgcn_cosf(x) * 0.08838834764831843f; tsn[tid] = __builtin_amdgcn_sinf(x) * 0.08838834764831843f; }
    const int g = v0 >> 8, isq = (v0 >> 7) & 1, cp0 = v0 & 127;
#pragma unroll
    for (int i = 0; i < 16; ++i) { const int idx = tid + 512 * i, kk = idx >> 7, c = idx & 127;
        S[kk * 129 + c] = win_l[(size_t)(k0 + kk) * 16384 + g * 128 + c]; }
    __syncthreads();
    const int vv = tid >> 3, kc = tid & 7, cp = cp0 + vv; const LAS float* tr = isq ? tsn : tc;
    float o[8] = {0.f, 0.f, 0.f, 0.f, 0.f, 0.f, 0.f, 0.f};
    for (int c = 0; c < 128; ++c) { const float w = tr[(c * cp) & 127];
#pragma unroll
        for (int j = 0; j < 8; ++j) o[j] += S[(kc * 8 + j) * 129 + c] * w; }
    u32x4 ov; ov.x = pk2(o[0], o[1]); ov.y = pk2(o[2], o[3]); ov.z = pk2(o[4], o[5]); ov.w = pk2(o[6], o[7]);
    *(u32x4*)(dst + (size_t)(v0 + vv) * DM + k0 + kc * 8) = ov;
}
__device__ __forceinline__ bf16_t fftm_bf1(float x) { return (bf16_t)(pk2(x, 0.f) & 0xffffu); }
__constant__ double ROPE_INV[8] = {1.0, 0.19392274474868576, 0.03760603093086393, 0.007292664737217109, 0.001414213562373095, 0.0002742481756762073, 5.318295896944988e-05, 1.031338537721246e-05};

__device__ __forceinline__ void ada_task(KArgs& a, int l, int jb, float* mod, LAS float* sc  , LAS float* red  , int tid) {
    __syncthreads();
#pragma unroll 1
    for (int i0 = 0; i0 < 6 * DM; i0 += 8 * 512) {
        float cv[8];
#pragma unroll
        for (int j = 0; j < 8; ++j) { const int i = i0 + j * 512 + tid, br = i >> 11, k = i & 2047; cv[j] = br < 2 ? a.in[I_CP][br * DM + k] : a.in[I_CS][(br - 2) * DM + k]; }
#pragma unroll
        for (int j = 0; j < 8; ++j) sc[i0 + j * 512 + tid] = cv[j] * pg8::sigm_f(cv[j]); }
    __syncthreads();
    const int jq = tid & 7, kp = tid >> 3, j0 = jb * 32;
    const float* w = a.in[I_WADA] + ((size_t)l * DM + kp * 32) * NMODC + j0 + 4 * jq;
    f32x4 acc[6];
#pragma unroll
    for (int br = 0; br < 6; ++br) acc[br] = (f32x4){0.f, 0.f, 0.f, 0.f};
    for (int k = 0; k < 32; ++k) { const f32x4 wv = *(const f32x4*)(w + (size_t)k * NMODC);
#pragma unroll
        for (int br = 0; br < 6; ++br) acc[br] += wv * sc[br * DM + kp * 32 + k]; }
#pragma unroll
    for (int br = 0; br < 6; ++br) *(LAS f32x4*)(red + (kp * 6 + br) * 32 + 4 * jq) = acc[br];
    __syncthreads();
    if (tid < 192) { const int br = tid >> 5, j = tid & 31; float s = a.in[I_BADA][(size_t)l * NMODC + j0 + j];
        for (int k = 0; k < 64; ++k) s += red[(k * 6 + br) * 32 + j];
        mod[((size_t)l * 6 + br) * NMODC + j0 + j] = s; }
}

constexpr int NT_ADA = 2 * 576, NT_FOLD = 0, NT_FFI = 5504, NT_FFO = 2752, NT_IN = 8192, NT_BR = 1024, NT_OUT = 1024;
constexpr int NT_LAYER = 2 * NT_FFI + 2 * NT_FFO + NT_IN + NT_BR + NT_OUT;
constexpr int NT_ROPE = 256, NT_DFT = 40, NT_ZSS = 192, NT_LAM = 1;
constexpr int NT_PRO = NT_ADA + NT_FOLD + 2 * NT_LAYER + NT_ROPE + NT_DFT + NT_ZSS + NT_LAM;

__device__ __forceinline__ void prologue_phase(KArgs& a, LAS unsigned char* lds, int wg, int nwg, int tid) {
    unsigned char* ws = a.ws;
    float* mod = (float*)(ws + WS_MOD);
    LAS float* L = (LAS float*)lds;
    for (int t = wg; t < NT_PRO; t += nwg) {
        int r = t;
        if (r < NT_ADA) { ada_task(a, r / 576, r % 576, mod, L, L + 6 * DM, tid); continue; } r -= NT_ADA;
        if (r < NT_FOLD) { const int l = r >> 9, q = r & 511; fold_tile(a.in[I_WIN] + (size_t)l * DM * 16384, (bf16_t*)(ws + WS_W + l * WLAYER + WO_IN), (q >> 5) * 64, (q & 31) * 64, L, L + 64 * 129, L + 64 * 129 + 128, tid); continue; } r -= NT_FOLD;
        if (r < 2 * NT_LAYER) { const int l = r / NT_LAYER; int q = r % NT_LAYER; unsigned char* wl = ws + WS_W + l * WLAYER;
            if (q < NT_FFI) { conv_tile(a.in[I_WFF1I] + (size_t)l * DM * 11008, 11008, (bf16_t*)(wl + WO_FF1I), DM, (q >> 5) * 64, (q & 31) * 64, 1, L, tid); continue; } q -= NT_FFI;
            if (q < NT_FFI) { conv_tile(a.in[I_WFF2I] + (size_t)l * DM * 11008, 11008, (bf16_t*)(wl + WO_FF2I), DM, (q >> 5) * 64, (q & 31) * 64, 1, L, tid); continue; } q -= NT_FFI;
            if (q < NT_FFO) { conv_tile(a.in[I_WFF1O] + (size_t)l * DFF * DM, DM, (bf16_t*)(wl + WO_FF1O), DFF, (q / 86) * 64, (q % 86) * 64, 0, L, tid); continue; } q -= NT_FFO;
            if (q < NT_FFO) { conv_tile(a.in[I_WFF2O] + (size_t)l * DFF * DM, DM, (bf16_t*)(wl + WO_FF2O), DFF, (q / 86) * 64, (q % 86) * 64, 0, L, tid); continue; } q -= NT_FFO;
            if (q < NT_IN) { conv_tile(a.in[I_WIN] + (size_t)l * DM * 16384, 16384, (bf16_t*)(wl + WO_IN), DM, (q >> 5) * 64, (q & 31) * 64, 2, L, tid); continue; } q -= NT_IN;
            if (q < NT_BR) { const int n = q >> 8, tt = q & 255; conv_tile(a.in[I_WBR] + (size_t)l * 4 * 512 * DM, DM, (bf16_t*)(wl + WO_BR), DM, (tt >> 3) * 64, n * 512 + (tt & 7) * 64, 0, L, tid); continue; } q -= NT_BR;
            conv_tile(a.in[I_WOUT] + (size_t)l * DM * DM, DM, (bf16_t*)(wl + WO_OUT), DM, (q >> 5) * 64, (q & 31) * 64, 0, L, tid); continue; }
        r -= 2 * NT_LAYER;
        if (r < NT_ROPE) { const int idx = r * 512 + tid, pos = idx >> 3, i = idx & 7; double rev = (double)pos * ROPE_INV[i] * 0.15915494309189535; rev -= floor(rev); const float fr = (float)rev;
            float* rp = (float*)(ws + WS_ROPE) + (size_t)idx * 2; rp[0] = __builtin_amdgcn_cosf(fr); rp[1] = __builtin_amdgcn_sinf(fr); continue; } r -= NT_ROPE;
        if (r < NT_DFT) {
            const bool big = r < 32; const int N = big ? 128 : 64, m = (big ? r : r - 32) * 512 + tid, k = m / N, t = m % N;
            const float x = (float)((k * t) & (N - 1)) / (float)N; const float c = __builtin_amdgcn_cosf(x), sn = __builtin_amdgcn_sinf(x);
            bf16_t* dp = (bf16_t*)(ws + WS_DFT + (big ? 0 : 98304)); dp[m] = fftm_bf1(c); dp[N * N + m] = fftm_bf1(sn); dp[2 * N * N + m] = fftm_bf1(-sn); continue; }
        r -= NT_DFT;
        if (r < NT_ZSS) { ((f32x4*)(ws + WS_SS))[r * 512 + tid] = (f32x4){0.f, 0.f, 0.f, 0.f}; continue; }
        if (tid < 2) { const int l = tid; float s1 = 0.f, s2 = 0.f;
            for (int k = 0; k < 64; ++k) { s1 += a.in[I_LQ1][l * 64 + k] * a.in[I_LK1][l * 64 + k]; s2 += a.in[I_LQ2][l * 64 + k] * a.in[I_LK2][l * 64 + k]; }
            const float li = l == 0 ? 0.2f : 0.35550906759096934f;
            ((float*)(ws + WS_LAM))[l] = __expf(s1) - __expf(s2) + li; }
    }
}

constexpr int NT_AT = 144, NT_BWT = 1200, NT_PRO2 = NT_AT + NT_BWT;
__device__ __forceinline__ void prologue2_phase(KArgs& a, LAS unsigned char* lds, int wg, int nwg, int tid) {
    unsigned char* ws = a.ws; const float* mod = (const float*)(ws + WS_MOD);
    LAS float* sh = (LAS float*)lds;
    const int lane = tid & 63, wid = tid >> 6;
    for (int t = wg; t < NT_PRO2; t += nwg) {
        if (t < NT_AT) { const int idx = t * 512 + tid, inst = idx / 12288, rem = idx % 12288, br = rem >> 11, col = rem & 2047, l = inst / 3, sl = inst % 3;
            const float g = a.in[sl == 0 ? I_GFF1 : (sl == 1 ? I_GMIX : I_GFF2)][l * DM + col];
            ((float*)(ws + WS_AT))[idx] = g * (1.0f + mod[((size_t)l * 6 + br) * NMODC + (3 * sl + 1) * DM + col]); continue; }
        const int R0 = (t - NT_AT) * 64, l = R0 / BWL, rr = R0 % BWL, sl = rr < 11008 ? 0 : (rr < 27392 ? 1 : 2), v0 = rr - (sl == 0 ? 0 : (sl == 1 ? 11008 : 27392));
        __syncthreads();
#pragma unroll 1
        for (int i0 = 0; i0 < 6 * DM; i0 += 8 * 512) {
            float mv[8];
#pragma unroll
            for (int j = 0; j < 8; ++j) { const int i = i0 + j * 512 + tid, br = i >> 11, k = i & 2047; mv[j] = mod[((size_t)l * 6 + br) * NMODC + 3 * sl * DM + k]; }
#pragma unroll
            for (int j = 0; j < 8; ++j) { const int i = i0 + j * 512 + tid, br = i >> 11, k = i & 2047; sh[(br * 8 + (k >> 8)) * 260 + (k & 255)] = mv[j]; } }
        __syncthreads();
        const bf16_t* W = (const bf16_t*)(ws + WS_W + (size_t)l * WLAYER + (sl == 0 ? WO_FF1I : (sl == 1 ? WO_IN : WO_FF2I)));
        const int v = v0 + wid * 8 + (lane >> 3), kq = lane & 7;
        float acc[6] = {0.f, 0.f, 0.f, 0.f, 0.f, 0.f};
        for (int i = 0; i < 32; ++i) { const u32x4 wv = *(const u32x4*)((const char*)W + pg8::wtile_off(v, kq * 256 + i * 8, DM / 64));
            const float w8[8] = {bf_lo(wv.x), bf_hi(wv.x), bf_lo(wv.y), bf_hi(wv.y), bf_lo(wv.z), bf_hi(wv.z), bf_lo(wv.w), bf_hi(wv.w)};
#pragma unroll
            for (int br = 0; br < 6; ++br) { const LAS float* sp = sh + (br * 8 + kq) * 260 + i * 8; const f32x4 s0 = *(const LAS f32x4*)sp, s1 = *(const LAS f32x4*)(sp + 4);
                acc[br] += (w8[0] * s0[0] + w8[1] * s0[1]) + (w8[2] * s0[2] + w8[3] * s0[3]) + (w8[4] * s1[0] + w8[5] * s1[1]) + (w8[6] * s1[2] + w8[7] * s1[3]); } }
#pragma unroll
        for (int br = 0; br < 6; ++br) { float x = acc[br];
            x += __uint_as_float((unsigned)__builtin_amdgcn_ds_swizzle((int)__float_as_uint(x), (1 << 10) | 0x1f));
            x += __uint_as_float((unsigned)__builtin_amdgcn_ds_swizzle((int)__float_as_uint(x), (2 << 10) | 0x1f));
            x += __uint_as_float((unsigned)__builtin_amdgcn_ds_swizzle((int)__float_as_uint(x), (4 << 10) | 0x1f));
            if (kq == 0) ((float*)(ws + WS_BW))[((size_t)l * 6 + br) * BWL + rr + wid * 8 + (lane >> 3)] = x; }
    }
}
__device__ __forceinline__ void norm_first_phase(KArgs& a, int wg, int nwg, int wave, int lane) {
    bf16_t* XA = (bf16_t*)(a.ws + WS_H); float* ss0 = (float*)(a.ws + WS_SS); const float* at = (const float*)(a.ws + WS_AT);
    const int stride = nwg * 8; int row = wg * 8 + wave; if (row >= NTOK) return;
    f32x4 v[8], vn[8], av[8]; int brc = -1;
    { const float* x = row < 32768 ? a.in[I_XP] + (size_t)row * DM : a.in[I_XS] + (size_t)(row - 32768) * DM;
#pragma unroll
      for (int i = 0; i < 8; ++i) v[i] = *(const f32x4*)(x + (i * 64 + lane) * 4); }
    for (; row < NTOK; row += stride) {
        const int rn = row + stride; const int br = brow_of(row);
        if (rn < NTOK) { const float* xn = rn < 32768 ? a.in[I_XP] + (size_t)rn * DM : a.in[I_XS] + (size_t)(rn - 32768) * DM;
#pragma unroll
            for (int i = 0; i < 8; ++i) vn[i] = *(const f32x4*)(xn + (i * 64 + lane) * 4); }
        if (br != brc) { brc = br;
#pragma unroll
            for (int i = 0; i < 8; ++i) av[i] = *(const f32x4*)(at + (size_t)br * DM + (i * 64 + lane) * 4); }
        float ss = 0.f;
#pragma unroll
        for (int i = 0; i < 8; ++i) ss += (v[i][0] * v[i][0] + v[i][1] * v[i][1]) + (v[i][2] * v[i][2] + v[i][3] * v[i][3]);
        ss = wave_sum(ss); if (lane == 0) ss0[row] = ss;
#pragma unroll
        for (int i = 0; i < 8; ++i) { const int col = (i * 64 + lane) * 4; const f32x4 o = v[i] * av[i]; u32x2 w; w.x = pk2(o[0], o[1]); w.y = pk2(o[2], o[3]);
            *(u32x2*)(XA + (size_t)row * DM + col) = w; }
#pragma unroll
        for (int i = 0; i < 8; ++i) v[i] = vn[i];
    }
}
__device__ __forceinline__ void final_phase(KArgs& a, int wg, int nwg, int wave, int lane) {
    const float* gw = a.in[I_GFIN];
    const int stride = nwg * 8; int row = wg * 8 + wave; if (row >= NTOK) return;
    f32x4 v[8], vn[8], gv[8];
#pragma unroll
    for (int i = 0; i < 8; ++i) { gv[i] = *(const f32x4*)(gw + (i * 64 + lane) * 4); v[i] = *(const f32x4*)(a.out + (size_t)row * DM + (i * 64 + lane) * 4); }
    for (; row < NTOK; row += stride) {
        const int rn = row + stride; float* x = a.out + (size_t)row * DM;
        if (rn < NTOK) {
#pragma unroll
            for (int i = 0; i < 8; ++i) vn[i] = *(const f32x4*)(a.out + (size_t)rn * DM + (i * 64 + lane) * 4); }
        float ss = 0.f;
#pragma unroll
        for (int i = 0; i < 8; ++i) ss += (v[i][0] * v[i][0] + v[i][1] * v[i][1]) + (v[i][2] * v[i][2] + v[i][3] * v[i][3]);
        ss = wave_sum(ss); const float rstd = __builtin_amdgcn_rsqf(ss * (1.0f / DM) + EPS);
#pragma unroll
        for (int i = 0; i < 8; ++i) { const int col = (i * 64 + lane) * 4; *(f32x4*)(x + col) = v[i] * rstd * gv[i]; }
#pragma unroll
        for (int i = 0; i < 8; ++i) v[i] = vn[i];
    }
}

namespace dattn {
constexpr int KP = 144, VP = 320, KT = 64 * KP, VT = 64 * VP;
constexpr int KS0 = 0, KS1 = KT, VS0 = 2 * KT, VS1 = 2 * KT + VT;
#define DBAR() asm volatile("s_waitcnt lgkmcnt(0)\n\ts_barrier" ::: "memory")
__device__ __forceinline__ bf16x8 trA(LAS unsigned char* p) {
    const s16x4 lo = __builtin_amdgcn_ds_read_tr16_b64_v4i16((LAS s16x4*)p), hi = __builtin_amdgcn_ds_read_tr16_b64_v4i16((LAS s16x4*)(p + 8 * VP));
    return (bf16x8){lo[0], lo[1], lo[2], lo[3], hi[0], hi[1], hi[2], hi[3]};
}
__device__ __forceinline__ void qk(f32x16& p0, f32x16& p1, LAS unsigned char* ks, const bf16x8 (&qf)[4], int r32, int hi) {
    p0 = (f32x16){0.f, 0.f, 0.f, 0.f, 0.f, 0.f, 0.f, 0.f, 0.f, 0.f, 0.f, 0.f, 0.f, 0.f, 0.f, 0.f}; p1 = p0;
#pragma unroll
    for (int s = 0; s < 4; ++s) { const bf16x8 k0f = *(const LAS bf16x8*)(ks + r32 * KP + (16 * s + 8 * hi) * 2), k1f = *(const LAS bf16x8*)(ks + (32 + r32) * KP + (16 * s + 8 * hi) * 2);
        p0 = __builtin_amdgcn_mfma_f32_32x32x16_bf16(k0f, qf[s], p0, 0, 0, 0); p1 = __builtin_amdgcn_mfma_f32_32x32x16_bf16(k1f, qf[s], p1, 0, 0, 0); }
}
__device__ __forceinline__ float softmax(f32x16& p0, f32x16& p1, float& m, float& l, bf16x8 (&pb)[4]) {
    float mx = fmaxf(p0[0], p1[0]);
#pragma unroll
    for (int r = 1; r < 16; ++r) mx = fmaxf(mx, fmaxf(p0[r], p1[r]));
    mx = swap_max(mx);
    const float mn = fmaxf(m, mx * C2), alpha = __builtin_amdgcn_exp2f(m - mn); m = mn;
    float ps = 0.f;
#pragma unroll
    for (int r = 0; r < 16; ++r) { p0[r] = __builtin_amdgcn_exp2f(fmaf(p0[r], C2, -mn)); p1[r] = __builtin_amdgcn_exp2f(fmaf(p1[r], C2, -mn)); ps += p0[r] + p1[r]; }
    ps = swap_sum(ps); l = l * alpha + ps;
#pragma unroll
    for (int ks = 0; ks < 4; ++ks) { u32x4 w;
        if (ks < 2) { w.x = pk2(p0[8 * (ks & 1) + 0], p0[8 * (ks & 1) + 1]); w.y = pk2(p0[8 * (ks & 1) + 2], p0[8 * (ks & 1) + 3]); w.z = pk2(p0[8 * (ks & 1) + 4], p0[8 * (ks & 1) + 5]); w.w = pk2(p0[8 * (ks & 1) + 6], p0[8 * (ks & 1) + 7]); }
        else        { w.x = pk2(p1[8 * (ks & 1) + 0], p1[8 * (ks & 1) + 1]); w.y = pk2(p1[8 * (ks & 1) + 2], p1[8 * (ks & 1) + 3]); w.z = pk2(p1[8 * (ks & 1) + 4], p1[8 * (ks & 1) + 5]); w.w = pk2(p1[8 * (ks & 1) + 6], p1[8 * (ks & 1) + 7]); }
        pb[ks] = __builtin_bit_cast(bf16x8, w); }
    return alpha;
}
__device__ __forceinline__ void pv(f32x16 (&o)[4], LAS unsigned char* vs, int vbase, const bf16x8 (&pb)[4]) {
#pragma unroll
    for (int ks = 0; ks < 4; ++ks)
#pragma unroll
        for (int db = 0; db < 4; ++db) { const bf16x8 va = trA(vs + vbase + ks * 16 * VP + db * 64); o[db] = __builtin_amdgcn_mfma_f32_32x32x16_bf16(va, pb[ks], o[db], 0, 0, 0); }
}
template <int MODE>
__device__ __forceinline__ void unit(const bf16_t* Zs, int T, int h, int qb, const float* lamp, int layer, const float* lng, bf16_t* Ys, u32x4* oscr, LAS unsigned char* lds, const int wv) {
    const int tid = opaque_tid(wv), lane = tid & 63, wid = __builtin_amdgcn_readfirstlane(tid >> 6), r32 = lane & 31, hi = lane >> 5;
    const int qrow = qb * 256 + wid * 32 + r32, NT = T >> 6;
    const int ksr = tid >> 3, ksc = tid & 7, vr0 = tid >> 4, vc0 = tid & 15;
    const int vbase = (4 * hi + ((lane >> 2) & 3)) * VP + (16 * ((lane >> 4) & 1) + 4 * (lane & 3)) * 2;
    const int kw = ksr * KP + ksc * 16, vw = vr0 * VP + vc0 * 16;
#pragma unroll
    for (int c = 0; c < 2; ++c) {
        const bf16_t* Qp = Zs + zoff(qrow, 2048 + h * 128 + c * 64) + hi * 8;
        bf16x8 qf[4];
#pragma unroll
        for (int s = 0; s < 4; ++s) qf[s] = *(const bf16x8*)(Qp + 16 * s);
        LAS unsigned char* const qlds = lds + 59392 + wid * 4096 + lane * 16;
        const bf16_t* Kg = Zs + zoff(ksr, 2560 + h * 128 + c * 64) + ksc * 8;
        const bf16_t* Vg = Zs + zoff(vr0, 3072 + h * 128 + vc0 * 8);
        f32x16 o[4];
#pragma unroll
        for (int d = 0; d < 4; ++d) o[d] = (f32x16){0.f, 0.f, 0.f, 0.f, 0.f, 0.f, 0.f, 0.f, 0.f, 0.f, 0.f, 0.f, 0.f, 0.f, 0.f, 0.f};
        float m = -1e30f, l = 0.f;
        __syncthreads();
#pragma unroll
        for (int s = 0; s < 4; ++s) *(LAS bf16x8*)(qlds + s * 1024) = qf[s];
        { const bf16x8 k0 = *(const bf16x8*)Kg, k1 = *(const bf16x8*)(Kg + (size_t)64 * ZR), v0 = *(const bf16x8*)Vg, v1 = *(const bf16x8*)(Vg + (size_t)32 * ZR);
          *(LAS bf16x8*)(lds + KS0 + kw) = k0; *(LAS bf16x8*)(lds + KS1 + kw) = k1; *(LAS bf16x8*)(lds + VS0 + vw) = v0; *(LAS bf16x8*)(lds + VS0 + vw + 32 * VP) = v1; }
        __syncthreads();
        constexpr float THR = 8.0f;
        f32x16 pA0, pA1, pB0, pB1, negm; u32x4 pbA[4], pbB[4]; float mref = 0.f;
        negm = (f32x16){0.f, 0.f, 0.f, 0.f, 0.f, 0.f, 0.f, 0.f, 0.f, 0.f, 0.f, 0.f, 0.f, 0.f, 0.f, 0.f};
        qk(pA0, pA1, lds + KS0, qf, r32, hi);
        __syncthreads();
#define KFRAG(SL, G) (*(const LAS bf16x8*)((SL) + ((((G) & 1) ? 32 : 0) + r32) * KP + (16 * ((G) >> 1) + 8 * hi) * 2))
#define MX3(a, b, c) __builtin_fmaxf(__builtin_fmaxf((a), (b)), (c))
#define DSTEP(C0, C1, N0, N1, PBR, PBW, J) do { const int j_ = (J); const int jk_ = (j_ + 2 < NT) ? j_ + 2 : NT - 1; \
            LAS unsigned char* ksl_ = lds + (((j_ + 1) & 1) ? KS1 : KS0); LAS unsigned char* vsl_ = lds + (((j_ - 1) & 1) ? VS1 : VS0) + vbase; \
            bf16x8 kf_[8], va_[16], qs_[4]; float ps_ = 0.f; \
            const bf16x8 kreg_ = *(const bf16x8*)(Kg + (size_t)jk_ * 64 * ZR);        \
            const bf16x8 v0_ = *(const bf16x8*)(Vg + (size_t)j_ * 64 * ZR), v1_ = *(const bf16x8*)(Vg + (size_t)j_ * 64 * ZR + (size_t)32 * ZR); \
            kf_[0] = KFRAG(ksl_, 0); kf_[1] = KFRAG(ksl_, 1); qs_[0] = *(const LAS bf16x8*)(qlds); \
            __builtin_amdgcn_sched_barrier(0); \
            _Pragma("unroll") for (int g_ = 0; g_ < 8; ++g_) { \
                if (g_ + 2 < 8) kf_[g_ + 2] = KFRAG(ksl_, g_ + 2); \
                if (!(g_ & 1) && g_ + 2 < 8) qs_[(g_ >> 1) + 1] = *(const LAS bf16x8*)(qlds + ((g_ >> 1) + 1) * 1024); \
                if (g_ >= 6) va_[g_ - 6] = trA(vsl_ + (g_ - 6) * 64); \
                if (g_ == 0) N0 = __builtin_amdgcn_mfma_f32_32x32x16_bf16(kf_[0], qs_[0], negm, 0, 0, 0); else if (g_ == 1) N1 = __builtin_amdgcn_mfma_f32_32x32x16_bf16(kf_[1], qs_[0], negm, 0, 0, 0); \
                else if (g_ & 1) N1 = __builtin_amdgcn_mfma_f32_32x32x16_bf16(kf_[g_], qs_[g_ >> 1], N1, 0, 0, 0); else N0 = __builtin_amdgcn_mfma_f32_32x32x16_bf16(kf_[g_], qs_[g_ >> 1], N0, 0, 0, 0); \
                { const float e0_ = __builtin_amdgcn_exp2f(C0[2 * g_]), e1_ = __builtin_amdgcn_exp2f(C0[2 * g_ + 1]); ps_ += e0_; ps_ += e1_; PBW[g_ >> 2][g_ & 3] = pk2(e0_, e1_); } \
                __builtin_amdgcn_sched_barrier(0); } \
            float tn_ = -1e30f, ep_ = 0.f; \
            __builtin_amdgcn_sched_barrier(0); \
            _Pragma("unroll") for (int i_ = 0; i_ < 16; ++i_) { \
                if (i_ + 2 < 16) va_[i_ + 2] = trA(vsl_ + ((i_ + 2) >> 2) * 16 * VP + ((i_ + 2) & 3) * 64); \
                o[i_ & 3] = __builtin_amdgcn_mfma_f32_32x32x16_bf16(va_[i_], __builtin_bit_cast(bf16x8, PBR[i_ >> 2]), o[i_ & 3], 0, 0, 0); \
                { const float e_ = __builtin_amdgcn_exp2f(C1[i_]); ps_ += e_; if (i_ & 1) PBW[2 + (i_ >> 3)][(i_ >> 1) & 3] = pk2(ep_, e_); else ep_ = e_; } \
                tn_ = MX3(tn_, N0[i_], N1[i_]); asm volatile("" : "+v"(tn_)); \
                __builtin_amdgcn_sched_barrier(0); } \
            asm volatile("" : "+v"(PBW[0]), "+v"(PBW[1]), "+v"(PBW[2]), "+v"(PBW[3])); \
            ps_ = swap_sum(ps_); l += ps_; \
            if (__any(fcarry < 1.0f)) { _Pragma("unroll") for (int d = 0; d < 4; ++d) o[d] *= fcarry; } \
            fcarry = 1.0f; \
            { const float mx_ = swap_max(tn_); \
              if ((j_ + 1 < NT) && __any(mx_ > THR)) { const float d_ = fmaxf(mx_, 0.f); fcarry = __builtin_amdgcn_exp2f(-d_); mref += d_; l *= fcarry; \
                  _Pragma("unroll") for (int r = 0; r < 16; ++r) { N0[r] -= d_; N1[r] -= d_; negm[r] = -mref; } } } \
            *(LAS bf16x8*)(lds + ((j_ & 1) ? KS1 : KS0) + kw) = kreg_; \
            *(LAS bf16x8*)(lds + ((j_ & 1) ? VS1 : VS0) + vw) = v0_; *(LAS bf16x8*)(lds + ((j_ & 1) ? VS1 : VS0) + vw + 32 * VP) = v1_; \
            DBAR(); } while (0)
        float fcarry = 1.0f;
        {
            const bf16x8 kreg_ = *(const bf16x8*)(Kg + (size_t)(2 < NT ? 2 : NT - 1) * 64 * ZR);
            float mx = fmaxf(pA0[0], pA1[0]);
#pragma unroll
            for (int r = 1; r < 16; ++r) mx = fmaxf(mx, fmaxf(pA0[r], pA1[r]));
            mx = swap_max(mx); mref = mx;
#pragma unroll
            for (int r = 0; r < 16; ++r) negm[r] = -mref;
            float ps = 0.f;
#pragma unroll
            for (int r = 0; r < 16; ++r) { pA0[r] = __builtin_amdgcn_exp2f(pA0[r] - mx); pA1[r] = __builtin_amdgcn_exp2f(pA1[r] - mx); ps += pA0[r] + pA1[r]; }
            l = swap_sum(ps);
#pragma unroll
            for (int ks = 0; ks < 4; ++ks) { u32x4 w;
                if (ks < 2) { w.x = pk2(pA0[8 * (ks & 1) + 0], pA0[8 * (ks & 1) + 1]); w.y = pk2(pA0[8 * (ks & 1) + 2], pA0[8 * (ks & 1) + 3]); w.z = pk2(pA0[8 * (ks & 1) + 4], pA0[8 * (ks & 1) + 5]); w.w = pk2(pA0[8 * (ks & 1) + 6], pA0[8 * (ks & 1) + 7]); }
                else        { w.x = pk2(pA1[8 * (ks & 1) + 0], pA1[8 * (ks & 1) + 1]); w.y = pk2(pA1[8 * (ks & 1) + 2], pA1[8 * (ks & 1) + 3]); w.z = pk2(pA1[8 * (ks & 1) + 4], pA1[8 * (ks & 1) + 5]); w.w = pk2(pA1[8 * (ks & 1) + 6], pA1[8 * (ks & 1) + 7]); }
                pbA[ks] = w; }
            { LAS unsigned char* ksl_ = lds + KS1;
#pragma unroll
              for (int g = 0; g < 8; ++g) { const bf16x8 kf = KFRAG(ksl_, g);
                if (g == 0) pB0 = __builtin_amdgcn_mfma_f32_32x32x16_bf16(kf, qf[0], negm, 0, 0, 0); else if (g == 1) pB1 = __builtin_amdgcn_mfma_f32_32x32x16_bf16(kf, qf[0], negm, 0, 0, 0);
                else if (g & 1) pB1 = __builtin_amdgcn_mfma_f32_32x32x16_bf16(kf, qf[g >> 1], pB1, 0, 0, 0); else pB0 = __builtin_amdgcn_mfma_f32_32x32x16_bf16(kf, qf[g >> 1], pB0, 0, 0, 0); } }
            { float t1 = fmaxf(pB0[0], pB1[0]);
#pragma unroll
              for (int r = 1; r < 16; ++r) t1 = fmaxf(t1, fmaxf(pB0[r], pB1[r]));
              t1 = swap_max(t1);
              if ((1 < NT) && __any(t1 > THR)) { const float d_ = fmaxf(t1, 0.f); fcarry = __builtin_amdgcn_exp2f(-d_); mref += d_; l *= fcarry;
#pragma unroll
                  for (int r = 0; r < 16; ++r) { pB0[r] -= d_; pB1[r] -= d_; negm[r] = -mref; } } }
            *(LAS bf16x8*)(lds + KS0 + kw) = kreg_;
            DBAR(); }
        for (int j = 1; j + 1 < NT; j += 2) { DSTEP(pB0, pB1, pA0, pA1, pbA, pbB, j); DSTEP(pA0, pA1, pB0, pB1, pbB, pbA, j + 1); }
        DSTEP(pB0, pB1, pA0, pA1, pbA, pbB, NT - 1);
#undef DSTEP
#undef KFRAG
#undef MX3
        { bf16x8 pbl[4];
#pragma unroll
          for (int q = 0; q < 4; ++q) pbl[q] = __builtin_bit_cast(bf16x8, pbB[q]);
          pv(o, lds + (((NT - 1) & 1) ? VS1 : VS0), vbase, pbl); }
        const float inv = __builtin_amdgcn_rcpf(l);
        const int tidE = opaque_tid(wv), hiE = (tidE >> 5) & 1, qrowE = qb * 256 + (tidE >> 6) * 32 + (tidE & 31);
        if (c == 0) {
#pragma unroll
            for (int d = 0; d < 4; ++d)
#pragma unroll
                for (int i = 0; i < 2; ++i) { u32x4 w; w.x = pk2(o[d][8 * i] * inv, o[d][8 * i + 1] * inv); w.y = pk2(o[d][8 * i + 2] * inv, o[d][8 * i + 3] * inv); w.z = pk2(o[d][8 * i + 4] * inv, o[d][8 * i + 5] * inv); w.w = pk2(o[d][8 * i + 6] * inv, o[d][8 * i + 7] * inv);
                    oscr[(size_t)tidE * 8 + d * 2 + i] = w; }
        } else {
            float ss = 0.f; int ly = layer; asm volatile("" : "+s"(ly));
            const float lamv = lamp[ly], postv = ly == 0 ? 0.8f : 0.64449093240903066f;
#pragma unroll
            for (int d = 0; d < 4; ++d) {
#pragma unroll
                for (int i = 0; i < 2; ++i) { const u32x4 w = __builtin_nontemporal_load(oscr + (size_t)tidE * 8 + d * 2 + i); const float il = inv * lamv;
                    o[d][8 * i + 0] = bf_lo(w.x) - o[d][8 * i + 0] * il; o[d][8 * i + 1] = bf_hi(w.x) - o[d][8 * i + 1] * il; o[d][8 * i + 2] = bf_lo(w.y) - o[d][8 * i + 2] * il; o[d][8 * i + 3] = bf_hi(w.y) - o[d][8 * i + 3] * il;
                    o[d][8 * i + 4] = bf_lo(w.z) - o[d][8 * i + 4] * il; o[d][8 * i + 5] = bf_hi(w.z) - o[d][8 * i + 5] * il; o[d][8 * i + 6] = bf_lo(w.w) - o[d][8 * i + 6] * il; o[d][8 * i + 7] = bf_hi(w.w) - o[d][8 * i + 7] * il; }
#pragma unroll
                for (int r = 0; r < 16; ++r) ss += o[d][r] * o[d][r]; }
            ss = swap_sum(ss);
            const float rn = __builtin_amdgcn_rsqf(ss * (1.0f / 128.0f) + EPS) * postv;
            bf16_t* yp = Ys + (size_t)qrowE * DM + 1024 + h * 128;
            f32x4 gl[16];
#pragma unroll
            for (int i = 0; i < 16; ++i) gl[i] = *(const f32x4*)(lng + (i >> 2) * 32 + 8 * (i & 3) + 4 * hiE);
            __builtin_amdgcn_sched_barrier(0);
#pragma unroll
            for (int d = 0; d < 4; ++d)
#pragma unroll
                for (int a4 = 0; a4 < 4; ++a4) { const int d0 = d * 32 + 8 * a4 + 4 * hiE; const f32x4 g = gl[d * 4 + a4];
                    u32x2 w; w.x = pk2(o[d][4 * a4] * rn * g[0], o[d][4 * a4 + 1] * rn * g[1]); w.y = pk2(o[d][4 * a4 + 2] * rn * g[2], o[d][4 * a4 + 3] * rn * g[3]);
                    *(u32x2*)((char*)Ys + pg8::atile_off(qrowE, 1024 + h * 128 + d * 32 + 8 * a4, DM / 64) + 8 * hiE) = w; (void)yp; (void)d0; }
        }
    }
}
#undef DBAR
}

namespace wattn {
constexpr int VP = 192, VBUF = 32 * VP, KP = 144, KBUF = 32 * KP, WBUF = VBUF + KBUF;
constexpr float THR = 8.0f;
struct KV { bf16x8 kr[4], vr[4]; };
struct Geom { int kind, a0, a1, B, TS, KS, nt, QB, qsh, qcol, kcol, vcol; };
__device__ __forceinline__ unsigned kv_off0(const Geom& G, int lane) { return (unsigned)(zoff(G.B + (lane >> 3) * G.KS, G.kcol) + 8 * (lane & 7)) * 2u; }
__device__ __forceinline__ void load_kv(KV& t, const char* Zc, unsigned off, unsigned rsb, int dv) {
#pragma unroll
    for (int i = 0; i < 4; ++i) { const char* pk = Zc + (off + (unsigned)i * rsb); t.kr[i] = *(const bf16x8*)pk; t.vr[i] = *(const bf16x8*)(pk + dv); }
}
__device__ __forceinline__ void load_q(bf16x8 (&qf)[4], const char* Zc, const Geom& G, int lane) {
    const int r32 = lane & 31, hi = lane >> 5; const int qtok = G.QB + (G.qsh < 0 ? (r32 >> 4) * 64 + (r32 & 15) : (r32 << G.qsh));
    const char* Qp = Zc + (unsigned)(zoff(qtok, G.qcol) + 8 * hi) * 2u;
#pragma unroll
    for (int s = 0; s < 4; ++s) qf[s] = *(const bf16x8*)(Qp + 32 * s);
}
__device__ __forceinline__ void put_k(const KV& t, LAS unsigned char* kb, int lane) {
#pragma unroll
    for (int i = 0; i < 4; ++i) *(LAS bf16x8*)(kb + ((lane >> 3) + 8 * i) * KP + (lane & 7) * 16) = t.kr[i];
}
__device__ __forceinline__ f32x16 qk4(LAS unsigned char* kb, const bf16x8 (&qf)[4], int lane) {
    LAS unsigned char* p = kb + (lane & 31) * KP + (lane >> 5) * 16;
    bf16x8 kf[4];
#pragma unroll
    for (int st = 0; st < 4; ++st) kf[st] = *(const LAS bf16x8*)(p + st * 32);
    __builtin_amdgcn_sched_barrier(0);
    f32x16 s = __builtin_amdgcn_mfma_f32_32x32x16_bf16(kf[0], qf[0], (f32x16){0.f, 0.f, 0.f, 0.f, 0.f, 0.f, 0.f, 0.f, 0.f, 0.f, 0.f, 0.f, 0.f, 0.f, 0.f, 0.f}, 0, 0, 0);
#pragma unroll
    for (int st = 1; st < 4; ++st) s = __builtin_amdgcn_mfma_f32_32x32x16_bf16(kf[st], qf[st], s, 0, 0, 0);
    return s;
}
__device__ __forceinline__ void put_v(const KV& t, LAS unsigned char* vb, int lane) {
#pragma unroll
    for (int i = 0; i < 4; ++i) *(LAS bf16x8*)(vb + ((lane >> 3) + 8 * i) * VP + (lane & 7) * 16) = t.vr[i];
}
__device__ __forceinline__ void pv2(f32x16& o0, f32x16& o1, LAS unsigned char* vb, const u32x4 (&pb)[2], int lane) {
    const int hi = lane >> 5; LAS unsigned char* p0 = vb + (4 * hi + ((lane >> 2) & 3)) * VP + (16 * ((lane >> 4) & 1) + 4 * (lane & 3)) * 2;
    bf16x8 va[4];
#pragma unroll
    for (int i = 0; i < 4; ++i) { LAS unsigned char* p = p0 + (i >> 1) * 16 * VP + (i & 1) * 64;
        const s16x4 lo = __builtin_amdgcn_ds_read_tr16_b64_v4i16((LAS s16x4*)p), hh = __builtin_amdgcn_ds_read_tr16_b64_v4i16((LAS s16x4*)(p + 8 * VP));
        va[i] = (bf16x8){lo[0], lo[1], lo[2], lo[3], hh[0], hh[1], hh[2], hh[3]}; }
    __builtin_amdgcn_sched_barrier(0);
#pragma unroll
    for (int ks = 0; ks < 2; ++ks) { o0 = __builtin_amdgcn_mfma_f32_32x32x16_bf16(va[2 * ks], __builtin_bit_cast(bf16x8, pb[ks]), o0, 0, 0, 0); o1 = __builtin_amdgcn_mfma_f32_32x32x16_bf16(va[2 * ks + 1], __builtin_bit_cast(bf16x8, pb[ks]), o1, 0, 0, 0); }
}
template <class FixS>
__device__ __forceinline__ void run(f32x16& o0, f32x16& o1, float& l, float& mref, bf16x8 (&qf)[4], KV& kvA, KV& kvB, const char* Zc, const Geom& G, const Geom& N, const bool hasN, const FixS& fixs, LAS unsigned char* wbuf, int lane) {
    const f32x16 zero = (f32x16){0.f, 0.f, 0.f, 0.f, 0.f, 0.f, 0.f, 0.f, 0.f, 0.f, 0.f, 0.f, 0.f, 0.f, 0.f, 0.f};
    LAS unsigned char* const vbuf = wbuf; LAS unsigned char* const kbuf = wbuf + VBUF;
    const int nt = G.nt; const unsigned tsb = (unsigned)G.TS * (ZR * 2), rsb = (unsigned)G.KS * (8 * ZR * 2); const int dv = ((G.vcol - G.kcol) >> 6) * (GT * ZR * 2);
    unsigned off2 = kv_off0(G, lane) + 2u * tsb;
    o0 = zero; o1 = zero; l = 0.f;
    f32x16 sA, sB; u32x4 pbA[2], pbB[2]; float fcarry = 1.0f;
    asm volatile("" ::: "memory"); put_k(kvA, kbuf, lane); asm volatile("" ::: "memory");
    sA = qk4(kbuf, qf, lane); fixs(0, sA);
    { float mx = sA[0];
#pragma unroll
      for (int r = 1; r < 16; ++r) mx = fmaxf(mx, sA[r]);
      mx = swap_max(mx); mx = (mx > -1e30f) ? mx : 0.f; mref = mx;
#pragma unroll
      for (int r = 0; r < 16; ++r) sA[r] -= mx; }
#define WSTEP(SC, SN, PBR, PBW, KC, KN, TT, KCI) do { const int t_ = (TT); const bool nx_ = (t_ + 1 < nt); \
        asm volatile("" ::: "memory"); \
        if (nx_) { put_k(KN, kbuf, lane); asm volatile("" ::: "memory"); SN = qk4(kbuf, qf, lane); } \
        if (t_ >= 1) pv2(o0, o1, vbuf, PBR, lane); \
        asm volatile("" ::: "memory"); put_v(KC, vbuf, lane); asm volatile("" ::: "memory"); \
        if (t_ + 2 < nt) { load_kv(KC, Zc, off2, rsb, dv); off2 += tsb; } \
        else if (hasN) load_kv(KC, Zc, kv_off0(N, lane) + (KCI) * ((unsigned)N.TS * (ZR * 2)), (unsigned)N.KS * (8 * ZR * 2), ((N.vcol - N.kcol) >> 6) * (GT * ZR * 2));     \
        if (!nx_ && hasN) load_q(qf, Zc, N, lane); \
        float ps_ = 0.f; \
        _Pragma("unroll") for (int r = 0; r < 16; r += 2) { const float e0_ = __builtin_amdgcn_exp2f(SC[r]), e1_ = __builtin_amdgcn_exp2f(SC[r + 1]); ps_ += e0_; ps_ += e1_; PBW[r >> 3][(r >> 1) & 3] = pk2(e0_, e1_); } \
        ps_ = swap_sum(ps_); l += ps_; \
        if (__any(fcarry < 1.0f)) { o0 *= fcarry; o1 *= fcarry; } \
        fcarry = 1.0f; \
        if (nx_) { _Pragma("unroll") for (int r = 0; r < 16; ++r) SN[r] -= mref; \
            fixs(t_ + 1, SN); float tn_ = SN[0]; \
            _Pragma("unroll") for (int r = 1; r < 16; ++r) tn_ = fmaxf(tn_, SN[r]); \
            tn_ = swap_max(tn_); \
            if (__any(tn_ > THR)) { const float d_ = fmaxf(tn_, 0.f); fcarry = __builtin_amdgcn_exp2f(-d_); mref += d_; l *= fcarry; \
                _Pragma("unroll") for (int r = 0; r < 16; ++r) SN[r] -= d_; } } \
    } while (0)
    int t = 0;
    for (; t + 1 < nt; t += 2) { WSTEP(sA, sB, pbB, pbA, kvA, kvB, t, 0); WSTEP(sB, sA, pbA, pbB, kvB, kvA, t + 1, 1); }
    if (t < nt) { WSTEP(sA, sB, pbB, pbA, kvA, kvB, t, 0); asm volatile("" ::: "memory"); pv2(o0, o1, vbuf, pbA, lane); }
    else { asm volatile("" ::: "memory"); pv2(o0, o1, vbuf, pbB, lane); }
#undef WSTEP
    asm volatile("" ::: "memory");
}

__device__ __forceinline__ Geom nat_geom(int T, int qb, int h) {
    const int tok0 = qb * 32, seqrow0 = tok0 & ~(T - 1), bl = (tok0 & (T - 1)) >> 5, r = 2 * (bl >> 2), c0 = 16 * (bl & 3), rows = T >> 6;
    const int rsu = min(max(r - 4, 0), rows - 8), nt = min(max(r - 3, 0), rows - 8) + 8 - rsu, cst = min(min(max(c0 - 8, 0), 48), 32);
    return Geom{0, qb, 0, seqrow0 + rsu * 64 + cst, 64, 1, nt, seqrow0 + r * 64 + c0, -1, 512 + h * 64, 1024 + h * 64, 1536 + h * 64};
}
__device__ __forceinline__ Geom dil_geom(int T, int g, int qblk, int h) {
    const int ds = 2 * g, d = 1 << ds, nqs = T >> 5;
    const int seqrow0 = (qblk << 5) & ~(T - 1), qs = qblk & (nqs - 1), rho = qs & (d - 1), u0 = (qs >> ds) * 32, U = T >> ds;
    const int jlo = u0 >= 64 ? 0 : (u0 >= 32 ? 1 : 2), jhi = (u0 + 96 <= U) ? 4 : ((u0 + 64 <= U) ? 3 : 2);
    const int base = seqrow0 + rho, ub = u0 - 64 + 32 * jlo;
    return Geom{1, g, qblk, base + (ub << ds), 32 << ds, d, jhi - jlo + 1, base + (u0 << ds), ds, 3584 + g * 512 + h * 64, 5120 + g * 512 + h * 64, 6656 + g * 512 + h * 64};
}
__device__ __forceinline__ void task(const bf16_t* Z, bf16_t* Y, float* DO, float* DL, const LAS float* tabl, int T, int h, bf16x8 (&qf)[4], KV& kvA, KV& kvB, const Geom& G, const Geom& N, bool hasN, LAS unsigned char* vbuf) {
    const int lane = opaque_lane(), r32 = lane & 31, hi = lane >> 5;
    const bool nat = G.kind == 0;
    const int tok0 = G.a0 * 32, nsr0 = tok0 & ~(T - 1), bl = (tok0 & (T - 1)) >> 5, r = 2 * (bl >> 2), c0 = 16 * (bl & 3), rows = T >> 6;
    const int qr = r + (r32 >> 4), qc = c0 + (r32 & 15);
    const int rsu = min(max(r - 4, 0), rows - 8), cst = min(min(max(c0 - 8, 0), 48), 32);
    const int dlo = min(max(qr - 4, 0), rows - 8) - rsu, clo = min(max(qc - 8, 0), 48) - cst - 4 * hi;
    const LAS float* rbl = tabl + h * 465 + (rsu - qr + 7) * 31 + 15 - qc + cst + 4 * hi;
    const int g = G.a0, qblk = G.a1, ds = 2 * g, d = 1 << ds, nqs = T >> 5;
    const int dsr0 = (qblk << 5) & ~(T - 1), qs = qblk & (nqs - 1), rho = qs & (d - 1), u0 = (qs >> ds) * 32;
    const int jlo = u0 >= 64 ? 0 : (u0 >= 32 ? 1 : 2);
    const int qtok = nat ? nsr0 + qr * 64 + qc : dsr0 + rho + ((u0 + r32) << ds);
    const int keyl = r32 - 4 * hi;
    f32x16 o0, o1; float l, mref;
    run(o0, o1, l, mref, qf, kvA, kvB, (const char*)Z, G, N, hasN,
        [&](int t, f32x16& s) {
            if (nat) { const int cl = ((unsigned)(t - dlo) < 8u) ? clo : (1 << 20); const LAS float* bp = rbl + t * 31;
                float bv[16];
#pragma unroll
                for (int rr = 0; rr < 16; ++rr) bv[rr] = bp[(rr & 3) + 8 * (rr >> 2)];
#pragma unroll
                for (int rr = 0; rr < 16; ++rr) s[rr] = ((unsigned)((rr & 3) + 8 * (rr >> 2) - cl) < 16u) ? s[rr] + bv[rr] : -INFINITY; }
            else { const int jt = jlo + t;
                if (jt == 0) {
#pragma unroll
                    for (int rr = 0; rr < 16; ++rr) s[rr] = ((rr & 3) + 8 * (rr >> 2) >= keyl) ? s[rr] : -INFINITY; }
                else if (jt == 4) {
#pragma unroll
                    for (int rr = 0; rr < 16; ++rr) s[rr] = ((rr & 3) + 8 * (rr >> 2) <= keyl) ? s[rr] : -INFINITY; } } },
        vbuf, lane);
    const float inv = __builtin_amdgcn_rcpf(l);
    if (nat) {
        bf16_t* yp = Y + (size_t)qtok * DM + 512 + h * 64;
#pragma unroll
        for (int a4 = 0; a4 < 4; ++a4) { const int d0 = 8 * a4 + 4 * hi;
            u32x2 w; w.x = pk2(o0[4 * a4] * inv, o0[4 * a4 + 1] * inv); w.y = pk2(o0[4 * a4 + 2] * inv, o0[4 * a4 + 3] * inv); *(u32x2*)((char*)Y + pg8::atile_off(qtok, 512 + h * 64 + 8 * a4, DM / 64) + 8 * hi) = w;
            u32x2 w1; w1.x = pk2(o1[4 * a4] * inv, o1[4 * a4 + 1] * inv); w1.y = pk2(o1[4 * a4 + 2] * inv, o1[4 * a4 + 3] * inv); *(u32x2*)((char*)Y + pg8::atile_off(qtok, 512 + h * 64 + 32 + 8 * a4, DM / 64) + 8 * hi) = w1; (void)yp; (void)d0; }
    } else {
        bf16_t* op = (bf16_t*)DO + ((size_t)g * GT + qtok) * 512 + h * 64;
#pragma unroll
        for (int a4 = 0; a4 < 4; ++a4) { const int d0 = 8 * a4 + 4 * hi;
            u32x2 w; w.x = pk2(o0[4 * a4] * inv, o0[4 * a4 + 1] * inv); w.y = pk2(o0[4 * a4 + 2] * inv, o0[4 * a4 + 3] * inv); *(u32x2*)(op + d0) = w;
            u32x2 w1; w1.x = pk2(o1[4 * a4] * inv, o1[4 * a4 + 1] * inv); w1.y = pk2(o1[4 * a4 + 2] * inv, o1[4 * a4 + 3] * inv); *(u32x2*)(op + 32 + d0) = w1; }
        if (hi == 0) DL[((size_t)g * GT + qtok) * 8 + h] = mref + __log2f(l);
    }
}
__device__ __forceinline__ Geom stream_geom(int T, int h, int kk, int wx, int nwg) {
    const int i = wx + (kk >> 1) * nwg, k = kk & 1;
    return nat_geom(T, 2 * i + k, h);
}
__device__ __forceinline__ void stream(const bf16_t* Z, bf16_t* Y, float* DO, float* DL, const LAS float* tabl, int T, int h, int wx, int nwg, LAS unsigned char* vbuf) {
    const int total = 2 * ((256 - wx + nwg - 1) / nwg);
    if (total <= 0) return;
    Geom G = stream_geom(T, h, 0, wx, nwg), N = G; bf16x8 qf[4]; KV kvA, kvB;
    { const int lane = opaque_lane(); const unsigned o0 = kv_off0(G, lane), tsb = (unsigned)G.TS * (ZR * 2), rsb = (unsigned)G.KS * (8 * ZR * 2); const int dv = ((G.vcol - G.kcol) >> 6) * (GT * ZR * 2);
      load_q(qf, (const char*)Z, G, lane); load_kv(kvA, (const char*)Z, o0, rsb, dv); load_kv(kvB, (const char*)Z, o0 + tsb, rsb, dv); }
    for (int kk = 0; kk < total; ++kk) {
        const bool hasN = kk + 1 < total; if (hasN) N = stream_geom(T, h, kk + 1, wx, nwg);
        task(Z, Y, DO, DL, tabl, T, h, qf, kvA, kvB, G, N, hasN, vbuf);
        G = N;
    }
}

constexpr int SKT = 32 * KP, SVT = 32 * VP, SVOFF = 12 * SKT;
struct DTask { int g, h, ds, tok0, u0b, U; };
__device__ __forceinline__ DTask dtask_of(int T, int j) {
    const int g = j >> 9, rem = j & 511, h = rem & 7, jj = rem >> 3, ds = 2 * g, d = 1 << ds, per = T >> 8;
    const int seq = jj / per, q = jj % per, rho = q & (d - 1), ubg = q >> ds;
    return DTask{g, h, ds, seq * T + rho, ubg * 256, T >> ds};
}
__device__ __forceinline__ void dshared_prefetch(u32x4 (&pre)[12], bf16x8 (&qn)[4], const char* Zc, const DTask& D, int tid, int wave, int lane) {
    const int kv = tid >> 8, row = (tid >> 3) & 31, chunk = tid & 7;
    const int col = (kv ? 6656 : 5120) + D.g * 512 + D.h * 64 + chunk * 8;
#pragma unroll
    for (int j = 0; j < 12; ++j) { const int u = D.u0b - 64 + 32 * j;
        if (u >= 0 && u + 32 <= D.U) pre[j] = *(const u32x4*)(Zc + (unsigned)zoff(D.tok0 + ((u + row) << D.ds), col) * 2u); }
    const int r32 = lane & 31, hi = lane >> 5; const int tq = D.tok0 + ((D.u0b + 32 * wave + r32) << D.ds);
    const char* Qp = Zc + (unsigned)(zoff(tq, 3584 + D.g * 512 + D.h * 64) + 8 * hi) * 2u;
#pragma unroll
    for (int s = 0; s < 4; ++s) qn[s] = *(const bf16x8*)(Qp + 32 * s);
}
__device__ __forceinline__ void dshared_task(const bf16_t* Z, float* DO, float* DL, int T, const DTask& D, const DTask& Nx, bool hasN, u32x4 (&pre)[12], bf16x8 (&qn)[4], LAS unsigned char* lds, int tid, int wave) {
    const int lane = tid & 63, r32 = lane & 31, hi = lane >> 5;
    asm volatile("s_waitcnt lgkmcnt(0)\n\ts_barrier" ::: "memory");
    { const int kv = tid >> 8, row = (tid >> 3) & 31, chunk = tid & 7; LAS unsigned char* wp = lds + (kv ? SVOFF + row * VP : row * KP) + chunk * 16;
#pragma unroll
      for (int j = 0; j < 12; ++j) { const int u = D.u0b - 64 + 32 * j; if (u >= 0 && u + 32 <= D.U) *(LAS u32x4*)(wp + j * (kv ? SVT : SKT)) = pre[j]; } }
    bf16x8 qf[4];
#pragma unroll
    for (int s = 0; s < 4; ++s) qf[s] = qn[s];
    asm volatile("s_waitcnt lgkmcnt(0)\n\ts_barrier" ::: "memory");
    if (hasN) dshared_prefetch(pre, qn, (const char*)Z, Nx, tid, wave, lane);
    const int u0 = D.u0b + 32 * wave, jlo = u0 >= 64 ? 0 : (u0 >= 32 ? 1 : 2), jhi = (u0 + 96 <= D.U) ? 4 : ((u0 + 64 <= D.U) ? 3 : 2), nt = jhi - jlo + 1;
    const int keyl = r32 - 4 * hi;
    LAS unsigned char* kb0 = lds + (wave + jlo) * SKT; LAS unsigned char* vb0 = lds + SVOFF + (wave + jlo) * SVT;
    const f32x16 zero = (f32x16){0.f, 0.f, 0.f, 0.f, 0.f, 0.f, 0.f, 0.f, 0.f, 0.f, 0.f, 0.f, 0.f, 0.f, 0.f, 0.f};
    f32x16 o0 = zero, o1 = zero, sA, sB; u32x4 pbA[2], pbB[2]; float l = 0.f, mref, fcarry = 1.0f;
#define DFIX(TT, S) do { const int jt_ = jlo + (TT); \
        if (jt_ == 0) { _Pragma("unroll") for (int rr = 0; rr < 16; ++rr) S[rr] = ((rr & 3) + 8 * (rr >> 2) >= keyl) ? S[rr] : -INFINITY; } \
        else if (jt_ == 4) { _Pragma("unroll") for (int rr = 0; rr < 16; ++rr) S[rr] = ((rr & 3) + 8 * (rr >> 2) <= keyl) ? S[rr] : -INFINITY; } } while (0)
    sA = qk4(kb0, qf, lane); DFIX(0, sA);
    { float mx = sA[0];
#pragma unroll
      for (int r = 1; r < 16; ++r) mx = fmaxf(mx, sA[r]);
      mx = swap_max(mx); mx = (mx > -1e30f) ? mx : 0.f; mref = mx;
#pragma unroll
      for (int r = 0; r < 16; ++r) sA[r] -= mx; }
#define DSTEP2(SC, SN, PBR, PBW, TT) do { const int t_ = (TT); const bool nx_ = (t_ + 1 < nt); \
        if (nx_) SN = qk4(kb0 + (t_ + 1) * SKT, qf, lane); \
        if (t_ >= 1) pv2(o0, o1, vb0 + (t_ - 1) * SVT, PBR, lane); \
        float ps_ = 0.f; \
        _Pragma("unroll") for (int r = 0; r < 16; r += 2) { const float e0_ = __builtin_amdgcn_exp2f(SC[r]), e1_ = __builtin_amdgcn_exp2f(SC[r + 1]); ps_ += e0_; ps_ += e1_; PBW[r >> 3][(r >> 1) & 3] = pk2(e0_, e1_); } \
        ps_ = swap_sum(ps_); l += ps_; \
        if (__any(fcarry < 1.0f)) { o0 *= fcarry; o1 *= fcarry; } \
        fcarry = 1.0f; \
        if (nx_) { _Pragma("unroll") for (int r = 0; r < 16; ++r) SN[r] -= mref; \
            DFIX(t_ + 1, SN); float tn_ = SN[0]; \
            _Pragma("unroll") for (int r = 1; r < 16; ++r) tn_ = fmaxf(tn_, SN[r]); \
            tn_ = swap_max(tn_); \
            if (__any(tn_ > THR)) { const float d_ = fmaxf(tn_, 0.f); fcarry = __builtin_amdgcn_exp2f(-d_); mref += d_; l *= fcarry; \
                _Pragma("unroll") for (int r = 0; r < 16; ++r) SN[r] -= d_; } } \
    } while (0)
    int t = 0;
    for (; t + 1 < nt; t += 2) { DSTEP2(sA, sB, pbB, pbA, t); DSTEP2(sB, sA, pbA, pbB, t + 1); }
    if (t < nt) { DSTEP2(sA, sB, pbB, pbA, t); pv2(o0, o1, vb0 + (nt - 1) * SVT, pbA, lane); }
    else pv2(o0, o1, vb0 + (nt - 1) * SVT, pbB, lane);
#undef DSTEP2
#undef DFIX
    const float inv = __builtin_amdgcn_rcpf(l);
    const int tq = D.tok0 + ((u0 + r32) << D.ds);
    bf16_t* op = (bf16_t*)DO + ((size_t)D.g * GT + tq) * 512 + D.h * 64;
#pragma unroll
    for (int a4 = 0; a4 < 4; ++a4) { const int d0 = 8 * a4 + 4 * hi;
        u32x2 w; w.x = pk2(o0[4 * a4] * inv, o0[4 * a4 + 1] * inv); w.y = pk2(o0[4 * a4 + 2] * inv, o0[4 * a4 + 3] * inv); *(u32x2*)(op + d0) = w;
        u32x2 w1; w1.x = pk2(o1[4 * a4] * inv, o1[4 * a4 + 1] * inv); w1.y = pk2(o1[4 * a4 + 2] * inv, o1[4 * a4 + 3] * inv); *(u32x2*)(op + 32 + d0) = w1; }
    if (hi == 0) DL[((size_t)D.g * GT + tq) * 8 + D.h] = mref + __log2f(l);
}
__device__ __forceinline__ void dshared(const bf16_t* Z, float* DO, float* DL, int T, int wx, int nwg, LAS unsigned char* lds, int tid, int wave) {
    if (wx >= 1536) return;
    const int lane = tid & 63;
    DTask D = dtask_of(T, wx), Nx = D; u32x4 pre[12]; bf16x8 qn[4];
    dshared_prefetch(pre, qn, (const char*)Z, D, tid, wave, lane);
    for (int j = wx; j < 1536; j += nwg) {
        const bool hasN = j + nwg < 1536; if (hasN) Nx = dtask_of(T, j + nwg);
        dshared_task(Z, DO, DL, T, D, Nx, hasN, pre, qn, lds, tid, wave);
        D = Nx;
    }
}
}

namespace fftm {
constexpr int PP = 320, PLANE = 128 * PP;
__device__ __forceinline__ bf16x8 trB(LAS unsigned char* p) {
    const s16x4 lo = __builtin_amdgcn_ds_read_tr16_b64_v4i16((LAS s16x4*)p), hh = __builtin_amdgcn_ds_read_tr16_b64_v4i16((LAS s16x4*)(p + 4 * PP));
    return (bf16x8){lo[0], lo[1], lo[2], lo[3], hh[0], hh[1], hh[2], hh[3]};
}
__device__ __forceinline__ bf16_t bf1(float x) { return (bf16_t)(pk2(x, 0.f) & 0xffffu); }
constexpr int UP = 272, PLOFF = 36864;
template <int N1>
__device__ __forceinline__ void pass1(const bf16_t* Zs, bf16_t* Bs, int t2, int g4, int dftstep, const bf16_t* W, const bf16_t* W128, LAS unsigned char* lds, int tid) {
    __syncthreads();
    { bf16x8 uv[N1 / 32];
#pragma unroll
      for (int i = 0; i < N1 / 32; ++i) { const int idx = tid + 512 * i, t1 = idx >> 4, c = idx & 15; uv[i] = *(const bf16x8*)(Zs + zoff(t1 * 128 + t2, g4 * 128 + c * 8)); }
#pragma unroll
      for (int i = 0; i < N1 / 32; ++i) { const int idx = tid + 512 * i, t1 = idx >> 4, c = idx & 15; *(LAS bf16x8*)(lds + t1 * UP + c * 16) = uv[i]; } }
    __syncthreads();
    constexpr int KB = N1 / 32, TPW = N1 / 64;
    const int lane = tid & 63, wid = __builtin_amdgcn_readfirstlane(tid >> 6), r32 = lane & 31, hi = lane >> 5;
    LAS unsigned char* const pl = lds + PLOFF;
    {
        const int tb = wid & 3, ca0 = (wid >> 2) * 2;
        if (tb < KB) {
            f32x16 aP[2], aQ[2];
#pragma unroll
            for (int t = 0; t < 2; ++t) { aP[t] = (f32x16){0.f, 0.f, 0.f, 0.f, 0.f, 0.f, 0.f, 0.f, 0.f, 0.f, 0.f, 0.f, 0.f, 0.f, 0.f, 0.f}; aQ[t] = aP[t]; }
            const LAS unsigned char* up = lds + (tb * 32 + r32) * UP + 16 * hi;
#pragma unroll
            for (int kh = 0; kh < 2; ++kh) {
                bf16x8 wP[4][2], wQ[4][2];
#pragma unroll
                for (int k4 = 0; k4 < 4; ++k4)
#pragma unroll
                    for (int t = 0; t < 2; ++t) { const bf16_t* wr_ = W128 + ((ca0 + t) * 32 + r32) * 128 + 16 * (kh * 4 + k4) + 8 * hi;
                        wP[k4][t] = *(const bf16x8*)wr_; wQ[k4][t] = *(const bf16x8*)(wr_ + 16384); }
                __builtin_amdgcn_sched_barrier(0);
#pragma unroll
                for (int k4 = 0; k4 < 4; ++k4) { const bf16x8 au = *(const LAS bf16x8*)(up + (kh * 4 + k4) * 32);
#pragma unroll
                    for (int t = 0; t < 2; ++t) { aP[t] = __builtin_amdgcn_mfma_f32_32x32x16_bf16(au, wP[k4][t], aP[t], 0, 0, 0); aQ[t] = __builtin_amdgcn_mfma_f32_32x32x16_bf16(au, wQ[k4][t], aQ[t], 0, 0, 0); } }
                __builtin_amdgcn_sched_barrier(0); }
#pragma unroll
            for (int t = 0; t < 2; ++t)
#pragma unroll
                for (int r = 0; r < 16; ++r) { LAS bf16_t* o = (LAS bf16_t*)(pl + (tb * 32 + crow(r, hi)) * PP) + (ca0 + t) * 32 + r32; o[0] = bf1(aP[t][r]); *(LAS bf16_t*)((LAS unsigned char*)o + PLANE) = bf1(aQ[t][r]); }
        }
    }
    __syncthreads();
    const int kblk = wid % KB, cb0 = (wid / KB) * TPW;
    const bf16_t* wc = W + (kblk * 32 + r32) * N1 + 8 * hi; const bf16_t* wsn = wc + N1 * N1; const bf16_t* wn = wsn + N1 * N1;
    const int vb = (8 * hi + ((lane >> 2) & 3)) * PP + (16 * ((lane >> 4) & 1) + 4 * (lane & 3)) * 2;
    f32x16 re[TPW], im[TPW];
#pragma unroll
    for (int t = 0; t < TPW; ++t) { re[t] = (f32x16){0.f, 0.f, 0.f, 0.f, 0.f, 0.f, 0.f, 0.f, 0.f, 0.f, 0.f, 0.f, 0.f, 0.f, 0.f, 0.f}; im[t] = re[t]; }
#pragma unroll
    for (int kh = 0; kh < N1 / 64; ++kh) {
        bf16x8 ac[4], as[4], an[4];
#pragma unroll
        for (int k4 = 0; k4 < 4; ++k4) { const int ks = kh * 4 + k4; ac[k4] = *(const bf16x8*)(wc + 16 * ks); as[k4] = *(const bf16x8*)(wsn + 16 * ks); an[k4] = *(const bf16x8*)(wn + 16 * ks); }
        __builtin_amdgcn_sched_barrier(0);
#pragma unroll
        for (int k4 = 0; k4 < 4; ++k4) { const int ks = kh * 4 + k4;
#pragma unroll
            for (int t = 0; t < TPW; ++t) { LAS unsigned char* bp = pl + vb + ks * 16 * PP + (cb0 + t) * 64;
                const bf16x8 bP = trB(bp), bQ = trB(bp + PLANE);
                re[t] = __builtin_amdgcn_mfma_f32_32x32x16_bf16(ac[k4], bP, re[t], 0, 0, 0); re[t] = __builtin_amdgcn_mfma_f32_32x32x16_bf16(an[k4], bQ, re[t], 0, 0, 0);
                im[t] = __builtin_amdgcn_mfma_f32_32x32x16_bf16(as[k4], bP, im[t], 0, 0, 0); im[t] = __builtin_amdgcn_mfma_f32_32x32x16_bf16(ac[k4], bQ, im[t], 0, 0, 0); } }
        __builtin_amdgcn_sched_barrier(0);
    }
#pragma unroll
    for (int t = 0; t < TPW; ++t) { const int ch = (cb0 + t) * 32 + r32;
#pragma unroll
        for (int r = 0; r < 16; ++r) { const int k1 = kblk * 32 + crow(r, hi); const float x = (float)((k1 * t2 * dftstep) & 16383) * (1.0f / 16384.0f);
            const float c = __builtin_amdgcn_cosf(x), sn = __builtin_amdgcn_sinf(x);
            bf16_t* o = Bs + ((((size_t)k1 * 128 + t2) * 4 + g4) * 256 + ch);
            o[0] = bf1(re[t][r] * c - im[t][r] * sn); o[128] = bf1(re[t][r] * sn + im[t][r] * c); } }
}
template <int N1>
__device__ __forceinline__ void pass2(const bf16_t* Bs, bf16_t* Ys, int k1, int g4, float rsT, const bf16_t* W128, LAS unsigned char* lds, int tid) {
    __syncthreads();
    { bf16x8 rv[4], iv[4];
#pragma unroll
      for (int i = 0; i < 4; ++i) { const int idx = tid + 512 * i, t2 = idx >> 4, c = idx & 15; const bf16_t* p = Bs + ((((size_t)k1 * 128 + t2) * 4 + g4) * 256 + c * 8); rv[i] = *(const bf16x8*)p; iv[i] = *(const bf16x8*)(p + 128); }
#pragma unroll
      for (int i = 0; i < 4; ++i) { const int idx = tid + 512 * i, t2 = idx >> 4, c = idx & 15; *(LAS bf16x8*)(lds + t2 * PP + c * 16) = rv[i]; *(LAS bf16x8*)(lds + PLANE + t2 * PP + c * 16) = iv[i]; } }
    __syncthreads();
    const int lane = tid & 63, wid = __builtin_amdgcn_readfirstlane(tid >> 6), r32 = lane & 31, hi = lane >> 5;
    const int kblk = wid & 3, cb0 = (wid >> 2) * 2;
    const bf16_t* wc = W128 + (kblk * 32 + r32) * 128 + 8 * hi; const bf16_t* wn = wc + 2 * 128 * 128;
    const int vb = (8 * hi + ((lane >> 2) & 3)) * PP + (16 * ((lane >> 4) & 1) + 4 * (lane & 3)) * 2;
    f32x16 acc[2];
    acc[0] = (f32x16){0.f, 0.f, 0.f, 0.f, 0.f, 0.f, 0.f, 0.f, 0.f, 0.f, 0.f, 0.f, 0.f, 0.f, 0.f, 0.f}; acc[1] = acc[0];
    bf16x8 ac[8], an[8];
#pragma unroll
    for (int ks = 0; ks < 8; ++ks) { ac[ks] = *(const bf16x8*)(wc + 16 * ks); an[ks] = *(const bf16x8*)(wn + 16 * ks); }
    __builtin_amdgcn_sched_barrier(0);
#pragma unroll
    for (int ks = 0; ks < 8; ++ks) {
#pragma unroll
        for (int t = 0; t < 2; ++t) { LAS unsigned char* bp = lds + vb + ks * 16 * PP + (cb0 + t) * 64;
            const bf16x8 bR = trB(bp), bI = trB(bp + PLANE);
            acc[t] = __builtin_amdgcn_mfma_f32_32x32x16_bf16(ac[ks], bR, acc[t], 0, 0, 0); acc[t] = __builtin_amdgcn_mfma_f32_32x32x16_bf16(an[ks], bI, acc[t], 0, 0, 0); }
    }
#pragma unroll
    for (int t = 0; t < 2; ++t) { const int ch = (cb0 + t) * 32 + r32;
#pragma unroll
        for (int r = 0; r < 16; ++r) { const int k2 = kblk * 32 + crow(r, hi); *(bf16_t*)((char*)Ys + pg8::atile_off(k1 + N1 * k2, (g4 * 128 + ch) & ~7, DM / 64) + (ch & 7) * 2) = bf1(acc[t][r] * rsT); } }
}
}

constexpr int NPH = 52;
__global__ void __launch_bounds__(512, 2) fwd(Args a_unused) {
    extern __shared__ __attribute__((aligned(16))) unsigned char lds_raw[];
    LAS unsigned char* lds = (LAS unsigned char*)lds_raw;
    const int wg = blockIdx.x, nwg = gridDim.x;
    int wv = __builtin_amdgcn_readfirstlane((int)threadIdx.x >> 6); asm volatile("" : "+s"(wv));
    { const int tid0 = opaque_tid(wv); for (int u = tid0; u < (LDS_BYTES - LDSCTL_OFF) / 4; u += 512) ((LAS unsigned*)(lds + LDSCTL_OFF))[u] = 0u; }
    __syncthreads();
    int lo, hi; XcdBarrier bar;
    { KArgs* ka = kargs(); lo = ka->ph_lo; hi = ka->ph_hi; unsigned* barw = (unsigned*)(ka->ws + WS_CTL) + CW_BAR + ka->li * XCD_BAR_WORDS;
      bar.bar = barw; bar.x = 0; bar.st = (volatile LAS unsigned*)(lds + MISC_OFF + 32); bar.wv = wv;
      if (hi - lo > 1) bar = xcd_barrier_post(barw, (volatile LAS unsigned*)(lds + MISC_OFF + 32), wv); }
    int pi = 0;
#define PH_BEGIN if (pi >= lo && pi < hi) { KArgs& a = *kargs(); unsigned char* const ws = a.ws; (void)ws;
#define PH_END   if (pi + 1 < hi) xcd_barrier(bar); } ++pi;

    PH_BEGIN prologue_phase(a, lds, wg, nwg, opaque_tid(wv)); PH_END
    PH_BEGIN prologue2_phase(a, lds, wg, nwg, opaque_tid(wv)); PH_END
    PH_BEGIN { const int t_ = opaque_tid(wv); for (int rep = 0; rep < NREP(6); ++rep) norm_first_phase(a, wg, nwg, __builtin_amdgcn_readfirstlane(t_ >> 6), t_ & 63); } PH_END

    for (int l = 0; l < 2; ++l) {
        for (int s = 0; s < 3; ++s) {
            const bool first = (l == 0 && s == 0);
            if ((DBG_SKIP & 1) && s == 1) { pi += 20; continue; }
            if (s != 1) {
                PH_BEGIN { unsigned char* wl = ws + WS_W + (size_t)l * WLAYER; pg8::PlainOrder S; S.init(ws + WS_H, wl + (s == 0 ? WO_FF1I : WO_FF2I), NTOK, 2 * DFF, DM, DM, nwg, wg, WGM_FFI); S.atile = !first;        pg8::EpiSwiGLU E{(bf16_t*)(ws + WS_BIG), (const float*)(ws + WS_SS) + (size_t)(l * 3 + s) * NTOK, (const float*)(ws + WS_BW) + (size_t)l * 6 * BWL + (s == 0 ? 0 : 27392)};
                           for (int rep = 0; rep < NREP(0); ++rep) pg8::gemm_phase(lds, DM, DM, DM, S, E, wv); } PH_END
                PH_BEGIN { unsigned char* wl = ws + WS_W + (size_t)l * WLAYER; pg8::PlainOrder S; S.init(ws + WS_BIG, wl + (s == 0 ? WO_FF1O : WO_FF2O), NTOK, DM, DFF, DFF, nwg, wg, WGM_FFO);
                           const bool lastsub = (l == 1 && s == 2);
                           pg8::EpiResid E{first ? a.in[I_XP] : (const float*)nullptr, first ? a.in[I_XS] - (size_t)32768 * DM : (const float*)nullptr, (float*)(ws + WS_XF), lastsub ? a.out : (float*)nullptr,
                                           (const float*)(ws + WS_MOD) + (size_t)l * 6 * NMODC, (3 * s + 2) * DM, 0.5f, 0,
                                           lastsub ? (bf16_t*)nullptr : (bf16_t*)(ws + WS_H), (const float*)(ws + WS_AT) + (size_t)(l * 3 + s + 1) * 6 * DM, (float*)(ws + WS_SS) + (size_t)(l * 3 + s + 1) * NTOK};
                           pg8::gemm_phase(lds, DFF, DFF, DFF, S, E, wv); } PH_END
            } else {
                for (int g = 0; g < 4; ++g) {
                    const int T = g < 2 ? 16384 : 8192;
                    PH_BEGIN if (!(DBG_SKIP & 128)) { unsigned char* wl = ws + WS_W + (size_t)l * WLAYER; pg8::PlainOrder S; S.init((bf16_t*)(ws + WS_H) + (size_t)g * GT * DM, wl + WO_IN, GT, NINV, DM, DM, nwg, wg, WGM_INP);
                               pg8::EpiInProj E{(bf16_t*)(ws + WS_Z), (bf16_t*)(ws + WS_G), a.in[I_BGATE] + (size_t)l * 4 * DM, T - 1, (const float*)(ws + WS_SS) + (size_t)(l * 3 + 1) * NTOK, (const float*)(ws + WS_BW) + (size_t)l * 6 * BWL + 11008, g * GT};
                               for (int rep = 0; rep < NREP(1); ++rep) pg8::gemm_phase(lds, DM, DM, DM, S, E, wv); } PH_END
                    PH_BEGIN {
                        bf16_t* Zb = (bf16_t*)(ws + WS_Z); bf16_t* Yb = (bf16_t*)(ws + WS_Y);
                        { const float* lamp = (const float*)(ws + WS_LAM); const float* lng = a.in[I_DLNG] + l * 128;
                          if (!(DBG_SKIP & 2)) for (int rep = 0; rep < NREP(2); ++rep) for (int u = wg; u < 256; u += nwg) { const int x = u & 7, h = x >> 1; int seq, qb;
                            if (T == 16384) { seq = 0; qb = (u >> 3) * 2 + (x & 1); } else { seq = x & 1; qb = u >> 3; }
                            dattn::unit<0>(Zb + (size_t)seq * T * ZR, T, h, qb, lamp, l, lng, Yb + (size_t)seq * T * DM, (u32x4*)(ws + WS_DOS) + (size_t)u * 4096, lds, wv);
#if DBG_PROBE >= 0
                            dattn::unit<DBG_PROBE>(Zb + (size_t)seq * T * ZR, T, h, qb, lamp, l, lng, (bf16_t*)(ws + WS_MG) + (size_t)seq * T * DM, (u32x4*)(ws + WS_DOS) + (size_t)u * 4096, lds, wv);
#endif
                            } }
                        __syncthreads();
                        { const int tid = opaque_tid(wv), lane = tid & 63, wave = __builtin_amdgcn_readfirstlane(tid >> 6);
                          LAS unsigned char* vbuf = lds + wave * wattn::WBUF; const float* relb = a.in[I_RELB] + (size_t)l * 8 * 465;
                          LAS float* tabl = (LAS float*)(lds + 8 * wattn::WBUF);
                          { float tv[8];
#pragma unroll
                            for (int i = 0; i < 8; ++i) { const int e = tid + 512 * i; tv[i] = e < 8 * 465 ? relb[e] : 0.f; }
#pragma unroll
                            for (int i = 0; i < 8; ++i) { const int e = tid + 512 * i; if (e < 8 * 465) tabl[e] = tv[i] * LOG2E; } }
                          __syncthreads();
                          float* DO = (float*)(ws + WS_DILO); float* DL = (float*)(ws + WS_DILL);
                          for (int rep = 0; rep < NREP(3); ++rep) {
                          const int wx = (nwg == 256) ? ((wg & 7) * 32 + (wg >> 3)) : wg;
                          wattn::stream(Zb, Yb, DO, DL, tabl, T, wave, wx, nwg, vbuf);
                          __syncthreads();
                          wattn::dshared(Zb, DO, DL, T, wx, nwg, lds, opaque_tid(wv), wave); }
                          }
                        __syncthreads();
                        { const int tid = opaque_tid(wv); const bf16_t* dft = (const bf16_t*)(ws + WS_DFT); bf16_t* FB = (bf16_t*)(ws + WS_FFTB);
                          for (int rep = 0; rep < NREP(4); ++rep)
                          if (DBG_SKIP & 16) {} else if (T == 16384) { for (int u = wg; u < 512; u += nwg) fftm::pass1<128>(Zb, FB, u >> 2, u & 3, 1, dft, dft, lds, tid); }
                          else { for (int u = wg; u < 1024; u += nwg) { const int seq = u >> 9; fftm::pass1<64>(Zb + (size_t)seq * 8192 * ZR, FB + (size_t)seq * 64 * 128 * 1024, (u >> 2) & 127, u & 3, 2, dft + 49152, dft, lds, tid); } } }
                    } PH_END
                    PH_BEGIN {
                        const int tid = opaque_tid(wv); bf16_t* Yb = (bf16_t*)(ws + WS_Y); const bf16_t* FB = (const bf16_t*)(ws + WS_FFTB); const bf16_t* dft = (const bf16_t*)(ws + WS_DFT); const float* DO = (const float*)(ws + WS_DILO); const float* DL = (const float*)(ws + WS_DILL);
                        for (int rep = 0; rep < NREP(4); ++rep)
                        if (DBG_SKIP & 16) {} else if (T == 16384) { for (int u = wg; u < 512; u += nwg) fftm::pass2<128>(FB, Yb, u >> 2, u & 3, 0.0078125f * 0.08838834764831843f, dft, lds, tid); }
                        else { for (int u = wg; u < 512; u += nwg) { const int seq = u >> 8; fftm::pass2<64>(FB + (size_t)seq * 64 * 128 * 1024, Yb + (size_t)seq * 8192 * DM, (u >> 2) & 63, u & 3, 0.011048543456039806f * 0.08838834764831843f, dft, lds, tid); } }
                        if (DBG_SKIP & 30) { for (int item = wg * 512 + tid; item < GT * 512; item += nwg * 512) { const int row = item >> 9, c4 = item & 511, part = c4 >> 7;
                            const bool z = (part == 0 && (DBG_SKIP & 16)) || (part == 1 && (DBG_SKIP & 4)) || (part == 2 && (DBG_SKIP & 2)) || (part == 3 && (DBG_SKIP & 8));
                            if (z) *(u32x2*)(Yb + (size_t)row * DM + c4 * 4) = ((DBG_SKIP & 64) && part == 1) ? ((DBG_SKIP & 128) ? *(const u32x2*)((const bf16_t*)(ws + WS_H) + ((size_t)g * GT + row) * DM + (c4 - 128) * 4) : *(const u32x2*)((const bf16_t*)(ws + WS_Z) + (size_t)row * ZP + 512 + (c4 - 128) * 4)) : (u32x2){0u, 0u}; } }
                        if (!(DBG_SKIP & 8)) {
                            const bf16_t* DOb = (const bf16_t*)DO; const int istr = nwg * 512;
#pragma unroll 1
                            for (int item0 = wg * 512 + tid; item0 < GT * 128; item0 += 4 * istr) {
                                float Lv[4][3]; u32x2 pv[4][3];
#pragma unroll
                                for (int q = 0; q < 4; ++q) { const int item = item0 + q * istr; const bool ok = item < GT * 128; const int row = ok ? item >> 7 : 0, c4 = item & 127, h = c4 >> 4;
#pragma unroll
                                    for (int gq = 0; gq < 3; ++gq) { Lv[q][gq] = DL[((size_t)gq * GT + row) * 8 + h]; pv[q][gq] = *(const u32x2*)(DOb + ((size_t)gq * GT + row) * 512 + c4 * 4); } }
#pragma unroll
                                for (int q = 0; q < 4; ++q) { const int item = item0 + q * istr; if (item >= GT * 128) break; const int row = item >> 7, c4 = item & 127;
                                    const float L0 = Lv[q][0], L1 = Lv[q][1], L2 = Lv[q][2];
                                    const float mx = fmaxf(L0, fmaxf(L1, L2)); const float w0 = __builtin_amdgcn_exp2f(L0 - mx), w1 = __builtin_amdgcn_exp2f(L1 - mx), w2 = __builtin_amdgcn_exp2f(L2 - mx);
                                    const float inv = __builtin_amdgcn_rcpf(w0 + w1 + w2);
                                    const u32x2 p0 = pv[q][0], p1 = pv[q][1], p2 = pv[q][2];
                                    const f32x4 o = ((f32x4){bf_lo(p0.x), bf_hi(p0.x), bf_lo(p0.y), bf_hi(p0.y)} * w0 + (f32x4){bf_lo(p1.x), bf_hi(p1.x), bf_lo(p1.y), bf_hi(p1.y)} * w1 + (f32x4){bf_lo(p2.x), bf_hi(p2.x), bf_lo(p2.y), bf_hi(p2.y)} * w2) * inv;
                                    u32x2 w; w.x = pk2(o[0], o[1]); w.y = pk2(o[2], o[3]); *(u32x2*)((char*)Yb + pg8::atile_off(row, 1536 + (c4 >> 1) * 8, DM / 64) + (c4 & 1) * 8) = w; } } }
                    } PH_END
                    PH_BEGIN { unsigned char* wl = ws + WS_W + (size_t)l * WLAYER; pg8::MergeOrder S{(const char*)(ws + WS_Y), (const char*)(wl + WO_BR), nwg, wg}; pg8::EpiMerge E{(const bf16_t*)(ws + WS_G), (bf16_t*)(ws + WS_MG)};
                               for (int rep = 0; rep < NREP(5); ++rep) pg8::gemm_hm3(lds, DM, DM, DM, S, E, wv); } PH_END
                    PH_BEGIN { unsigned char* wl = ws + WS_W + (size_t)l * WLAYER; pg8::PlainOrder S; S.init(ws + WS_MG, wl + WO_OUT, GT, DM, DM, DM, nwg, wg);
                               pg8::EpiResid E{(const float*)nullptr, (const float*)nullptr, (float*)(ws + WS_XF), (float*)nullptr, (const float*)(ws + WS_MOD) + (size_t)l * 6 * NMODC, 5 * DM, 1.0f, g * GT,
                                               (bf16_t*)(ws + WS_H), (const float*)(ws + WS_AT) + (size_t)(l * 3 + 2) * 6 * DM, (float*)(ws + WS_SS) + (size_t)(l * 3 + 2) * NTOK};
                               pg8::gemm_phase(lds, DM, DM, DM, S, E, wv); } PH_END
                }
            }
        }
    }
    PH_BEGIN { const int t_ = opaque_tid(wv); final_phase(a, wg, nwg, __builtin_amdgcn_readfirstlane(t_ >> 6), t_ & 63); } PH_END
#undef PH_BEGIN
#undef PH_END
}

extern "C" void kernel_launch(void* const* d_in, const int* in_sizes, int n_in, void* d_out, int out_size, void* d_ws, size_t ws_size, hipStream_t stream) {
    static int grid = 0;
    if (grid == 0) {
        if (n_in != 24 || in_sizes[0] != 32768 * DM || out_size != NTOK * DM || ws_size < WS_END) { fprintf(stderr, "kernel_launch: unexpected shapes (n_in %d, out %d, ws %zu, need %zu)\n", n_in, out_size, ws_size, (size_t)WS_END); grid = -1; return; }
        int dev = 0, cus = 0, per_cu = 0;
        if (hipGetDevice(&dev) != hipSuccess || hipDeviceGetAttribute(&cus, hipDeviceAttributeMultiprocessorCount, dev) != hipSuccess) { grid = -1; return; }
        if (hipFuncSetAttribute((const void*)fwd, hipFuncAttributeMaxDynamicSharedMemorySize, LDS_BYTES) != hipSuccess) { fprintf(stderr, "kernel_launch: hipFuncSetAttribute failed\n"); grid = -1; return; }
        if (hipOccupancyMaxActiveBlocksPerMultiprocessor(&per_cu, (const void*)fwd, 512, LDS_BYTES) != hipSuccess || per_cu < 1) { fprintf(stderr, "kernel_launch: occupancy query says %d\n", per_cu); }
        (void)hipGetLastError();
        grid = cus > 256 ? 256 : cus;
    }
    if (grid < 0) return;
    if (hipMemsetAsync((char*)d_ws + WS_CTL, 0, CTL_ZERO_BYTES, stream) != hipSuccess) return;
    Args a{};
    for (int i = 0; i < 24; ++i) a.in[i] = (const float*)d_in[i];
    a.out = (float*)d_out; a.ws = (unsigned char*)d_ws; a.pad = 0;
#if MK_ONE_LAUNCH
    a.ph_lo = 0; a.ph_hi = NPH; a.li = 0;
    hipLaunchKernelGGL(fwd, dim3(grid), dim3(512), LDS_BYTES, stream, a);
#else
    for (int li = 0; li < NPH; ++li) { a.ph_lo = li; a.ph_hi = li + 1; a.li = 0; hipLaunchKernelGGL(fwd, dim3(grid), dim3(512), LDS_BYTES, stream, a); }
#endif
}
```
